# Optimizing an MI355X kernel written in HIP

```python
import jax, jax.numpy as jnp
from jax import lax
import numpy as np

D_MODEL = 1024
BATCH = 32
SEQ = 2048
DEPTH = 2
DEC_BATCH = 4
DEC_SEQ = 4096
PAST_LEN = 128

GRID_W = 64
ATTN_HEADS = 8
ATTN_HEAD_DIM = 64
ATTN_WIDTH = ATTN_HEADS * ATTN_HEAD_DIM
WIN_ROWS = 8
WIN_COLS = 16
QBLK_COLS = 16
KBLK_COLS = QBLK_COLS + WIN_COLS
N_CBLK = GRID_W // QBLK_COLS
SSM_HEADS = 8
SSM_HEAD_DIM = 64
SSM_WIDTH = SSM_HEADS * SSM_HEAD_DIM
SSM_GROUPS = 2
SSM_STATE = 128
CONV_W = 5
CONV_DIM = SSM_WIDTH + 2 * SSM_GROUPS * SSM_STATE
CHUNK = 128
D_MIX = ATTN_WIDTH + SSM_WIDTH
D_IN_PROJ = 3 * ATTN_WIDTH + SSM_WIDTH + CONV_DIM + 2 * SSM_HEADS
SPLITS = [ATTN_WIDTH, 2 * ATTN_WIDTH, 3 * ATTN_WIDTH, 3 * ATTN_WIDTH + SSM_WIDTH,
          3 * ATTN_WIDTH + SSM_WIDTH + CONV_DIM]
D_FF = 2816
ALPHA = (2 * DEPTH) ** 0.25
BETA = (8 * DEPTH) ** -0.25
LN_EPS = 1e-5
RMS_EPS = 1e-6

kernel_name = "hymba_natten_ssd_macaron_deepnorm_encoder"


def layer_norm(x, g, b):
    x32 = x.astype(jnp.float32)
    mu = jnp.mean(x32, axis=-1, keepdims=True)
    xc = x32 - mu
    var = jnp.mean(xc * xc, axis=-1, keepdims=True)
    y = xc * lax.rsqrt(var + LN_EPS) * g.astype(jnp.float32) + b.astype(jnp.float32)
    return y.astype(x.dtype)


def rms_norm(x, g):
    x32 = x.astype(jnp.float32)
    y = x32 * lax.rsqrt(jnp.mean(x32 * x32, axis=-1, keepdims=True) + RMS_EPS)
    return y * g.astype(jnp.float32)


def swiglu_ffn(x, w_gate, w_up, w_down):
    return (jax.nn.silu(x @ w_gate) * (x @ w_up)) @ w_down


def neighbourhood_attention(q, k, v, rpb):
    bsz, t, h, dh = q.shape
    rows = t // GRID_W
    kr = min(WIN_ROWS, rows)
    qcol = np.arange(GRID_W).reshape(N_CBLK, QBLK_COLS)
    kstart = np.clip(np.arange(N_CBLK) * QBLK_COLS - WIN_COLS // 2, 0, GRID_W - KBLK_COLS)
    kcol = kstart[:, None] + np.arange(KBLK_COLS)
    cstart = np.clip(qcol - WIN_COLS // 2, 0, GRID_W - WIN_COLS)
    col_valid = (kcol[:, None, :] >= cstart[:, :, None]) & (kcol[:, None, :] < cstart[:, :, None] + WIN_COLS)
    col_off = np.clip(kcol[:, None, :] - qcol[:, :, None] + WIN_COLS - 1, 0, 2 * WIN_COLS - 2)
    rpb_cols = jnp.where(col_valid, rpb[:, :, col_off].astype(jnp.float32), -jnp.inf)

    qg = q.reshape(bsz, rows, N_CBLK, QBLK_COLS, h, dh)
    kg_cols = k.reshape(bsz, rows, GRID_W, h, dh)[:, :, kcol]
    vg_cols = v.reshape(bsz, rows, GRID_W, h, dh)[:, :, kcol]

    def row_block(r):
        rs = jnp.clip(r - kr // 2, 0, rows - kr)
        k_blk = lax.dynamic_slice_in_dim(kg_cols, rs, kr, axis=1)
        v_blk = lax.dynamic_slice_in_dim(vg_cols, rs, kr, axis=1)
        q_blk = lax.dynamic_index_in_dim(qg, r, axis=1, keepdims=False)
        row_off = rs + jnp.arange(kr) - r + (WIN_ROWS - 1)
        bias = jnp.take(rpb_cols, row_off, axis=1).transpose(0, 2, 3, 1, 4)
        s = jnp.einsum('bjqhd,brjkhd->bhjqrk', q_blk, k_blk).astype(jnp.float32) + bias[None]
        p = jax.nn.softmax(s.reshape(s.shape[:4] + (kr * KBLK_COLS,)), axis=-1).reshape(s.shape)
        o = jnp.einsum('bhjqrk,brjkhd->bjqhd', p.astype(v.dtype), v_blk)
        return o.reshape(bsz, GRID_W, h, dh)

    out = lax.map(row_block, jnp.arange(rows))
    return jnp.moveaxis(out, 0, 1).reshape(bsz, t, h * dh)


def ssd_chunked(x, dt, a, b_mat, c_mat):
    bsz, t, h, p = x.shape
    g, n = b_mat.shape[2], b_mat.shape[3]
    e = h // g
    nc = t // CHUNK
    xd = (x.astype(jnp.float32) * dt[..., None]).reshape(bsz, nc, CHUNK, g, e, p)
    la = (dt * a).reshape(bsz, nc, CHUNK, g, e).transpose(0, 3, 4, 1, 2)
    a_cum = jnp.cumsum(la, axis=-1)
    bc = b_mat.astype(jnp.float32).reshape(bsz, nc, CHUNK, g, n)
    cc = c_mat.astype(jnp.float32).reshape(bsz, nc, CHUNK, g, n)
    cb = jnp.einsum('bclgn,bcsgn->bgcls', cc, bc)
    seg = a_cum[..., :, None] - a_cum[..., None, :]
    causal = np.tril(np.ones((CHUNK, CHUNK), dtype=bool))
    decay = jnp.exp(jnp.where(causal, seg, -jnp.inf))
    y_diag = jnp.einsum('bgcls,bgecls,bcsgep->bclgep', cb, decay, xd)
    decay_states = jnp.exp(a_cum[..., -1:] - a_cum)
    states = jnp.einsum('bclgn,bgecl,bclgep->bcgepn', bc, decay_states, xd)
    chunk_decay = jnp.exp(a_cum[..., -1])

    def step(hstate, inp):
        st, dec = inp
        return hstate * dec[..., None, None] + st, hstate

    _, prev = lax.scan(step, jnp.zeros_like(states[:, 0]),
                       (jnp.moveaxis(states, 1, 0), jnp.moveaxis(chunk_decay, 3, 0)))
    prev = jnp.moveaxis(prev, 0, 1)
    y_off = jnp.einsum('bclgn,bcgepn,bgecl->bclgep', cc, prev, jnp.exp(a_cum))
    return (y_diag + y_off).reshape(bsz, t, h, p)


def dwconv_centred(u, w, b):
    c = u.shape[-1]
    out = lax.conv_general_dilated(u, w[:, None, :].astype(u.dtype), window_strides=(1,),
                                   padding=[(CONV_W // 2, CONV_W // 2)],
                                   dimension_numbers=('NWC', 'WIO', 'NWC'), feature_group_count=c)
    return out + b


def ssd_mixer(z, xbc, dt_raw, conv_w, conv_b, dt_bias, a_log, d_skip, norm_g):
    bsz, t = z.shape[:2]
    xbc = jax.nn.silu(dwconv_centred(xbc, conv_w, conv_b))
    xs = xbc[..., :SSM_WIDTH].reshape(bsz, t, SSM_HEADS, SSM_HEAD_DIM)
    bm = xbc[..., SSM_WIDTH:SSM_WIDTH + SSM_GROUPS * SSM_STATE].reshape(bsz, t, SSM_GROUPS, SSM_STATE)
    cm = xbc[..., SSM_WIDTH + SSM_GROUPS * SSM_STATE:].reshape(bsz, t, SSM_GROUPS, SSM_STATE)
    dt = jax.nn.softplus(dt_raw.astype(jnp.float32).reshape(bsz, t, 2, SSM_HEADS) + dt_bias.astype(jnp.float32))
    a = -jnp.exp(a_log.astype(jnp.float32))
    y_f = ssd_chunked(xs, dt[:, :, 0], a[0], bm, cm)
    y_b = ssd_chunked(xs[:, ::-1], dt[:, ::-1, 1], a[1], bm[:, ::-1], cm[:, ::-1])[:, ::-1]
    y = y_f + y_b + d_skip.astype(jnp.float32)[:, None] * xs.astype(jnp.float32)
    y = y.reshape(bsz, t, SSM_WIDTH)
    return rms_norm(y * jax.nn.silu(z.astype(jnp.float32)), norm_g).astype(z.dtype)


def hybrid_mixer(x, w_in, conv_w, conv_b, dt_bias, a_log, d_skip, ssm_norm_g, attn_norm_g, rpb, w_out):
    bsz, t, _ = x.shape
    proj = x @ w_in
    q, k, v, z, xbc, dt_raw = jnp.split(proj, SPLITS, axis=-1)
    q = q.reshape(bsz, t, ATTN_HEADS, ATTN_HEAD_DIM) * (ATTN_HEAD_DIM ** -0.5)
    k = k.reshape(bsz, t, ATTN_HEADS, ATTN_HEAD_DIM)
    v = v.reshape(bsz, t, ATTN_HEADS, ATTN_HEAD_DIM)
    attn = rms_norm(neighbourhood_attention(q, k, v, rpb), attn_norm_g).astype(x.dtype)
    ssm = ssd_mixer(z, xbc, dt_raw, conv_w, conv_b, dt_bias, a_log, d_skip, ssm_norm_g)
    return jnp.concatenate([attn, ssm], axis=-1) @ w_out


def setup_inputs(seed: int = 0) -> dict:
    key = jax.random.key(seed)
    ks = jax.random.split(key, 26)
    nrm = lambda k, shape, s: jax.random.normal(k, shape, jnp.float32) * s
    dt0 = jnp.exp(jax.random.uniform(ks[10], (DEPTH, 2, SSM_HEADS), jnp.float32,
                                     minval=float(np.log(1e-3)), maxval=float(np.log(1e-1))))
    return {
        "x_prompt": nrm(ks[0], (BATCH, SEQ, D_MODEL), 1.0),
        "x_sample": nrm(ks[1], (DEC_BATCH, DEC_SEQ, D_MODEL), 1.0),
        "ffn1_w_gate": nrm(ks[2], (DEPTH, D_MODEL, D_FF), D_MODEL ** -0.5),
        "ffn1_w_up": nrm(ks[3], (DEPTH, D_MODEL, D_FF), D_MODEL ** -0.5),
        "ffn1_w_down": nrm(ks[4], (DEPTH, D_FF, D_MODEL), BETA * D_FF ** -0.5),
        "ln1_g": 1.0 + nrm(ks[5], (DEPTH, D_MODEL), 0.02),
        "ln1_b": nrm(ks[6], (DEPTH, D_MODEL), 0.02),
        "w_in": nrm(ks[7], (DEPTH, D_MODEL, D_IN_PROJ), D_MODEL ** -0.5),
        "conv_w": nrm(ks[8], (DEPTH, CONV_W, CONV_DIM), CONV_W ** -0.5),
        "conv_b": nrm(ks[9], (DEPTH, CONV_DIM), 0.01),
        "dt_bias": dt0 + jnp.log(-jnp.expm1(-dt0)),
        "a_log": jnp.log(jax.random.uniform(ks[11], (DEPTH, 2, SSM_HEADS), jnp.float32, minval=1.0, maxval=16.0)),
        "d_skip": 1.0 + nrm(ks[12], (DEPTH, SSM_HEADS), 0.02),
        "ssm_norm_g": 1.0 + nrm(ks[13], (DEPTH, SSM_WIDTH), 0.02),
        "attn_norm_g": 1.0 + nrm(ks[14], (DEPTH, ATTN_WIDTH), 0.02),
        "rpb": nrm(ks[15], (DEPTH, ATTN_HEADS, 2 * WIN_ROWS - 1, 2 * WIN_COLS - 1), 0.1),
        "w_out": nrm(ks[16], (DEPTH, D_MIX, D_MODEL), BETA * D_MIX ** -0.5),
        "ln2_g": 1.0 + nrm(ks[17], (DEPTH, D_MODEL), 0.02),
        "ln2_b": nrm(ks[18], (DEPTH, D_MODEL), 0.02),
        "ffn2_w_gate": nrm(ks[19], (DEPTH, D_MODEL, D_FF), D_MODEL ** -0.5),
        "ffn2_w_up": nrm(ks[20], (DEPTH, D_MODEL, D_FF), D_MODEL ** -0.5),
        "ffn2_w_down": nrm(ks[21], (DEPTH, D_FF, D_MODEL), BETA * D_FF ** -0.5),
        "ln3_g": 1.0 + nrm(ks[22], (DEPTH, D_MODEL), 0.02),
        "ln3_b": nrm(ks[23], (DEPTH, D_MODEL), 0.02),
    }


def reference(x_prompt, x_sample, ffn1_w_gate, ffn1_w_up, ffn1_w_down, ln1_g, ln1_b, w_in, conv_w, conv_b,
              dt_bias, a_log, d_skip, ssm_norm_g, attn_norm_g, rpb, w_out, ln2_g, ln2_b,
              ffn2_w_gate, ffn2_w_up, ffn2_w_down, ln3_g, ln3_b):
    def trunk(x):
        for l in range(DEPTH):
            x = layer_norm(ALPHA * x + 0.5 * swiglu_ffn(x, ffn1_w_gate[l], ffn1_w_up[l], ffn1_w_down[l]),
                           ln1_g[l], ln1_b[l])
            mix = hybrid_mixer(x, w_in[l], conv_w[l], conv_b[l], dt_bias[l], a_log[l], d_skip[l],
                               ssm_norm_g[l], attn_norm_g[l], rpb[l], w_out[l])
            x = layer_norm(ALPHA * x + mix, ln2_g[l], ln2_b[l])
            x = layer_norm(ALPHA * x + 0.5 * swiglu_ffn(x, ffn2_w_gate[l], ffn2_w_up[l], ffn2_w_down[l]),
                           ln3_g[l], ln3_b[l])
        return x

    y_prompt = trunk(x_prompt)
    y_sample = trunk(x_sample)
    return (y_prompt, y_sample)
```

```cpp
#include <hip/hip_runtime.h>
#include <hip/hip_cooperative_groups.h>
#include <cstdio>
#include <cstdint>
namespace cg = cooperative_groups;
namespace pg8 {
#define PG8_LAS __attribute__((address_space(3)))
typedef unsigned short bf16_t;
typedef short bf16x8 __attribute__((ext_vector_type(8)));
typedef float f32x4 __attribute__((ext_vector_type(4)));
typedef unsigned u32x4 __attribute__((ext_vector_type(4)));
constexpr int BM = 256, BK = 64, HALF = 128, HTB = HALF * BK * 2  , STAGE_BYTES = 8 * HTB, NXCD = 8, WGM = 8;

__host__ __device__ __forceinline__ int lds_byte(int r, int c) { const int st = (r >> 4) * 2 + (c >> 5), rr = r & 15, cc = c & 31, ob = rr * 64 + cc * 2; return st * 1024 + (ob ^ (((ob >> 9) & 1) << 5)); }
__host__ __device__ __forceinline__ void stage_rc(int b, int& R, int& C) { const int st = b / 1024, sb = b % 1024, swz = sb ^ (((sb >> 9) & 1) << 5); R = (st >> 1) * 16 + swz / 64; C = (st & 1) * 32 + (swz % 64) / 2; }
__host__ __device__ __forceinline__ int perm32(int rho) { const int n = rho >> 4, i = rho & 15; return 8 * (i >> 2) + 4 * n + (i & 3); }

struct Unit { int pm, pn; };
struct Gemm { const bf16_t* A; const bf16_t* Bt; int M, N, K; };

struct StaticOrder {
    int nM, nN, nwg, G, c;
    __host__ __device__ void init(int M, int N, int G_, int c_) { nM = M / BM; nN = N / BM; nwg = nM * nN; G = G_; c = c_; }
    __host__ __device__ bool next(int i, Unit& u) const {
        const long L = (long)i * G + c; if (L >= nwg) return false;
        int wgid = (int)L; { const int q = nwg / NXCD, r = nwg % NXCD, xcd = wgid % NXCD, off = wgid / NXCD; wgid = (xcd < r ? xcd * (q + 1) : r * (q + 1) + (xcd - r) * q) + off; }
        const int nig = WGM * nN, gid = wgid / nig, fm = gid * WGM, gsz = (nM - fm) < WGM ? (nM - fm) : WGM;
        u.pm = fm + ((wgid % nig) % gsz); u.pn = (wgid % nig) / gsz; return true;
    }
    __device__ __forceinline__ void a_ready(const Unit&) const {}
    __device__ __forceinline__ void done(const Unit&) const {}
};

typedef float f32x2e __attribute__((ext_vector_type(2)));
typedef __bf16 bf16x2e __attribute__((ext_vector_type(2)));
__device__ __forceinline__ unsigned pkbf(float a, float b) { f32x2e v = {a, b}; bf16x2e r = __builtin_convertvector(v, bf16x2e); return __builtin_bit_cast(unsigned, r); }
__device__ __forceinline__ float silu_f(float g) { return g * __builtin_amdgcn_rcpf(1.f + __builtin_amdgcn_exp2f(-1.4426950408889634f * g)); }
constexpr float ALPHA_F = 1.4142135623730951f;
constexpr int MPROMPT = 65536;

struct EpiSwiGLU {
    static constexpr bool PERM = true, AFTER_DRAIN = false;
    bf16_t* H; int ldh;
    __device__ __forceinline__ void operator()(const f32x4 (&acc)[2][2][4][2], const Unit& u, int wr, int wc, int fr, int fq) const {
        const int row0 = u.pm * BM + wr * 64 + fr, col0 = u.pn * HALF + wc * 32 + 8 * fq;
#pragma unroll
        for (int ai = 0; ai < 2; ++ai)
#pragma unroll
            for (int m = 0; m < 4; ++m) {
                bf16_t* p = H + (size_t)(row0 + ai * HALF + m * 16) * ldh + col0;
                const f32x4 g0 = acc[ai][0][m][0], g1 = acc[ai][0][m][1], u0 = acc[ai][1][m][0], u1 = acc[ai][1][m][1];
                u32x4 w;
                w.x = pkbf(silu_f(g0[0]) * u0[0], silu_f(g0[1]) * u0[1]); w.y = pkbf(silu_f(g0[2]) * u0[2], silu_f(g0[3]) * u0[3]);
                w.z = pkbf(silu_f(g1[0]) * u1[0], silu_f(g1[1]) * u1[1]); w.w = pkbf(silu_f(g1[2]) * u1[2], silu_f(g1[3]) * u1[3]);
                *(u32x4*)p = w;
            }
    }
};
struct EpiResid {
    static constexpr bool PERM = false, AFTER_DRAIN = false;
    const float* r0; const float* r1; float* out; float scale;
    __device__ __forceinline__ void operator()(const f32x4 (&acc)[2][2][4][2], const Unit& u, int wr, int wc, int fr, int fq) const {
        const float* rbase = (u.pm * BM < MPROMPT) ? r0 : r1;
#pragma unroll
        for (int ai = 0; ai < 2; ++ai)
#pragma unroll
            for (int m = 0; m < 4; ++m) {
                const size_t roff = (size_t)(u.pm * BM + ai * HALF + wr * 64 + m * 16 + fr) * 1024;
#pragma unroll
                for (int bj = 0; bj < 2; ++bj)
#pragma unroll
                    for (int n = 0; n < 2; ++n) {
                        const int c = u.pn * BM + bj * HALF + wc * 32 + n * 16 + 4 * fq;
                        const f32x4 b = *(const f32x4*)(rbase + roff + c);
                        *(f32x4*)(out + roff + c) = b * ALPHA_F + acc[ai][bj][m][n] * scale;
                    }
            }
    }
};
struct EpiProj {
    static constexpr bool PERM = true, AFTER_DRAIN = false;
    bf16_t* QKV; bf16_t* Z; bf16_t* XBC; float* DT;
    __device__ __forceinline__ void operator()(const f32x4 (&acc)[2][2][4][2], const Unit& u, int wr, int wc, int fr, int fq) const {
        const int row0 = u.pm * BM + wr * 64 + fr, pn = u.pn;
        if (pn == 12) {
            if (wc == 0 && fq < 2) {
#pragma unroll
                for (int ai = 0; ai < 2; ++ai)
#pragma unroll
                    for (int m = 0; m < 4; ++m) { float* p = DT + (size_t)(row0 + ai * HALF + m * 16) * 16 + 8 * fq;
                        *(f32x4*)p = acc[ai][0][m][0]; *(f32x4*)(p + 4) = acc[ai][0][m][1]; }
            }
            return;
        }
        bf16_t* base; int ldc, colt; float sc = 1.f;
        if (pn < 6) { base = QKV; ldc = 1536; colt = pn * 256; if (pn < 2) sc = 0.125f; }
        else if (pn < 8) { base = Z; ldc = 512; colt = (pn - 6) * 256; }
        else { base = XBC; ldc = 1024; colt = (pn - 8) * 256; }
        const int col0 = colt + wc * 32 + 8 * fq;
#pragma unroll
        for (int ai = 0; ai < 2; ++ai)
#pragma unroll
            for (int m = 0; m < 4; ++m) { bf16_t* rowp = base + (size_t)(row0 + ai * HALF + m * 16) * ldc + col0;
#pragma unroll
                for (int bj = 0; bj < 2; ++bj) { const f32x4 v0 = acc[ai][bj][m][0] * sc, v1 = acc[ai][bj][m][1] * sc;
                    u32x4 w; w.x = pkbf(v0[0], v0[1]); w.y = pkbf(v0[2], v0[3]); w.z = pkbf(v1[0], v1[1]); w.w = pkbf(v1[2], v1[3]);
                    *(u32x4*)(rowp + bj * HALF) = w; } }
    }
};

template <class Epi, class Sched, bool ALIGN_EPI = false, bool SP2 = false>
__device__ __forceinline__ void gemm_phase(PG8_LAS unsigned char* lds, const Gemm g, const Sched& S, const Epi& E) {
    int tid_ = threadIdx.x; asm volatile("" : "+v"(tid_));
    const int tid = tid_, wid = __builtin_amdgcn_readfirstlane(tid >> 6), lane = tid & 63, wr = wid >> 2, wc = wid & 3, fr = lane & 15, fq = lane >> 4;
    const int K = g.K, nt = K / BK;
    unsigned voffA[2], voffB[2];
#pragma unroll
    for (int i = 0; i < 2; ++i) { int R, C; stage_rc(tid * 16 + i * 8192, R, C); const int Rb = Epi::PERM ? ((R & ~31) + perm32(R & 31)) : R;
        voffA[i] = (unsigned)(R * K + C) * 2u; voffB[i] = (unsigned)(Rb * K + C) * 2u; }
    const size_t kstep = (size_t)(BK * 2);
    const size_t hstep = (size_t)HALF * K * 2;
    const size_t tstep = 2 * hstep;
    const unsigned ldsw = (unsigned)wid * 1024u;
    const int aoff = lds_byte(wr * 64 + fr, fq * 8), boff = lds_byte(wc * 32 + fr, fq * 8);
#define PG8_SA(b, h) (((b) * 2 + (h)) * HTB)
#define PG8_SB(b, h) ((4 + (b) * 2 + (h)) * HTB)
#define PG8_STAGE(bufoff, gbase, voff) do { _Pragma("unroll") for (int _i = 0; _i < 2; ++_i) \
        __builtin_amdgcn_global_load_lds((const unsigned*)((const char*)(gbase) + (voff)[_i]), (PG8_LAS unsigned*)(lds + (bufoff) + ldsw + _i * 8192), 16, 0, 0); } while (0)
#define PG8_LDA(dst, b, h) do { _Pragma("unroll") for (int m = 0; m < 4; ++m) _Pragma("unroll") for (int k = 0; k < 2; ++k) dst[m][k] = *(const PG8_LAS bf16x8*)(lds + PG8_SA(b, h) + aoff + m * 2048 + k * 1024); } while (0)
#define PG8_LDB(dst, b, h) do { _Pragma("unroll") for (int n = 0; n < 2; ++n) _Pragma("unroll") for (int k = 0; k < 2; ++k) dst[n][k] = *(const PG8_LAS bf16x8*)(lds + PG8_SB(b, h) + boff + n * 2048 + k * 1024); } while (0)
#define PG8_MMA(ai, bj, At, Bt) do { __builtin_amdgcn_s_setprio(1); _Pragma("unroll") for (int m = 0; m < 4; ++m) _Pragma("unroll") for (int n = 0; n < 2; ++n) _Pragma("unroll") for (int k = 0; k < 2; ++k) \
        acc[ai][bj][m][n] = __builtin_amdgcn_mfma_f32_16x16x32_bf16(Bt[n][k], At[m][k], acc[ai][bj][m][n], 0, 0, 0); __builtin_amdgcn_s_setprio(0); } while (0)
#define PG8_WAIT_V(n) asm volatile("s_waitcnt vmcnt(" #n ")" ::: "memory")
#define PG8_WAIT_L(n) asm volatile("s_waitcnt lgkmcnt(" #n ")" ::: "memory")
#define PG8_BAR __builtin_amdgcn_s_barrier()
#define PG8_SCHED __builtin_amdgcn_sched_barrier(0)
    Unit cur, nxt; int ui = 0;
    if (!S.next(0, cur)) return;
    f32x4 acc[2][2][4][2];
#pragma unroll
    for (int a = 0; a < 2; ++a)
#pragma unroll
        for (int b = 0; b < 2; ++b)
#pragma unroll
            for (int m = 0; m < 4; ++m)
#pragma unroll
                for (int n = 0; n < 2; ++n) acc[a][b][m][n] = (f32x4){0.f, 0.f, 0.f, 0.f};
    bf16x8 At[4][2], B0[2][2], B1[2][2];
    const char* cA = (const char*)g.A + (size_t)cur.pm * tstep; const char* cB = (const char*)g.Bt + (size_t)cur.pn * tstep;
    S.a_ready(cur);
    if constexpr (SP2) {
        PG8_STAGE(PG8_SB(0, 0), cB, voffB); PG8_STAGE(PG8_SB(0, 1), cB + hstep, voffB); PG8_STAGE(PG8_SA(0, 0), cA, voffA); PG8_STAGE(PG8_SA(0, 1), cA + hstep, voffA);
        if (wr == 1) PG8_BAR;
        PG8_WAIT_V(2); PG8_BAR;
        PG8_STAGE(PG8_SB(1, 0), cB + kstep, voffB); PG8_STAGE(PG8_SA(1, 0), cA + kstep, voffA); PG8_STAGE(PG8_SB(1, 1), cB + hstep + kstep, voffB);
        PG8_WAIT_V(6); PG8_BAR;
    } else {
        PG8_STAGE(PG8_SB(0, 0), cB, voffB); PG8_STAGE(PG8_SA(0, 0), cA, voffA); PG8_STAGE(PG8_SB(0, 1), cB + hstep, voffB); PG8_STAGE(PG8_SA(0, 1), cA + hstep, voffA);
        if (wr == 1) PG8_BAR;
        PG8_WAIT_V(4); PG8_BAR;
        PG8_STAGE(PG8_SB(1, 0), cB + kstep, voffB); PG8_STAGE(PG8_SA(1, 0), cA + kstep, voffA); PG8_STAGE(PG8_SB(1, 1), cB + hstep + kstep, voffB);
        PG8_WAIT_V(6); PG8_BAR;
    }
    for (;;) {
        const bool has_next = S.next(ui + 1, nxt);
        const char* nA = has_next ? (const char*)g.A + (size_t)nxt.pm * tstep : cA; const char* nB = has_next ? (const char*)g.Bt + (size_t)nxt.pn * tstep : cB;
        for (int t = 0; t < nt; t += 2) {
            const bool last = (t == nt - 2);
            const char* a1 = cA + (size_t)(t + 1) * kstep;
            const char* a2 = last ? nA : cA + (size_t)(t + 2) * kstep; const char* b2 = last ? nB : cB + (size_t)(t + 2) * kstep;
            const char* a3 = a2 + kstep; const char* b3 = b2 + kstep;
            if (last && has_next) S.a_ready(nxt);
            if constexpr (SP2) {
            PG8_LDB(B0, 0, 0); PG8_LDB(B1, 0, 1); PG8_SCHED; PG8_LDA(At, 0, 0); PG8_STAGE(PG8_SA(1, 1), a1 + hstep, voffA);
            PG8_WAIT_V(8); PG8_WAIT_L(0); PG8_BAR; PG8_MMA(0, 0, At, B0); PG8_MMA(0, 1, At, B1); PG8_BAR; PG8_SCHED;
            PG8_LDA(At, 0, 1); PG8_STAGE(PG8_SB(0, 0), b2, voffB); PG8_STAGE(PG8_SB(0, 1), b2 + hstep, voffB); PG8_STAGE(PG8_SA(0, 0), a2, voffA);
            PG8_WAIT_V(8); PG8_WAIT_L(0); PG8_BAR; PG8_MMA(1, 0, At, B0); PG8_MMA(1, 1, At, B1); PG8_BAR; PG8_SCHED;
            PG8_LDB(B0, 1, 0); PG8_LDB(B1, 1, 1); PG8_SCHED; PG8_LDA(At, 1, 0); PG8_STAGE(PG8_SA(0, 1), a2 + hstep, voffA);
            PG8_WAIT_V(8); PG8_WAIT_L(0); PG8_BAR; PG8_MMA(0, 0, At, B0); PG8_MMA(0, 1, At, B1); PG8_BAR; PG8_SCHED;
            PG8_LDA(At, 1, 1); PG8_STAGE(PG8_SB(1, 0), b3, voffB); PG8_STAGE(PG8_SB(1, 1), b3 + hstep, voffB); PG8_STAGE(PG8_SA(1, 0), a3, voffA);
            PG8_WAIT_V(8); PG8_WAIT_L(0); PG8_BAR; PG8_MMA(1, 0, At, B0); PG8_MMA(1, 1, At, B1); PG8_BAR; PG8_SCHED;
            } else {
            PG8_LDB(B0, 0, 0); PG8_SCHED; PG8_LDA(At, 0, 0); PG8_STAGE(PG8_SA(1, 1), a1 + hstep, voffA);
            PG8_WAIT_L(8); PG8_BAR; PG8_WAIT_L(0); PG8_MMA(0, 0, At, B0); PG8_BAR; PG8_SCHED;
            PG8_LDB(B1, 0, 1); PG8_STAGE(PG8_SB(0, 0), b2, voffB);
            PG8_BAR; PG8_WAIT_L(0); PG8_MMA(0, 1, At, B1); PG8_BAR;
            PG8_LDA(At, 0, 1); PG8_STAGE(PG8_SA(0, 0), a2, voffA);
            PG8_BAR; PG8_WAIT_L(0); PG8_MMA(1, 0, At, B0); PG8_BAR; PG8_SCHED;
            PG8_STAGE(PG8_SB(0, 1), b2 + hstep, voffB);
            PG8_WAIT_V(6); PG8_BAR; PG8_MMA(1, 1, At, B1); PG8_BAR;
            PG8_LDB(B0, 1, 0); PG8_SCHED; PG8_LDA(At, 1, 0); PG8_STAGE(PG8_SA(0, 1), a2 + hstep, voffA);
            PG8_WAIT_L(8); PG8_BAR; PG8_WAIT_L(0); PG8_MMA(0, 0, At, B0); PG8_BAR; PG8_SCHED;
            PG8_LDB(B1, 1, 1); PG8_STAGE(PG8_SB(1, 0), b3, voffB);
            PG8_BAR; PG8_WAIT_L(0); PG8_MMA(0, 1, At, B1); PG8_BAR;
            PG8_LDA(At, 1, 1); PG8_STAGE(PG8_SA(1, 0), a3, voffA);
            PG8_BAR; PG8_WAIT_L(0); PG8_MMA(1, 0, At, B0); PG8_BAR; PG8_SCHED;
            PG8_STAGE(PG8_SB(1, 1), b3 + hstep, voffB);
            PG8_WAIT_V(6); PG8_BAR; PG8_MMA(1, 1, At, B1); PG8_BAR;
            }
        }
        if constexpr (ALIGN_EPI) { if (wr == 0) PG8_BAR; }
        if constexpr (!Epi::AFTER_DRAIN) { E(acc, cur, wr, wc, fr, fq); S.done(cur); }
        if (!has_next) break;
#pragma unroll
        for (int a = 0; a < 2; ++a)
#pragma unroll
            for (int b = 0; b < 2; ++b)
#pragma unroll
                for (int m = 0; m < 4; ++m)
#pragma unroll
                    for (int n = 0; n < 2; ++n) acc[a][b][m][n] = (f32x4){0.f, 0.f, 0.f, 0.f};
        cur = nxt; cA = nA; cB = nB; ++ui;
        if constexpr (ALIGN_EPI) { if (wr == 1) PG8_BAR; }
    }
    PG8_WAIT_V(0);
    if constexpr (!ALIGN_EPI) { if (wr == 0) PG8_BAR; }
    PG8_BAR;
    if constexpr (Epi::AFTER_DRAIN) { E.fused(acc, cur, wr, wc, fr, fq, lds, wid, lane); S.done(cur); }
#undef PG8_SA
#undef PG8_SB
#undef PG8_STAGE
#undef PG8_LDA
#undef PG8_LDB
#undef PG8_MMA
#undef PG8_WAIT_V
#undef PG8_WAIT_L
#undef PG8_BAR
#undef PG8_SCHED
}
}

#define LAS __attribute__((address_space(3)))
typedef unsigned short bf16;
using pg8::f32x4; using pg8::u32x4; using pg8::pkbf; using pg8::silu_f; using pg8::MPROMPT;
typedef unsigned u32x2 __attribute__((ext_vector_type(2)));
constexpr int NWAVES = 8, NT = 512;
constexpr int M = 81920, D = 1024, FF = 2816, NGU = 5632, NIN = 3328, NPROJ = 3088;
constexpr float LN_EPS = 1e-5f, RMS_EPS = 1e-6f;
constexpr size_t MiB = 1u << 20;
constexpr size_t WS_W = 1 * MiB, W_LAYER = 42 * MiB;
constexpr size_t OW_GU1 = 0, OW_D1 = 11534336, OW_IN = 17301504, OW_OUT = 24117248, OW_GU2 = 26214400, OW_D2 = 37748736;
constexpr size_t WS_XB = 85 * MiB, WS_R = 245 * MiB, WS_QKV = WS_R, WS_Z = WS_R + 240 * MiB, WS_RAW = WS_R + 320 * MiB, WS_H = WS_R;
constexpr size_t WS_Y = 725 * MiB, WS_DT = 885 * MiB, WS_END = 890 * MiB;
constexpr int LDS_BYTES = 147456;

#define LDS_WAIT() asm volatile("s_waitcnt lgkmcnt(0)" ::: "memory")
__device__ __forceinline__ float bf_lo(unsigned u) { return __uint_as_float(u << 16); }
__device__ __forceinline__ float bf_hi(unsigned u) { return __uint_as_float(u & 0xffff0000u); }
__device__ __forceinline__ float bf2f(bf16 v) { return __uint_as_float(((unsigned)v) << 16); }
__device__ __forceinline__ bf16 f2bf(float f) { return (bf16)(pkbf(f, 0.f) & 0xffffu); }
__device__ __forceinline__ float wave_sum(float v) {
#pragma unroll
    for (int o = 1; o < 64; o <<= 1) v += __shfl_xor(v, o);
    return v;
}
__device__ __forceinline__ float wave_max(float v) {
#pragma unroll
    for (int o = 1; o < 64; o <<= 1) v = fmaxf(v, __shfl_xor(v, o));
    return v;
}

struct Params { const float* in[24]; float* out; unsigned char* ws; };
__device__ __forceinline__ unsigned long long karg_u64(int i) { int j = i; asm volatile("" : "+s"(j)); const __attribute__((address_space(4))) unsigned long long* ka = (const __attribute__((address_space(4))) unsigned long long*)__builtin_amdgcn_kernarg_segment_ptr(); return ka[j]; }
#define KIN(i) ((const float*)karg_u64(i))
#define KOUT() ((float*)karg_u64(24))
#define KWS() ((unsigned char*)karg_u64(25))

__device__ __forceinline__ void tr_item(const float* W, int ldw, int ncols, bf16* WT, int Kdst, int k0, int n0, int drow, LAS float* scr, int lane) {
    int n = n0 + (lane & 31); n = n < ncols ? n : ncols - 1;
#pragma unroll 8
    for (int i = 0; i < 32; ++i) { const int kk = 2 * i + (lane >> 5); scr[kk * 33 + (lane & 31)] = W[(size_t)(k0 + kk) * ldw + n]; }
    LDS_WAIT(); asm volatile("" ::: "memory");
    const int c = lane & 7;
#pragma unroll
    for (int j = 0; j < 4; ++j) { const int nn = (lane >> 3) + 8 * j; const LAS float* s = scr + (8 * c) * 33 + nn;
        u32x4 o; o.x = pkbf(s[0 * 33], s[1 * 33]); o.y = pkbf(s[2 * 33], s[3 * 33]); o.z = pkbf(s[4 * 33], s[5 * 33]); o.w = pkbf(s[6 * 33], s[7 * 33]);
        *(u32x4*)(WT + (size_t)(drow + nn) * Kdst + k0 + 8 * c) = o; }
    LDS_WAIT(); asm volatile("" ::: "memory");
}
constexpr int IT_GU = 16 * 88, IT_D = 44 * 32, IT_IN = 16 * 97, IT_OUT = 16 * 32, IT_LAYER = 6 * IT_GU + IT_IN + IT_OUT;
__device__ __forceinline__ void prologue_item(unsigned char* wsb, int it, LAS float* scr, int lane) {
    const int l = it / IT_LAYER; int r = it % IT_LAYER;
    unsigned char* wl = wsb + WS_W + (size_t)l * W_LAYER;
    if (r < 2 * IT_GU) { const int up = r >= IT_GU; r -= up * IT_GU; const int kb = r / 88, nb = r % 88, n0 = 32 * nb;
        tr_item(KIN(up ? 3 : 2) + (size_t)l * D * FF, FF, FF, (bf16*)(wl + OW_GU1), D, 64 * kb, n0, 256 * (n0 >> 7) + (n0 & 127) + 128 * up, scr, lane); return; }
    r -= 2 * IT_GU;
    if (r < IT_D) { const int kb = r / 32, nb = r % 32; tr_item(KIN(4) + (size_t)l * FF * D, D, D, (bf16*)(wl + OW_D1), FF, 64 * kb, 32 * nb, 32 * nb, scr, lane); return; }
    r -= IT_D;
    if (r < IT_IN) { const int kb = r / 97, nb = r % 97; tr_item(KIN(7) + (size_t)l * D * NPROJ, NPROJ, NPROJ, (bf16*)(wl + OW_IN), D, 64 * kb, 32 * nb, 32 * nb, scr, lane); return; }
    r -= IT_IN;
    if (r < IT_OUT) { const int kb = r / 32, nb = r % 32; tr_item(KIN(16) + (size_t)l * D * D, D, D, (bf16*)(wl + OW_OUT), D, 64 * kb, 32 * nb, 32 * nb, scr, lane); return; }
    r -= IT_OUT;
    if (r < 2 * IT_GU) { const int up = r >= IT_GU; r -= up * IT_GU; const int kb = r / 88, nb = r % 88, n0 = 32 * nb;
        tr_item(KIN(up ? 20 : 19) + (size_t)l * D * FF, FF, FF, (bf16*)(wl + OW_GU2), D, 64 * kb, n0, 256 * (n0 >> 7) + (n0 & 127) + 128 * up, scr, lane); return; }
    r -= 2 * IT_GU;
    { const int kb = r / 32, nb = r % 32; tr_item(KIN(21) + (size_t)l * FF * D, D, D, (bf16*)(wl + OW_D2), FF, 64 * kb, 32 * nb, 32 * nb, scr, lane); }
}
__device__ __forceinline__ void row_to_bf16(const float* xrow, bf16* orow, int lane) {
    const f32x4* xr = (const f32x4*)xrow + lane; u32x2* o8 = (u32x2*)orow + lane;
#pragma unroll
    for (int j = 0; j < 4; ++j) { const f32x4 v = xr[64 * j]; u32x2 w; w.x = pkbf(v[0], v[1]); w.y = pkbf(v[2], v[3]); o8[64 * j] = w; }
}
__device__ __forceinline__ void ln_row(float* xrow, bf16* orow, const float* g, const float* b, int lane) {
    f32x4* xr = (f32x4*)xrow + lane; f32x4 v[4]; float s = 0.f;
#pragma unroll
    for (int j = 0; j < 4; ++j) { v[j] = xr[64 * j]; s += (v[j][0] + v[j][1]) + (v[j][2] + v[j][3]); }
    const float mean = wave_sum(s) * (1.f / D); float s2 = 0.f;
#pragma unroll
    for (int j = 0; j < 4; ++j) { v[j] = v[j] - mean; s2 += (v[j][0] * v[j][0] + v[j][1] * v[j][1]) + (v[j][2] * v[j][2] + v[j][3] * v[j][3]); }
    const float rstd = 1.f / sqrtf(wave_sum(s2) * (1.f / D) + LN_EPS);
    u32x2* o8 = (u32x2*)orow + lane;
#pragma unroll
    for (int j = 0; j < 4; ++j) { const f32x4 gv = ((const f32x4*)g)[lane + 64 * j], bv = ((const f32x4*)b)[lane + 64 * j];
        const f32x4 o = v[j] * rstd * gv + bv; xr[64 * j] = o; u32x2 w; w.x = pkbf(o[0], o[1]); w.y = pkbf(o[2], o[3]); o8[64 * j] = w; }
}

__device__ __forceinline__ void seq_of_row(int m, int& s0, int& T) { if (m < MPROMPT) { s0 = m & ~2047; T = 2048; } else { s0 = MPROMPT + ((m - MPROMPT) & ~4095); T = 4096; } }
__device__ __forceinline__ void conv8(const bf16* raw, int m, int tl, int T, int c0, const float* cw, const float* cb, float (&o)[8]) {
    const f32x4 b0 = *(const f32x4*)(cb + c0), b1 = *(const f32x4*)(cb + c0 + 4);
    float a[8] = {b0[0], b0[1], b0[2], b0[3], b1[0], b1[1], b1[2], b1[3]};
#pragma unroll
    for (int j = 0; j < 5; ++j) { const int tt = tl + j - 2;
        if (tt >= 0 && tt < T) { const u32x4 v = *(const u32x4*)(raw + (size_t)(m + j - 2) * 1024 + c0);
            const f32x4 w0 = *(const f32x4*)(cw + j * 1024 + c0), w1 = *(const f32x4*)(cw + j * 1024 + c0 + 4);
            a[0] += bf_lo(v.x) * w0[0]; a[1] += bf_hi(v.x) * w0[1]; a[2] += bf_lo(v.y) * w0[2]; a[3] += bf_hi(v.y) * w0[3];
            a[4] += bf_lo(v.z) * w1[0]; a[5] += bf_hi(v.z) * w1[1]; a[6] += bf_lo(v.w) * w1[2]; a[7] += bf_hi(v.w) * w1[3]; } }
#pragma unroll
    for (int e = 0; e < 8; ++e) o[e] = silu_f(a[e]);
}
__device__ __forceinline__ float softplus_f(float x) { return x > 20.f ? x : log1pf(expf(x)); }

constexpr int SCAN_DIR_F = 10368;
__device__ __forceinline__ void scan_naive_unit(int b, int h, const bf16* raw, const float* DT, float* Y, const float* cw, const float* cb, const float* dt_bias, const float* a_log, const float* d_skip, LAS float* L, int tid, int wave, int lane) {
    int s0, T; if (b < 32) { s0 = b * 2048; T = 2048; } else { s0 = MPROMPT + (b - 32) * 4096; T = 4096; }
    const int g = h >> 2, dir = wave >> 2, pb = wave & 3, p = pb * 16 + (lane & 15), nq = lane >> 4;
    const float a = -expf(a_log[dir * 8 + h]), dskip = d_skip[h], dtb = dt_bias[dir * 8 + h];
    float s[32];
#pragma unroll
    for (int k = 0; k < 32; ++k) s[k] = 0.f;
    LAS float* Lw = L + dir * SCAN_DIR_F;
    const int nblk = T >> 5;
    for (int blk = 0; blk < nblk; ++blk) {
        __syncthreads();
        const int tbase = dir == 0 ? 32 * blk : T - 32 * (blk + 1);
        { const int r_ = tid & 255, tok = r_ >> 3, part = r_ & 7, tl = tbase + tok, m = s0 + tl; float o[8];
          conv8(raw, m, tl, T, 512 + 128 * g + 16 * part, cw, cb, o);
#pragma unroll
          for (int e = 0; e < 8; ++e) Lw[tok * 128 + 16 * part + e] = o[e];
          conv8(raw, m, tl, T, 512 + 128 * g + 16 * part + 8, cw, cb, o);
#pragma unroll
          for (int e = 0; e < 8; ++e) Lw[tok * 128 + 16 * part + 8 + e] = o[e];
          conv8(raw, m, tl, T, 768 + 128 * g + 16 * part, cw, cb, o);
#pragma unroll
          for (int e = 0; e < 8; ++e) Lw[4096 + tok * 128 + 16 * part + e] = o[e];
          conv8(raw, m, tl, T, 768 + 128 * g + 16 * part + 8, cw, cb, o);
#pragma unroll
          for (int e = 0; e < 8; ++e) Lw[4096 + tok * 128 + 16 * part + 8 + e] = o[e];
          conv8(raw, m, tl, T, h * 64 + 8 * part, cw, cb, o);
#pragma unroll
          for (int e = 0; e < 8; ++e) Lw[8192 + tok * 64 + 8 * part + e] = o[e];
          if (part == 0) { const float dtv = softplus_f(DT[(size_t)m * 16 + dir * 8 + h] + dtb); Lw[10240 + tok] = dtv; Lw[10272 + tok] = expf(dtv * a); }
        }
        __syncthreads();
        for (int i = 0; i < 32; ++i) {
            const int ti = dir == 0 ? i : 31 - i;
            const float d = Lw[10272 + ti], dtv = Lw[10240 + ti], xv = Lw[8192 + ti * 64 + p], xdt = xv * dtv;
            float y = 0.f;
#pragma unroll
            for (int k4 = 0; k4 < 8; ++k4) { const f32x4 bv = *(const LAS f32x4*)(Lw + ti * 128 + 32 * nq + 4 * k4), cv = *(const LAS f32x4*)(Lw + 4096 + ti * 128 + 32 * nq + 4 * k4);
#pragma unroll
                for (int e = 0; e < 4; ++e) { s[4 * k4 + e] = s[4 * k4 + e] * d + xdt * bv[e]; y += s[4 * k4 + e] * cv[e]; } }
            y += __shfl_xor(y, 16); y += __shfl_xor(y, 32);
            if (nq == 0) atomicAdd(Y + (size_t)(s0 + tbase + ti) * 512 + h * 64 + p, y + (dir == 0 ? dskip * xv : 0.f));
        }
    }
}

__device__ __forceinline__ void attn_naive_unit(int m, int wave, int lane, const bf16* QKV, const float* rpb, const float* gattn, bf16* MIX, LAS float* Ps, volatile LAS float* exch, int parity) {
    const int h = wave; int s0, T; seq_of_row(m, s0, T);
    const int tl = m - s0, r = tl >> 6, qc = tl & 63, rows = T >> 6;
    const int cstart = min(max(qc - 8, 0), 48), rs = min(max(r - 4, 0), rows - 8);
    float q[64];
    { const bf16* qp = QKV + (size_t)m * 1536 + h * 64;
#pragma unroll
      for (int i = 0; i < 8; ++i) { const u32x4 v = *(const u32x4*)(qp + 8 * i); q[8 * i] = bf_lo(v.x); q[8 * i + 1] = bf_hi(v.x); q[8 * i + 2] = bf_lo(v.y); q[8 * i + 3] = bf_hi(v.y);
          q[8 * i + 4] = bf_lo(v.z); q[8 * i + 5] = bf_hi(v.z); q[8 * i + 6] = bf_lo(v.w); q[8 * i + 7] = bf_hi(v.w); } }
    float sc[2];
#pragma unroll
    for (int k2 = 0; k2 < 2; ++k2) { const int kk = lane + 64 * k2, kri = kk >> 4, kci = kk & 15; const int kt = s0 + (rs + kri) * 64 + cstart + kci;
        const bf16* kp = QKV + (size_t)kt * 1536 + 512 + h * 64; float d = 0.f;
#pragma unroll
        for (int i = 0; i < 8; ++i) { const u32x4 v = *(const u32x4*)(kp + 8 * i);
            d += q[8 * i] * bf_lo(v.x) + q[8 * i + 1] * bf_hi(v.x) + q[8 * i + 2] * bf_lo(v.y) + q[8 * i + 3] * bf_hi(v.y) + q[8 * i + 4] * bf_lo(v.z) + q[8 * i + 5] * bf_hi(v.z) + q[8 * i + 6] * bf_lo(v.w) + q[8 * i + 7] * bf_hi(v.w); }
        sc[k2] = d + rpb[h * 465 + (rs + kri - r + 7) * 31 + (cstart + kci - qc + 15)]; }
    const float mx = wave_max(fmaxf(sc[0], sc[1]));
    const float p0 = __expf(sc[0] - mx), p1 = __expf(sc[1] - mx);
    const float inv = 1.f / wave_sum(p0 + p1);
    Ps[lane] = p0 * inv; Ps[lane + 64] = p1 * inv;
    LDS_WAIT(); asm volatile("" ::: "memory");
    float o = 0.f; const bf16* vbase = QKV + 1024 + h * 64 + lane;
#pragma unroll 4
    for (int kk = 0; kk < 128; kk += 4) { const f32x4 pv = *(const LAS f32x4*)(Ps + kk); const int kt = s0 + (rs + (kk >> 4)) * 64 + cstart + (kk & 15);
#pragma unroll
        for (int e = 0; e < 4; ++e) o += pv[e] * bf2f(vbase[(size_t)(kt + e) * 1536]); }
    const float ssq = wave_sum(o * o);
    if (lane == 0) exch[parity * 8 + h] = ssq;
    __syncthreads();
    float tot = 0.f;
#pragma unroll
    for (int i = 0; i < 8; ++i) tot += exch[parity * 8 + i];
    const float scl = 1.f / sqrtf(tot * (1.f / 512.f) + RMS_EPS);
    MIX[(size_t)m * 1024 + h * 64 + lane] = f2bf(o * scl * gattn[h * 64 + lane]);
}

__device__ __forceinline__ void gate_norm_row(int m, int lane, const float* Y, const bf16* Z, const float* g, bf16* MIX) {
    const f32x4 y0 = *(const f32x4*)(Y + (size_t)m * 512 + 8 * lane), y1 = *(const f32x4*)(Y + (size_t)m * 512 + 8 * lane + 4);
    const u32x4 zv = *(const u32x4*)(Z + (size_t)m * 512 + 8 * lane);
    float v[8] = {y0[0] * silu_f(bf_lo(zv.x)), y0[1] * silu_f(bf_hi(zv.x)), y0[2] * silu_f(bf_lo(zv.y)), y0[3] * silu_f(bf_hi(zv.y)),
                  y1[0] * silu_f(bf_lo(zv.z)), y1[1] * silu_f(bf_hi(zv.z)), y1[2] * silu_f(bf_lo(zv.w)), y1[3] * silu_f(bf_hi(zv.w))};
    float ss = 0.f;
#pragma unroll
    for (int e = 0; e < 8; ++e) ss += v[e] * v[e];
    const float scl = 1.f / sqrtf(wave_sum(ss) * (1.f / 512.f) + RMS_EPS);
    const f32x4 g0 = *(const f32x4*)(g + 8 * lane), g1 = *(const f32x4*)(g + 8 * lane + 4);
    u32x4 w; w.x = pkbf(v[0] * scl * g0[0], v[1] * scl * g0[1]); w.y = pkbf(v[2] * scl * g0[2], v[3] * scl * g0[3]);
    w.z = pkbf(v[4] * scl * g1[0], v[5] * scl * g1[1]); w.w = pkbf(v[6] * scl * g1[2], v[7] * scl * g1[3]);
    *(u32x4*)(MIX + (size_t)m * 1024 + 512 + 8 * lane) = w;
}

__global__ void __launch_bounds__(NT, 2) fwd_mega(Params P) {
    extern __shared__ __attribute__((aligned(16))) unsigned char lds_raw[];
    LAS unsigned char* lds = (LAS unsigned char*)lds_raw;
    cg::grid_group grid = cg::this_grid();
    const int G = gridDim.x, bx = blockIdx.x, NGW = G * NWAVES;
#define FRESH_IDS() int tid = threadIdx.x; asm volatile("" : "+v"(tid)); const int lane = tid & 63, wave = __builtin_amdgcn_readfirstlane(tid >> 6), gw = bx * NWAVES + wave; (void)gw; (void)lane
    unsigned char* ws = KWS();
    bf16* XB = (bf16*)(ws + WS_XB); bf16* Hb = (bf16*)(ws + WS_H); bf16* QKV = (bf16*)(ws + WS_QKV); bf16* Zb = (bf16*)(ws + WS_Z); bf16* RAW = (bf16*)(ws + WS_RAW);
    float* Yb = (float*)(ws + WS_Y); float* DTb = (float*)(ws + WS_DT); float* out = KOUT();

    { FRESH_IDS(); LAS float* scr = (LAS float*)(lds + wave * 16384);
      for (int it = gw; it < 2 * IT_LAYER; it += NGW) prologue_item(ws, it, scr, lane);
      for (int m = gw; m < M; m += NGW) { const float* src = m < MPROMPT ? KIN(0) + (size_t)m * D : KIN(1) + (size_t)(m - MPROMPT) * D; row_to_bf16(src, XB + (size_t)m * D, lane); } }
    grid.sync();

    for (int l = 0; l < 2; ++l) {
        unsigned char* wl = ws + WS_W + (size_t)l * W_LAYER;
        { pg8::Gemm g{XB, (const bf16*)(wl + OW_GU1), M, NGU, D}; pg8::StaticOrder S; S.init(M, NGU, G, bx); pg8::EpiSwiGLU E{Hb, FF};
          pg8::gemm_phase<pg8::EpiSwiGLU, pg8::StaticOrder, true, true>(lds, g, S, E); }
        grid.sync();
        { pg8::Gemm g{Hb, (const bf16*)(wl + OW_D1), M, D, FF}; pg8::StaticOrder S; S.init(M, D, G, bx);
          pg8::EpiResid E{l == 0 ? KIN(0) : out, l == 0 ? KIN(1) - (size_t)MPROMPT * D : out, out, 0.5f};
          pg8::gemm_phase<pg8::EpiResid, pg8::StaticOrder, true, true>(lds, g, S, E); }
        grid.sync();
        { FRESH_IDS(); const float* g_ = KIN(5) + l * D; const float* b_ = KIN(6) + l * D;
          for (int m = gw; m < M; m += NGW) ln_row(out + (size_t)m * D, XB + (size_t)m * D, g_, b_, lane);
          f32x4* yz = (f32x4*)Yb; const f32x4 z4 = {0.f, 0.f, 0.f, 0.f};
          for (size_t i = (size_t)bx * NT + tid; i < (size_t)M * 512 / 4; i += (size_t)G * NT) yz[i] = z4; }
        grid.sync();
        { pg8::Gemm g{XB, (const bf16*)(wl + OW_IN), M, NIN, D}; pg8::StaticOrder S; S.init(M, NIN, G, bx); pg8::EpiProj E{QKV, Zb, RAW, DTb};
          pg8::gemm_phase<pg8::EpiProj, pg8::StaticOrder, true, true>(lds, g, S, E); }
        grid.sync();
        { FRESH_IDS(); const float* cw = KIN(8) + (size_t)l * 5 * 1024; const float* cb = KIN(9) + l * 1024;
          for (int u = bx; u < 36 * 8; u += G) { const int uu = (u + 32 * 8) % (36 * 8);
              scan_naive_unit(uu >> 3, uu & 7, RAW, DTb, Yb, cw, cb, KIN(10) + l * 16, KIN(11) + l * 16, KIN(12) + l * 8, (LAS float*)lds, tid, wave, lane); }
          __syncthreads();
          LAS float* Ps = (LAS float*)lds + wave * 128; volatile LAS float* exch = (volatile LAS float*)((LAS float*)lds + 1024);
          int par = 0;
          for (int m = bx; m < M; m += G) { attn_naive_unit(m, wave, lane, QKV, KIN(15) + (size_t)l * 8 * 465, KIN(14) + l * 512, XB, Ps, exch, par); par ^= 1; } }
        grid.sync();
        { FRESH_IDS(); for (int m = gw; m < M; m += NGW) gate_norm_row(m, lane, Yb, Zb, KIN(13) + l * 512, XB); }
        grid.sync();
        { pg8::Gemm g{XB, (const bf16*)(wl + OW_OUT), M, D, D}; pg8::StaticOrder S; S.init(M, D, G, bx); pg8::EpiResid E{out, out, out, 1.0f};
          pg8::gemm_phase<pg8::EpiResid, pg8::StaticOrder, true, true>(lds, g, S, E); }
        grid.sync();
        { FRESH_IDS(); const float* g_ = KIN(17) + l * D; const float* b_ = KIN(18) + l * D;
          for (int m = gw; m < M; m += NGW) ln_row(out + (size_t)m * D, XB + (size_t)m * D, g_, b_, lane); }
        grid.sync();
        { pg8::Gemm g{XB, (const bf16*)(wl + OW_GU2), M, NGU, D}; pg8::StaticOrder S; S.init(M, NGU, G, bx); pg8::EpiSwiGLU E{Hb, FF};
          pg8::gemm_phase<pg8::EpiSwiGLU, pg8::StaticOrder, true, true>(lds, g, S, E); }
        grid.sync();
        { pg8::Gemm g{Hb, (const bf16*)(wl + OW_D2), M, D, FF}; pg8::StaticOrder S; S.init(M, D, G, bx); pg8::EpiResid E{out, out, out, 0.5f};
          pg8::gemm_phase<pg8::EpiResid, pg8::StaticOrder, true, true>(lds, g, S, E); }
        grid.sync();
        { FRESH_IDS(); const float* g_ = KIN(22) + l * D; const float* b_ = KIN(23) + l * D;
          for (int m = gw; m < M; m += NGW) ln_row(out + (size_t)m * D, XB + (size_t)m * D, g_, b_, lane); }
        if (l == 0) grid.sync();
    }
}

extern "C" void kernel_launch(void* const* d_in, const int* in_sizes, int n_in, void* d_out, int out_size, void* d_ws, size_t ws_size, hipStream_t stream) {
    static int grid_blocks = 0;
    if (grid_blocks == 0) {
        if (n_in != 24 || out_size != M * D || ws_size < WS_END) { fprintf(stderr, "kernel_launch: unexpected shapes (n_in %d out %d ws %zu)\n", n_in, out_size, ws_size); grid_blocks = -1; return; }
        int dev = 0, cus = 0, per_cu = 0;
        (void)hipGetDevice(&dev); (void)hipDeviceGetAttribute(&cus, hipDeviceAttributeMultiprocessorCount, dev);
        if (hipFuncSetAttribute((const void*)fwd_mega, hipFuncAttributeMaxDynamicSharedMemorySize, LDS_BYTES) != hipSuccess) { fprintf(stderr, "kernel_launch: hipFuncSetAttribute failed\n"); grid_blocks = -1; return; }
        if (hipOccupancyMaxActiveBlocksPerMultiprocessor(&per_cu, (const void*)fwd_mega, NT, LDS_BYTES) != hipSuccess || per_cu < 1) { fprintf(stderr, "kernel_launch: occupancy query gave %d\n", per_cu); per_cu = 1; }
        (void)hipGetLastError();
        grid_blocks = cus * per_cu;
    }
    if (grid_blocks < 0) return;
    Params p{};
    for (int i = 0; i < 24; ++i) p.in[i] = (const float*)d_in[i];
    p.out = (float*)d_out; p.ws = (unsigned char*)d_ws;
    void* args[] = {&p};
    hipError_t e = hipLaunchCooperativeKernel((const void*)fwd_mega, dim3(grid_blocks), dim3(NT), args, LDS_BYTES, stream);
    if (e != hipSuccess) fprintf(stderr, "cooperative launch failed: %s (grid %d)\n", hipGetErrorString(e), grid_blocks);
}
```

```cpp
#include <hip/hip_runtime.h>
#include <hip/hip_cooperative_groups.h>
#include <cstdio>
#include <cstdint>
namespace cg = cooperative_groups;
namespace pg8 {
#define PG8_LAS __attribute__((address_space(3)))
typedef unsigned short bf16_t;
typedef short bf16x8 __attribute__((ext_vector_type(8)));
typedef float f32x4 __attribute__((ext_vector_type(4)));
typedef unsigned u32x4 __attribute__((ext_vector_type(4)));
constexpr int BM = 256, BK = 64, HALF = 128, HTB = HALF * BK * 2  , STAGE_BYTES = 8 * HTB, NXCD = 8, WGM = 8;

__host__ __device__ __forceinline__ int lds_byte(int r, int c) { const int st = (r >> 4) * 2 + (c >> 5), rr = r & 15, cc = c & 31, ob = rr * 64 + cc * 2; return st * 1024 + (ob ^ (((ob >> 9) & 1) << 5)); }
__host__ __device__ __forceinline__ void stage_rc(int b, int& R, int& C) { const int st = b / 1024, sb = b % 1024, swz = sb ^ (((sb >> 9) & 1) << 5); R = (st >> 1) * 16 + swz / 64; C = (st & 1) * 32 + (swz % 64) / 2; }
__host__ __device__ __forceinline__ int perm32(int rho) { const int n = rho >> 4, i = rho & 15; return 8 * (i >> 2) + 4 * n + (i & 3); }

struct Unit { int pm, pn; };
struct Gemm { const bf16_t* A; const bf16_t* Bt; int M, N, K; };

struct StaticOrder {
    int nM, nN, nwg, G, c;
    __host__ __device__ void init(int M, int N, int G_, int c_) { nM = M / BM; nN = N / BM; nwg = nM * nN; G = G_; c = c_; }
    __host__ __device__ bool next(int i, Unit& u) const {
        const long L = (long)i * G + c; if (L >= nwg) return false;
        int wgid = (int)L; { const int q = nwg / NXCD, r = nwg % NXCD, xcd = wgid % NXCD, off = wgid / NXCD; wgid = (xcd < r ? xcd * (q + 1) : r * (q + 1) + (xcd - r) * q) + off; }
        const int nig = WGM * nN, gid = wgid / nig, fm = gid * WGM, gsz = (nM - fm) < WGM ? (nM - fm) : WGM;
        u.pm = fm + ((wgid % nig) % gsz); u.pn = (wgid % nig) / gsz; return true;
    }
    __device__ __forceinline__ void a_ready(const Unit&) const {}
    __device__ __forceinline__ void done(const Unit&) const {}
};

typedef float f32x2e __attribute__((ext_vector_type(2)));
typedef __bf16 bf16x2e __attribute__((ext_vector_type(2)));
__device__ __forceinline__ unsigned pkbf(float a, float b) { f32x2e v = {a, b}; bf16x2e r = __builtin_convertvector(v, bf16x2e); return __builtin_bit_cast(unsigned, r); }
__device__ __forceinline__ float silu_f(float g) { return g * __builtin_amdgcn_rcpf(1.f + __builtin_amdgcn_exp2f(-1.4426950408889634f * g)); }
constexpr float ALPHA_F = 1.4142135623730951f;
constexpr int MPROMPT = 65536;

struct EpiSwiGLU {
    static constexpr bool PERM = true, AFTER_DRAIN = false, MID = false;
    bf16_t* H; int ldh;
    __device__ __forceinline__ void operator()(const f32x4 (&acc)[2][2][4][2], const Unit& u, int wr, int wc, int fr, int fq) const {
        const int row0 = u.pm * BM + wr * 64 + fr, col0 = u.pn * HALF + wc * 32 + 8 * fq;
#pragma unroll
        for (int ai = 0; ai < 2; ++ai)
#pragma unroll
            for (int m = 0; m < 4; ++m) {
                bf16_t* p = H + (size_t)(row0 + ai * HALF + m * 16) * ldh + col0;
                const f32x4 g0 = acc[ai][0][m][0], g1 = acc[ai][0][m][1], u0 = acc[ai][1][m][0], u1 = acc[ai][1][m][1];
                u32x4 w;
                w.x = pkbf(silu_f(g0[0]) * u0[0], silu_f(g0[1]) * u0[1]); w.y = pkbf(silu_f(g0[2]) * u0[2], silu_f(g0[3]) * u0[3]);
                w.z = pkbf(silu_f(g1[0]) * u1[0], silu_f(g1[1]) * u1[1]); w.w = pkbf(silu_f(g1[2]) * u1[2], silu_f(g1[3]) * u1[3]);
                *(u32x4*)p = w;
            }
    }
};
struct EpiResid {
    static constexpr bool PERM = false, AFTER_DRAIN = false, MID = false;
    const float* r0; const float* r1; float* out; float scale;
    __device__ __forceinline__ void operator()(const f32x4 (&acc)[2][2][4][2], const Unit& u, int wr, int wc, int fr, int fq) const {
        const float* rbase = (u.pm * BM < MPROMPT) ? r0 : r1;
#pragma unroll
        for (int ai = 0; ai < 2; ++ai)
#pragma unroll
            for (int m = 0; m < 4; ++m) {
                const size_t roff = (size_t)(u.pm * BM + ai * HALF + wr * 64 + m * 16 + fr) * 1024;
#pragma unroll
                for (int bj = 0; bj < 2; ++bj)
#pragma unroll
                    for (int n = 0; n < 2; ++n) {
                        const int c = u.pn * BM + bj * HALF + wc * 32 + n * 16 + 4 * fq;
                        const f32x4 b = *(const f32x4*)(rbase + roff + c);
                        *(f32x4*)(out + roff + c) = b * ALPHA_F + acc[ai][bj][m][n] * scale;
                    }
            }
    }
};
struct EpiResidMix {
    static constexpr bool PERM = false, AFTER_DRAIN = false, MID = true;
    const float* resid; float* out; const float* ssq_a; const float* ssq_s;
    __device__ __forceinline__ void mid(f32x4 (&acc)[2][2][4][2], const Unit& u, int wr, int wc, int fr, int fq) const {
#pragma unroll
        for (int ai = 0; ai < 2; ++ai)
#pragma unroll
            for (int m = 0; m < 4; ++m) { const int r = u.pm * BM + ai * HALF + wr * 64 + m * 16 + fr;
                float f = 1.f / sqrtf(ssq_a[r] * (1.f / 512.f) + 1e-6f); if (ssq_s) f *= sqrtf(ssq_s[r] * (1.f / 512.f) + 1e-6f);
#pragma unroll
                for (int bj = 0; bj < 2; ++bj)
#pragma unroll
                    for (int n = 0; n < 2; ++n) acc[ai][bj][m][n] = acc[ai][bj][m][n] * f; }
    }
    __device__ __forceinline__ void operator()(const f32x4 (&acc)[2][2][4][2], const Unit& u, int wr, int wc, int fr, int fq) const {
#pragma unroll
        for (int ai = 0; ai < 2; ++ai)
#pragma unroll
            for (int m = 0; m < 4; ++m) { const int r = u.pm * BM + ai * HALF + wr * 64 + m * 16 + fr; const size_t roff = (size_t)r * 1024;
                const float f = ssq_s ? 1.f / sqrtf(ssq_s[r] * (1.f / 512.f) + 1e-6f) : 1.f;
#pragma unroll
                for (int bj = 0; bj < 2; ++bj)
#pragma unroll
                    for (int n = 0; n < 2; ++n) { const int c = u.pn * BM + bj * HALF + wc * 32 + n * 16 + 4 * fq;
                        const f32x4 b = *(const f32x4*)(resid + roff + c);
                        *(f32x4*)(out + roff + c) = b * ALPHA_F + acc[ai][bj][m][n] * f; } }
    }
};
struct EpiProj {
    static constexpr bool PERM = true, AFTER_DRAIN = false, MID = false;
    bf16_t* QKV; bf16_t* Z; bf16_t* XBC; float* DT;
    __device__ __forceinline__ void operator()(const f32x4 (&acc)[2][2][4][2], const Unit& u, int wr, int wc, int fr, int fq) const {
        const int row0 = u.pm * BM + wr * 64 + fr, pn = u.pn;
        if (pn == 12) {
            if (wc == 0 && fq < 2) {
#pragma unroll
                for (int ai = 0; ai < 2; ++ai)
#pragma unroll
                    for (int m = 0; m < 4; ++m) { float* p = DT + (size_t)(row0 + ai * HALF + m * 16) * 16 + 8 * fq;
                        *(f32x4*)p = acc[ai][0][m][0]; *(f32x4*)(p + 4) = acc[ai][0][m][1]; }
            }
            return;
        }
        bf16_t* base; int ldc, colt; float sc = 1.f;
        if (pn < 6) { base = QKV; ldc = 1536; colt = pn * 256; if (pn < 2) sc = 0.125f * 1.4426950408889634f; }
        else if (pn < 8) { base = Z; ldc = 512; colt = (pn - 6) * 256; }
        else { base = XBC; ldc = 1024; colt = (pn - 8) * 256; }
        const int col0 = colt + wc * 32 + 8 * fq;
#pragma unroll
        for (int ai = 0; ai < 2; ++ai)
#pragma unroll
            for (int m = 0; m < 4; ++m) { bf16_t* rowp = base + (size_t)(row0 + ai * HALF + m * 16) * ldc + col0;
#pragma unroll
                for (int bj = 0; bj < 2; ++bj) { const f32x4 v0 = acc[ai][bj][m][0] * sc, v1 = acc[ai][bj][m][1] * sc;
                    u32x4 w; w.x = pkbf(v0[0], v0[1]); w.y = pkbf(v0[2], v0[3]); w.z = pkbf(v1[0], v1[1]); w.w = pkbf(v1[2], v1[3]);
                    *(u32x4*)(rowp + bj * HALF) = w; } }
    }
};

template <class Epi, class Sched, bool ALIGN_EPI = false, bool SP2 = false>
__device__ __forceinline__ void gemm_phase(PG8_LAS unsigned char* lds, const Gemm g, const Sched& S, const Epi& E) {
    int tid_ = threadIdx.x; asm volatile("" : "+v"(tid_));
    const int tid = tid_, wid = __builtin_amdgcn_readfirstlane(tid >> 6), lane = tid & 63, wr = wid >> 2, wc = wid & 3, fr = lane & 15, fq = lane >> 4;
    const int K = g.K, nt = K / BK;
    unsigned voffA[2], voffB[2];
#pragma unroll
    for (int i = 0; i < 2; ++i) { int R, C; stage_rc(tid * 16 + i * 8192, R, C); const int Rb = Epi::PERM ? ((R & ~31) + perm32(R & 31)) : R;
        voffA[i] = (unsigned)(R * K + C) * 2u; voffB[i] = (unsigned)(Rb * K + C) * 2u; }
    const size_t kstep = (size_t)(BK * 2);
    const size_t hstep = (size_t)HALF * K * 2;
    const size_t tstep = 2 * hstep;
    const unsigned ldsw = (unsigned)wid * 1024u;
    const int aoff = lds_byte(wr * 64 + fr, fq * 8), boff = lds_byte(wc * 32 + fr, fq * 8);
#define PG8_SA(b, h) (((b) * 2 + (h)) * HTB)
#define PG8_SB(b, h) ((4 + (b) * 2 + (h)) * HTB)
#define PG8_STAGE(bufoff, gbase, voff) do { _Pragma("unroll") for (int _i = 0; _i < 2; ++_i) \
        __builtin_amdgcn_global_load_lds((const unsigned*)((const char*)(gbase) + (voff)[_i]), (PG8_LAS unsigned*)(lds + (bufoff) + ldsw + _i * 8192), 16, 0, 0); } while (0)
#define PG8_LDA(dst, b, h) do { _Pragma("unroll") for (int m = 0; m < 4; ++m) _Pragma("unroll") for (int k = 0; k < 2; ++k) dst[m][k] = *(const PG8_LAS bf16x8*)(lds + PG8_SA(b, h) + aoff + m * 2048 + k * 1024); } while (0)
#define PG8_LDB(dst, b, h) do { _Pragma("unroll") for (int n = 0; n < 2; ++n) _Pragma("unroll") for (int k = 0; k < 2; ++k) dst[n][k] = *(const PG8_LAS bf16x8*)(lds + PG8_SB(b, h) + boff + n * 2048 + k * 1024); } while (0)
#define PG8_MMA(ai, bj, At, Bt) do { __builtin_amdgcn_s_setprio(1); _Pragma("unroll") for (int m = 0; m < 4; ++m) _Pragma("unroll") for (int n = 0; n < 2; ++n) _Pragma("unroll") for (int k = 0; k < 2; ++k) \
        acc[ai][bj][m][n] = __builtin_amdgcn_mfma_f32_16x16x32_bf16(Bt[n][k], At[m][k], acc[ai][bj][m][n], 0, 0, 0); __builtin_amdgcn_s_setprio(0); } while (0)
#define PG8_WAIT_V(n) asm volatile("s_waitcnt vmcnt(" #n ")" ::: "memory")
#define PG8_WAIT_L(n) asm volatile("s_waitcnt lgkmcnt(" #n ")" ::: "memory")
#define PG8_BAR __builtin_amdgcn_s_barrier()
#define PG8_SCHED __builtin_amdgcn_sched_barrier(0)
    Unit cur, nxt; int ui = 0;
    if (!S.next(0, cur)) return;
    f32x4 acc[2][2][4][2];
#pragma unroll
    for (int a = 0; a < 2; ++a)
#pragma unroll
        for (int b = 0; b < 2; ++b)
#pragma unroll
            for (int m = 0; m < 4; ++m)
#pragma unroll
                for (int n = 0; n < 2; ++n) acc[a][b][m][n] = (f32x4){0.f, 0.f, 0.f, 0.f};
    bf16x8 At[4][2], B0[2][2], B1[2][2];
    const char* cA = (const char*)g.A + (size_t)cur.pm * tstep; const char* cB = (const char*)g.Bt + (size_t)cur.pn * tstep;
    S.a_ready(cur);
    if constexpr (SP2) {
        PG8_STAGE(PG8_SB(0, 0), cB, voffB); PG8_STAGE(PG8_SB(0, 1), cB + hstep, voffB); PG8_STAGE(PG8_SA(0, 0), cA, voffA); PG8_STAGE(PG8_SA(0, 1), cA + hstep, voffA);
        if (wr == 1) PG8_BAR;
        PG8_WAIT_V(2); PG8_BAR;
        PG8_STAGE(PG8_SB(1, 0), cB + kstep, voffB); PG8_STAGE(PG8_SA(1, 0), cA + kstep, voffA); PG8_STAGE(PG8_SB(1, 1), cB + hstep + kstep, voffB);
        PG8_WAIT_V(6); PG8_BAR;
    } else {
        PG8_STAGE(PG8_SB(0, 0), cB, voffB); PG8_STAGE(PG8_SA(0, 0), cA, voffA); PG8_STAGE(PG8_SB(0, 1), cB + hstep, voffB); PG8_STAGE(PG8_SA(0, 1), cA + hstep, voffA);
        if (wr == 1) PG8_BAR;
        PG8_WAIT_V(4); PG8_BAR;
        PG8_STAGE(PG8_SB(1, 0), cB + kstep, voffB); PG8_STAGE(PG8_SA(1, 0), cA + kstep, voffA); PG8_STAGE(PG8_SB(1, 1), cB + hstep + kstep, voffB);
        PG8_WAIT_V(6); PG8_BAR;
    }
    for (;;) {
        const bool has_next = S.next(ui + 1, nxt);
        const char* nA = has_next ? (const char*)g.A + (size_t)nxt.pm * tstep : cA; const char* nB = has_next ? (const char*)g.Bt + (size_t)nxt.pn * tstep : cB;
        for (int t = 0; t < nt; t += 2) {
            if constexpr (Epi::MID) { if (t == (nt >> 1)) E.mid(acc, cur, wr, wc, fr, fq); }
            const bool last = (t == nt - 2);
            const char* a1 = cA + (size_t)(t + 1) * kstep;
            const char* a2 = last ? nA : cA + (size_t)(t + 2) * kstep; const char* b2 = last ? nB : cB + (size_t)(t + 2) * kstep;
            const char* a3 = a2 + kstep; const char* b3 = b2 + kstep;
            if (last && has_next) S.a_ready(nxt);
            if constexpr (SP2) {
            PG8_LDB(B0, 0, 0); PG8_LDB(B1, 0, 1); PG8_SCHED; PG8_LDA(At, 0, 0); PG8_STAGE(PG8_SA(1, 1), a1 + hstep, voffA);
            PG8_WAIT_V(8); PG8_WAIT_L(0); PG8_BAR; PG8_MMA(0, 0, At, B0); PG8_MMA(0, 1, At, B1); PG8_BAR; PG8_SCHED;
            PG8_LDA(At, 0, 1); PG8_STAGE(PG8_SB(0, 0), b2, voffB); PG8_STAGE(PG8_SB(0, 1), b2 + hstep, voffB); PG8_STAGE(PG8_SA(0, 0), a2, voffA);
            PG8_WAIT_V(8); PG8_WAIT_L(0); PG8_BAR; PG8_MMA(1, 0, At, B0); PG8_MMA(1, 1, At, B1); PG8_BAR; PG8_SCHED;
            PG8_LDB(B0, 1, 0); PG8_LDB(B1, 1, 1); PG8_SCHED; PG8_LDA(At, 1, 0); PG8_STAGE(PG8_SA(0, 1), a2 + hstep, voffA);
            PG8_WAIT_V(8); PG8_WAIT_L(0); PG8_BAR; PG8_MMA(0, 0, At, B0); PG8_MMA(0, 1, At, B1); PG8_BAR; PG8_SCHED;
            PG8_LDA(At, 1, 1); PG8_STAGE(PG8_SB(1, 0), b3, voffB); PG8_STAGE(PG8_SB(1, 1), b3 + hstep, voffB); PG8_STAGE(PG8_SA(1, 0), a3, voffA);
            PG8_WAIT_V(8); PG8_WAIT_L(0); PG8_BAR; PG8_MMA(1, 0, At, B0); PG8_MMA(1, 1, At, B1); PG8_BAR; PG8_SCHED;
            } else {
            PG8_LDB(B0, 0, 0); PG8_SCHED; PG8_LDA(At, 0, 0); PG8_STAGE(PG8_SA(1, 1), a1 + hstep, voffA);
            PG8_WAIT_L(8); PG8_BAR; PG8_WAIT_L(0); PG8_MMA(0, 0, At, B0); PG8_BAR; PG8_SCHED;
            PG8_LDB(B1, 0, 1); PG8_STAGE(PG8_SB(0, 0), b2, voffB);
            PG8_BAR; PG8_WAIT_L(0); PG8_MMA(0, 1, At, B1); PG8_BAR;
            PG8_LDA(At, 0, 1); PG8_STAGE(PG8_SA(0, 0), a2, voffA);
            PG8_BAR; PG8_WAIT_L(0); PG8_MMA(1, 0, At, B0); PG8_BAR; PG8_SCHED;
            PG8_STAGE(PG8_SB(0, 1), b2 + hstep, voffB);
            PG8_WAIT_V(6); PG8_BAR; PG8_MMA(1, 1, At, B1); PG8_BAR;
            PG8_LDB(B0, 1, 0); PG8_SCHED; PG8_LDA(At, 1, 0); PG8_STAGE(PG8_SA(0, 1), a2 + hstep, voffA);
            PG8_WAIT_L(8); PG8_BAR; PG8_WAIT_L(0); PG8_MMA(0, 0, At, B0); PG8_BAR; PG8_SCHED;
            PG8_LDB(B1, 1, 1); PG8_STAGE(PG8_SB(1, 0), b3, voffB);
            PG8_BAR; PG8_WAIT_L(0); PG8_MMA(0, 1, At, B1); PG8_BAR;
            PG8_LDA(At, 1, 1); PG8_STAGE(PG8_SA(1, 0), a3, voffA);
            PG8_BAR; PG8_WAIT_L(0); PG8_MMA(1, 0, At, B0); PG8_BAR; PG8_SCHED;
            PG8_STAGE(PG8_SB(1, 1), b3 + hstep, voffB);
            PG8_WAIT_V(6); PG8_BAR; PG8_MMA(1, 1, At, B1); PG8_BAR;
            }
        }
        if constexpr (ALIGN_EPI) { if (wr == 0) PG8_BAR; }
        if constexpr (!Epi::AFTER_DRAIN) { E(acc, cur, wr, wc, fr, fq); S.done(cur); }
        if (!has_next) break;
#pragma unroll
        for (int a = 0; a < 2; ++a)
#pragma unroll
            for (int b = 0; b < 2; ++b)
#pragma unroll
                for (int m = 0; m < 4; ++m)
#pragma unroll
                    for (int n = 0; n < 2; ++n) acc[a][b][m][n] = (f32x4){0.f, 0.f, 0.f, 0.f};
        cur = nxt; cA = nA; cB = nB; ++ui;
        if constexpr (ALIGN_EPI) { if (wr == 1) PG8_BAR; }
    }
    PG8_WAIT_V(0);
    if constexpr (!ALIGN_EPI) { if (wr == 0) PG8_BAR; }
    PG8_BAR;
    if constexpr (Epi::AFTER_DRAIN) { E.fused(acc, cur, wr, wc, fr, fq, lds, wid, lane); S.done(cur); }
#undef PG8_SA
#undef PG8_SB
#undef PG8_STAGE
#undef PG8_LDA
#undef PG8_LDB
#undef PG8_MMA
#undef PG8_WAIT_V
#undef PG8_WAIT_L
#undef PG8_BAR
#undef PG8_SCHED
}
}

#define LAS __attribute__((address_space(3)))
typedef unsigned short bf16;
using pg8::f32x4; using pg8::u32x4; using pg8::pkbf; using pg8::silu_f; using pg8::MPROMPT;
typedef unsigned u32x2 __attribute__((ext_vector_type(2)));
constexpr int NWAVES = 8, NT = 512;
constexpr int M = 81920, D = 1024, FF = 2816, NGU = 5632, NIN = 3328, NPROJ = 3088;
constexpr float LN_EPS = 1e-5f, RMS_EPS = 1e-6f;
constexpr size_t MiB = 1u << 20;
constexpr size_t WS_W = 1 * MiB, W_LAYER = 42 * MiB;
constexpr size_t OW_GU1 = 0, OW_D1 = 11534336, OW_IN = 17301504, OW_OUT = 24117248, OW_GU2 = 26214400, OW_D2 = 37748736;
constexpr size_t WS_XB = 85 * MiB, WS_R = 245 * MiB, WS_QKV = WS_R, WS_Z = WS_R + 240 * MiB, WS_RAW = WS_R + 320 * MiB, WS_H = WS_R;
constexpr size_t WS_Y = 725 * MiB, WS_DT = 885 * MiB, WS_SSQ = 890 * MiB, WS_TB = 891 * MiB, WS_END = 893 * MiB;
constexpr int LDS_BYTES = 155648;

#define LDS_WAIT() asm volatile("s_waitcnt lgkmcnt(0)" ::: "memory")
__device__ __forceinline__ float bf_lo(unsigned u) { return __uint_as_float(u << 16); }
__device__ __forceinline__ float bf_hi(unsigned u) { return __uint_as_float(u & 0xffff0000u); }
__device__ __forceinline__ float bf2f(bf16 v) { return __uint_as_float(((unsigned)v) << 16); }
__device__ __forceinline__ bf16 f2bf(float f) { return (bf16)(pkbf(f, 0.f) & 0xffffu); }
__device__ __forceinline__ float wave_sum(float v) {
#pragma unroll
    for (int o = 1; o < 64; o <<= 1) v += __shfl_xor(v, o);
    return v;
}
__device__ __forceinline__ float wave_max(float v) {
#pragma unroll
    for (int o = 1; o < 64; o <<= 1) v = fmaxf(v, __shfl_xor(v, o));
    return v;
}

struct Params { const float* in[24]; float* out; unsigned char* ws; };
__device__ __forceinline__ unsigned long long karg_u64(int i) { int j = i; asm volatile("" : "+s"(j)); const __attribute__((address_space(4))) unsigned long long* ka = (const __attribute__((address_space(4))) unsigned long long*)__builtin_amdgcn_kernarg_segment_ptr(); return ka[j]; }
#define KIN(i) ((const float*)karg_u64(i))
#define KOUT() ((float*)karg_u64(24))
#define KWS() ((unsigned char*)karg_u64(25))

__device__ __forceinline__ void tr_item(const float* W, int ldw, int ncols, bf16* WT, int Kdst, int k0, int n0, int drow, LAS float* scr, int lane) {
    int n = n0 + (lane & 31); n = n < ncols ? n : ncols - 1;
#pragma unroll 8
    for (int i = 0; i < 32; ++i) { const int kk = 2 * i + (lane >> 5); scr[kk * 33 + (lane & 31)] = W[(size_t)(k0 + kk) * ldw + n]; }
    LDS_WAIT(); asm volatile("" ::: "memory");
    const int c = lane & 7;
#pragma unroll
    for (int j = 0; j < 4; ++j) { const int nn = (lane >> 3) + 8 * j; const LAS float* s = scr + (8 * c) * 33 + nn;
        u32x4 o; o.x = pkbf(s[0 * 33], s[1 * 33]); o.y = pkbf(s[2 * 33], s[3 * 33]); o.z = pkbf(s[4 * 33], s[5 * 33]); o.w = pkbf(s[6 * 33], s[7 * 33]);
        *(u32x4*)(WT + (size_t)(drow + nn) * Kdst + k0 + 8 * c) = o; }
    LDS_WAIT(); asm volatile("" ::: "memory");
}
constexpr int IT_GU = 16 * 88, IT_D = 44 * 32, IT_IN = 16 * 97, IT_OUT = 16 * 32, IT_LAYER = 6 * IT_GU + IT_IN + IT_OUT;
__device__ __forceinline__ void prologue_item(unsigned char* wsb, int it, LAS float* scr, int lane) {
    const int l = it / IT_LAYER; int r = it % IT_LAYER;
    unsigned char* wl = wsb + WS_W + (size_t)l * W_LAYER;
    if (r < 2 * IT_GU) { const int up = r >= IT_GU; r -= up * IT_GU; const int kb = r / 88, nb = r % 88, n0 = 32 * nb;
        tr_item(KIN(up ? 3 : 2) + (size_t)l * D * FF, FF, FF, (bf16*)(wl + OW_GU1), D, 64 * kb, n0, 256 * (n0 >> 7) + (n0 & 127) + 128 * up, scr, lane); return; }
    r -= 2 * IT_GU;
    if (r < IT_D) { const int kb = r / 32, nb = r % 32; tr_item(KIN(4) + (size_t)l * FF * D, D, D, (bf16*)(wl + OW_D1), FF, 64 * kb, 32 * nb, 32 * nb, scr, lane); return; }
    r -= IT_D;
    if (r < IT_IN) { const int kb = r / 97, nb = r % 97; tr_item(KIN(7) + (size_t)l * D * NPROJ, NPROJ, NPROJ, (bf16*)(wl + OW_IN), D, 64 * kb, 32 * nb, 32 * nb, scr, lane); return; }
    r -= IT_IN;
    if (r < IT_OUT) { const int kb = r / 32, nb = r % 32; tr_item(KIN(16) + (size_t)l * D * D, D, D, (bf16*)(wl + OW_OUT), D, 64 * kb, 32 * nb, 32 * nb, scr, lane); return; }
    r -= IT_OUT;
    if (r < 2 * IT_GU) { const int up = r >= IT_GU; r -= up * IT_GU; const int kb = r / 88, nb = r % 88, n0 = 32 * nb;
        tr_item(KIN(up ? 20 : 19) + (size_t)l * D * FF, FF, FF, (bf16*)(wl + OW_GU2), D, 64 * kb, n0, 256 * (n0 >> 7) + (n0 & 127) + 128 * up, scr, lane); return; }
    r -= 2 * IT_GU;
    { const int kb = r / 32, nb = r % 32; tr_item(KIN(21) + (size_t)l * FF * D, D, D, (bf16*)(wl + OW_D2), FF, 64 * kb, 32 * nb, 32 * nb, scr, lane); }
}
__device__ __forceinline__ void row_to_bf16(const float* xrow, bf16* orow, int lane) {
    const f32x4* xr = (const f32x4*)xrow + lane; u32x2* o8 = (u32x2*)orow + lane;
#pragma unroll
    for (int j = 0; j < 4; ++j) { const f32x4 v = xr[64 * j]; u32x2 w; w.x = pkbf(v[0], v[1]); w.y = pkbf(v[2], v[3]); o8[64 * j] = w; }
}
__device__ __forceinline__ void ln_row(float* xrow, bf16* orow, const float* g, const float* b, int lane) {
    f32x4* xr = (f32x4*)xrow + lane; f32x4 v[4]; float s = 0.f;
#pragma unroll
    for (int j = 0; j < 4; ++j) { v[j] = xr[64 * j]; s += (v[j][0] + v[j][1]) + (v[j][2] + v[j][3]); }
    const float mean = wave_sum(s) * (1.f / D); float s2 = 0.f;
#pragma unroll
    for (int j = 0; j < 4; ++j) { v[j] = v[j] - mean; s2 += (v[j][0] * v[j][0] + v[j][1] * v[j][1]) + (v[j][2] * v[j][2] + v[j][3] * v[j][3]); }
    const float rstd = 1.f / sqrtf(wave_sum(s2) * (1.f / D) + LN_EPS);
    u32x2* o8 = (u32x2*)orow + lane;
#pragma unroll
    for (int j = 0; j < 4; ++j) { const f32x4 gv = ((const f32x4*)g)[lane + 64 * j], bv = ((const f32x4*)b)[lane + 64 * j];
        const f32x4 o = v[j] * rstd * gv + bv; xr[64 * j] = o; u32x2 w; w.x = pkbf(o[0], o[1]); w.y = pkbf(o[2], o[3]); o8[64 * j] = w; }
}

__device__ __forceinline__ void seq_of_row(int m, int& s0, int& T) { if (m < MPROMPT) { s0 = m & ~2047; T = 2048; } else { s0 = MPROMPT + ((m - MPROMPT) & ~4095); T = 4096; } }
__device__ __forceinline__ void conv8(const bf16* raw, int m, int tl, int T, int c0, const float* cw, const float* cb, float (&o)[8]) {
    const f32x4 b0 = *(const f32x4*)(cb + c0), b1 = *(const f32x4*)(cb + c0 + 4);
    float a[8] = {b0[0], b0[1], b0[2], b0[3], b1[0], b1[1], b1[2], b1[3]};
#pragma unroll
    for (int j = 0; j < 5; ++j) { const int tt = tl + j - 2;
        if (tt >= 0 && tt < T) { const u32x4 v = *(const u32x4*)(raw + (size_t)(m + j - 2) * 1024 + c0);
            const f32x4 w0 = *(const f32x4*)(cw + j * 1024 + c0), w1 = *(const f32x4*)(cw + j * 1024 + c0 + 4);
            a[0] += bf_lo(v.x) * w0[0]; a[1] += bf_hi(v.x) * w0[1]; a[2] += bf_lo(v.y) * w0[2]; a[3] += bf_hi(v.y) * w0[3];
            a[4] += bf_lo(v.z) * w1[0]; a[5] += bf_hi(v.z) * w1[1]; a[6] += bf_lo(v.w) * w1[2]; a[7] += bf_hi(v.w) * w1[3]; } }
#pragma unroll
    for (int e = 0; e < 8; ++e) o[e] = silu_f(a[e]);
}
__device__ __forceinline__ float softplus_f(float x) { return x > 20.f ? x : log1pf(expf(x)); }

constexpr int SCAN_DIR_F = 10368;
__device__ __forceinline__ void scan_naive_unit(int b, int h, const bf16* raw, const float* DT, float* Y, const float* cw, const float* cb, const float* dt_bias, const float* a_log, const float* d_skip, LAS float* L, int tid, int wave, int lane) {
    int s0, T; if (b < 32) { s0 = b * 2048; T = 2048; } else { s0 = MPROMPT + (b - 32) * 4096; T = 4096; }
    const int g = h >> 2, dir = wave >> 2, pb = wave & 3, p = pb * 16 + (lane & 15), nq = lane >> 4;
    const float a = -expf(a_log[dir * 8 + h]), dskip = d_skip[h], dtb = dt_bias[dir * 8 + h];
    float s[32];
#pragma unroll
    for (int k = 0; k < 32; ++k) s[k] = 0.f;
    LAS float* Lw = L + dir * SCAN_DIR_F;
    const int nblk = T >> 5;
    for (int blk = 0; blk < nblk; ++blk) {
        __syncthreads();
        const int tbase = dir == 0 ? 32 * blk : T - 32 * (blk + 1);
        { const int r_ = tid & 255, tok = r_ >> 3, part = r_ & 7, tl = tbase + tok, m = s0 + tl; float o[8];
          conv8(raw, m, tl, T, 512 + 128 * g + 16 * part, cw, cb, o);
#pragma unroll
          for (int e = 0; e < 8; ++e) Lw[tok * 128 + 16 * part + e] = o[e];
          conv8(raw, m, tl, T, 512 + 128 * g + 16 * part + 8, cw, cb, o);
#pragma unroll
          for (int e = 0; e < 8; ++e) Lw[tok * 128 + 16 * part + 8 + e] = o[e];
          conv8(raw, m, tl, T, 768 + 128 * g + 16 * part, cw, cb, o);
#pragma unroll
          for (int e = 0; e < 8; ++e) Lw[4096 + tok * 128 + 16 * part + e] = o[e];
          conv8(raw, m, tl, T, 768 + 128 * g + 16 * part + 8, cw, cb, o);
#pragma unroll
          for (int e = 0; e < 8; ++e) Lw[4096 + tok * 128 + 16 * part + 8 + e] = o[e];
          conv8(raw, m, tl, T, h * 64 + 8 * part, cw, cb, o);
#pragma unroll
          for (int e = 0; e < 8; ++e) Lw[8192 + tok * 64 + 8 * part + e] = o[e];
          if (part == 0) { const float dtv = softplus_f(DT[(size_t)m * 16 + dir * 8 + h] + dtb); Lw[10240 + tok] = dtv; Lw[10272 + tok] = expf(dtv * a); }
        }
        __syncthreads();
        for (int i = 0; i < 32; ++i) {
            const int ti = dir == 0 ? i : 31 - i;
            const float d = Lw[10272 + ti], dtv = Lw[10240 + ti], xv = Lw[8192 + ti * 64 + p], xdt = xv * dtv;
            float y = 0.f;
#pragma unroll
            for (int k4 = 0; k4 < 8; ++k4) { const f32x4 bv = *(const LAS f32x4*)(Lw + ti * 128 + 32 * nq + 4 * k4), cv = *(const LAS f32x4*)(Lw + 4096 + ti * 128 + 32 * nq + 4 * k4);
#pragma unroll
                for (int e = 0; e < 4; ++e) { s[4 * k4 + e] = s[4 * k4 + e] * d + xdt * bv[e]; y += s[4 * k4 + e] * cv[e]; } }
            y += __shfl_xor(y, 16); y += __shfl_xor(y, 32);
            if (nq == 0) atomicAdd(Y + (size_t)(s0 + tbase + ti) * 512 + h * 64 + p, y + (dir == 0 ? dskip * xv : 0.f));
        }
    }
}

__device__ __forceinline__ void attn_naive_unit(int m, int wave, int lane, const bf16* QKV, const float* rpb, const float* gattn, bf16* MIX, LAS float* Ps, volatile LAS float* exch, int parity) {
    const int h = wave; int s0, T; seq_of_row(m, s0, T);
    const int tl = m - s0, r = tl >> 6, qc = tl & 63, rows = T >> 6;
    const int cstart = min(max(qc - 8, 0), 48), rs = min(max(r - 4, 0), rows - 8);
    float q[64];
    { const bf16* qp = QKV + (size_t)m * 1536 + h * 64;
#pragma unroll
      for (int i = 0; i < 8; ++i) { const u32x4 v = *(const u32x4*)(qp + 8 * i); q[8 * i] = bf_lo(v.x); q[8 * i + 1] = bf_hi(v.x); q[8 * i + 2] = bf_lo(v.y); q[8 * i + 3] = bf_hi(v.y);
          q[8 * i + 4] = bf_lo(v.z); q[8 * i + 5] = bf_hi(v.z); q[8 * i + 6] = bf_lo(v.w); q[8 * i + 7] = bf_hi(v.w); } }
    float sc[2];
#pragma unroll
    for (int k2 = 0; k2 < 2; ++k2) { const int kk = lane + 64 * k2, kri = kk >> 4, kci = kk & 15; const int kt = s0 + (rs + kri) * 64 + cstart + kci;
        const bf16* kp = QKV + (size_t)kt * 1536 + 512 + h * 64; float d = 0.f;
#pragma unroll
        for (int i = 0; i < 8; ++i) { const u32x4 v = *(const u32x4*)(kp + 8 * i);
            d += q[8 * i] * bf_lo(v.x) + q[8 * i + 1] * bf_hi(v.x) + q[8 * i + 2] * bf_lo(v.y) + q[8 * i + 3] * bf_hi(v.y) + q[8 * i + 4] * bf_lo(v.z) + q[8 * i + 5] * bf_hi(v.z) + q[8 * i + 6] * bf_lo(v.w) + q[8 * i + 7] * bf_hi(v.w); }
        sc[k2] = d + rpb[h * 465 + (rs + kri - r + 7) * 31 + (cstart + kci - qc + 15)]; }
    const float mx = wave_max(fmaxf(sc[0], sc[1]));
    const float p0 = __expf(sc[0] - mx), p1 = __expf(sc[1] - mx);
    const float inv = 1.f / wave_sum(p0 + p1);
    Ps[lane] = p0 * inv; Ps[lane + 64] = p1 * inv;
    LDS_WAIT(); asm volatile("" ::: "memory");
    float o = 0.f; const bf16* vbase = QKV + 1024 + h * 64 + lane;
#pragma unroll 4
    for (int kk = 0; kk < 128; kk += 4) { const f32x4 pv = *(const LAS f32x4*)(Ps + kk); const int kt = s0 + (rs + (kk >> 4)) * 64 + cstart + (kk & 15);
#pragma unroll
        for (int e = 0; e < 4; ++e) o += pv[e] * bf2f(vbase[(size_t)(kt + e) * 1536]); }
    const float ssq = wave_sum(o * o);
    if (lane == 0) exch[parity * 8 + h] = ssq;
    __syncthreads();
    float tot = 0.f;
#pragma unroll
    for (int i = 0; i < 8; ++i) tot += exch[parity * 8 + i];
    const float scl = 1.f / sqrtf(tot * (1.f / 512.f) + RMS_EPS);
    MIX[(size_t)m * 1024 + h * 64 + lane] = f2bf(o * scl * gattn[h * 64 + lane]);
}


typedef short bf16x8v __attribute__((ext_vector_type(8)));
typedef short s16x4v __attribute__((ext_vector_type(4)));
#define MFMA16(a, b, c) __builtin_amdgcn_mfma_f32_16x16x32_bf16((a), (b), (c), 0, 0, 0)
constexpr int VPITCH = 144, VHEAD = 512 * VPITCH;
__device__ __forceinline__ void attn_fast_unit(int u, const bf16* QKV, const float* TB  , const float* gattn, bf16* MIX, float* SSQA, LAS unsigned char* lds, int tid, int wave, int lane) {
    const int hp = u / 1280, gr = u % 1280;
    int s0, rows, r;
    if (gr < 1024) { s0 = (gr >> 5) * 2048; r = gr & 31; rows = 32; } else { const int g2 = gr - 1024; s0 = MPROMPT + (g2 >> 6) * 4096; r = g2 & 63; rows = 64; }
    const int rs = min(max(r - 4, 0), rows - 8);
    __syncthreads();
    { u32x4 v[16];
#pragma unroll
      for (int i = 0; i < 16; ++i) { const int id = i * 512 + tid, c = id & 7, key = (id >> 3) & 511, hh = id >> 12;
          v[i] = *(const u32x4*)(QKV + (size_t)(s0 + rs * 64 + key) * 1536 + 1024 + (2 * hp + hh) * 64 + 8 * c); }
#pragma unroll
      for (int i = 0; i < 16; ++i) { const int id = i * 512 + tid, c = id & 7, key = (id >> 3) & 511, hh = id >> 12;
          *(LAS u32x4*)(lds + hh * VHEAD + key * VPITCH + 16 * c) = v[i]; } }
    __syncthreads();
    const int hh = wave >> 2, j = wave & 3, h = 2 * hp + hh, fr = lane & 15, fq = lane >> 4;
    const int kstart = j == 0 ? 0 : (j == 1 ? 8 : (j == 2 ? 24 : 32));
    const int qtok = s0 + r * 64 + 16 * j + fr;
    const bf16x8v q0 = *(const bf16x8v*)(QKV + (size_t)qtok * 1536 + h * 64 + 8 * fq), q1 = *(const bf16x8v*)(QKV + (size_t)qtok * 1536 + h * 64 + 32 + 8 * fq);
    f32x4 sacc[16];
    const float* tb = TB + (size_t)((h * 4 + j) * 15 + (rs - r + 7)) * 512 + fr * 32 + 4 * fq;
#pragma unroll
    for (int kt = 0; kt < 16; ++kt) { const int kri = kt >> 1; const size_t ktok = (size_t)(s0 + (rs + kri) * 64 + kstart + 16 * (kt & 1) + fr);
        const bf16x8v k0 = *(const bf16x8v*)(QKV + ktok * 1536 + 512 + h * 64 + 8 * fq), k1 = *(const bf16x8v*)(QKV + ktok * 1536 + 512 + h * 64 + 32 + 8 * fq);
        f32x4 a = {0.f, 0.f, 0.f, 0.f}; a = MFMA16(k0, q0, a); a = MFMA16(k1, q1, a);
        sacc[kt] = a + *(const f32x4*)(tb + kri * 512 + 16 * (kt & 1)); }
    float mx = -INFINITY;
#pragma unroll
    for (int kt = 0; kt < 16; ++kt) mx = fmaxf(mx, fmaxf(fmaxf(sacc[kt][0], sacc[kt][1]), fmaxf(sacc[kt][2], sacc[kt][3])));
    mx = fmaxf(mx, __shfl_xor(mx, 16)); mx = fmaxf(mx, __shfl_xor(mx, 32));
    float l = 0.f;
#pragma unroll
    for (int kt = 0; kt < 16; ++kt) {
#pragma unroll
        for (int i = 0; i < 4; ++i) { const float pz = __builtin_amdgcn_exp2f(sacc[kt][i] - mx); sacc[kt][i] = pz; l += pz; } }
    l += __shfl_xor(l, 16); l += __shfl_xor(l, 32);
    f32x4 o[4];
#pragma unroll
    for (int dt = 0; dt < 4; ++dt) o[dt] = (f32x4){0.f, 0.f, 0.f, 0.f};
    const LAS unsigned char* vb = lds + hh * VHEAD + (kstart + 4 * fq + ((lane & 15) >> 2)) * VPITCH + 8 * (lane & 3);
#pragma unroll
    for (int ks = 0; ks < 8; ++ks) {
        u32x4 pw; pw.x = pkbf(sacc[2 * ks][0], sacc[2 * ks][1]); pw.y = pkbf(sacc[2 * ks][2], sacc[2 * ks][3]); pw.z = pkbf(sacc[2 * ks + 1][0], sacc[2 * ks + 1][1]); pw.w = pkbf(sacc[2 * ks + 1][2], sacc[2 * ks + 1][3]);
        const bf16x8v pf = __builtin_bit_cast(bf16x8v, pw);
#pragma unroll
        for (int dt = 0; dt < 4; ++dt) {
            const s16x4v lo = __builtin_amdgcn_ds_read_tr16_b64_v4i16((LAS s16x4v*)(vb + ks * 64 * VPITCH + 32 * dt));
            const s16x4v hi = __builtin_amdgcn_ds_read_tr16_b64_v4i16((LAS s16x4v*)(vb + (ks * 64 + 16) * VPITCH + 32 * dt));
            const bf16x8v vf = __builtin_shufflevector(lo, hi, 0, 1, 2, 3, 4, 5, 6, 7);
            o[dt] = MFMA16(vf, pf, o[dt]); } }
    const float inv = 1.f / l; float ssq = 0.f;
#pragma unroll
    for (int dt = 0; dt < 4; ++dt) { o[dt] = o[dt] * inv; ssq += (o[dt][0] * o[dt][0] + o[dt][1] * o[dt][1]) + (o[dt][2] * o[dt][2] + o[dt][3] * o[dt][3]); }
    ssq += __shfl_xor(ssq, 16); ssq += __shfl_xor(ssq, 32);
    if (fq == 0) atomicAdd(SSQA + qtok, ssq);
#pragma unroll
    for (int dt = 0; dt < 4; ++dt) { const f32x4 gv = *(const f32x4*)(gattn + h * 64 + 16 * dt + 4 * fq); const f32x4 ov = o[dt] * gv;
        u32x2 w; w.x = pkbf(ov[0], ov[1]); w.y = pkbf(ov[2], ov[3]); *(u32x2*)(MIX + (size_t)qtok * 1024 + h * 64 + 16 * dt + 4 * fq) = w; }
}

__device__ __forceinline__ void gate_norm_row(int m, int lane, const float* Y, const bf16* Z, const float* g, bf16* MIX) {
    const f32x4 y0 = *(const f32x4*)(Y + (size_t)m * 512 + 8 * lane), y1 = *(const f32x4*)(Y + (size_t)m * 512 + 8 * lane + 4);
    const u32x4 zv = *(const u32x4*)(Z + (size_t)m * 512 + 8 * lane);
    float v[8] = {y0[0] * silu_f(bf_lo(zv.x)), y0[1] * silu_f(bf_hi(zv.x)), y0[2] * silu_f(bf_lo(zv.y)), y0[3] * silu_f(bf_hi(zv.y)),
                  y1[0] * silu_f(bf_lo(zv.z)), y1[1] * silu_f(bf_hi(zv.z)), y1[2] * silu_f(bf_lo(zv.w)), y1[3] * silu_f(bf_hi(zv.w))};
    float ss = 0.f;
#pragma unroll
    for (int e = 0; e < 8; ++e) ss += v[e] * v[e];
    const float scl = 1.f / sqrtf(wave_sum(ss) * (1.f / 512.f) + RMS_EPS);
    const f32x4 g0 = *(const f32x4*)(g + 8 * lane), g1 = *(const f32x4*)(g + 8 * lane + 4);
    u32x4 w; w.x = pkbf(v[0] * scl * g0[0], v[1] * scl * g0[1]); w.y = pkbf(v[2] * scl * g0[2], v[3] * scl * g0[3]);
    w.z = pkbf(v[4] * scl * g1[0], v[5] * scl * g1[1]); w.w = pkbf(v[6] * scl * g1[2], v[7] * scl * g1[3]);
    *(u32x4*)(MIX + (size_t)m * 1024 + 512 + 8 * lane) = w;
}

__global__ void __launch_bounds__(NT, 2) fwd_mega(Params P) {
    extern __shared__ __attribute__((aligned(16))) unsigned char lds_raw[];
    LAS unsigned char* lds = (LAS unsigned char*)lds_raw;
    cg::grid_group grid = cg::this_grid();
#define FRESH_IDS() int tid = threadIdx.x; asm volatile("" : "+v"(tid)); int G = gridDim.x, bx = blockIdx.x; asm volatile("" : "+s"(G), "+s"(bx)); \
    const int lane = tid & 63, wave = __builtin_amdgcn_readfirstlane(tid >> 6), gw = bx * NWAVES + wave, NGW = G * NWAVES; (void)gw; (void)lane; (void)NGW; \
    unsigned char* ws = KWS(); float* out = KOUT(); (void)out; \
    bf16* XB = (bf16*)(ws + WS_XB); bf16* Hb = (bf16*)(ws + WS_H); bf16* QKV = (bf16*)(ws + WS_QKV); bf16* Zb = (bf16*)(ws + WS_Z); bf16* RAW = (bf16*)(ws + WS_RAW); \
    float* Yb = (float*)(ws + WS_Y); float* DTb = (float*)(ws + WS_DT); (void)XB; (void)Hb; (void)QKV; (void)Zb; (void)RAW; (void)Yb; (void)DTb
    { FRESH_IDS(); LAS float* scr = (LAS float*)(lds + wave * 16384);
      for (int it = gw; it < 2 * IT_LAYER; it += NGW) prologue_item(ws, it, scr, lane);
      { float* TBw = (float*)(ws + WS_TB);
        for (int i = bx * NT + tid; i < 2 * 8 * 4 * 15 * 512; i += G * NT) { const int kc = i & 31, q = (i >> 5) & 15; int t = i >> 9; const int ro = t % 15; t /= 15; const int j = t & 3; t >>= 2; const int h = t & 7, l = t >> 3;
            const int kstart = j == 0 ? 0 : (j == 1 ? 8 : (j == 2 ? 24 : 32)), qcol = 16 * j + q, kcol = kstart + kc, cst = min(max(qcol - 8, 0), 48);
            const bool valid = kcol >= cst && kcol < cst + 16;
            TBw[i] = valid ? 1.4426950408889634f * KIN(15)[((l * 8 + h) * 15 + ro) * 31 + (kcol - qcol + 15)] : -INFINITY; } }
      for (int m = gw; m < M; m += NGW) { const float* src = m < MPROMPT ? KIN(0) + (size_t)m * D : KIN(1) + (size_t)(m - MPROMPT) * D; row_to_bf16(src, XB + (size_t)m * D, lane); } }
    grid.sync();

    for (int l = 0; l < 2; ++l) {
        { FRESH_IDS(); pg8::Gemm g{XB, (const bf16*)(ws + WS_W + (size_t)l * W_LAYER + OW_GU1), M, NGU, D}; pg8::StaticOrder S; S.init(M, NGU, (int)gridDim.x, (int)blockIdx.x); pg8::EpiSwiGLU E{Hb, FF};
          pg8::gemm_phase<pg8::EpiSwiGLU, pg8::StaticOrder, true, true>(lds, g, S, E); }
        grid.sync();
        { FRESH_IDS(); pg8::Gemm g{Hb, (const bf16*)(ws + WS_W + (size_t)l * W_LAYER + OW_D1), M, D, FF}; pg8::StaticOrder S; S.init(M, D, (int)gridDim.x, (int)blockIdx.x);
          pg8::EpiResid E{l == 0 ? KIN(0) : out, l == 0 ? KIN(1) - (size_t)MPROMPT * D : out, out, 0.5f};
          pg8::gemm_phase<pg8::EpiResid, pg8::StaticOrder, true, true>(lds, g, S, E); }
        grid.sync();
        { FRESH_IDS(); const float* g_ = KIN(5) + l * D; const float* b_ = KIN(6) + l * D;
          for (int m = gw; m < M; m += NGW) ln_row(out + (size_t)m * D, XB + (size_t)m * D, g_, b_, lane);
          f32x4* yz = (f32x4*)Yb; const f32x4 z4 = {0.f, 0.f, 0.f, 0.f};
          for (size_t i = (size_t)bx * NT + tid; i < (size_t)M * 512 / 4; i += (size_t)G * NT) yz[i] = z4;
          f32x4* sz = (f32x4*)(ws + WS_SSQ); for (int i = bx * NT + tid; i < 2 * M / 4; i += G * NT) sz[i] = z4; }
        grid.sync();
        { FRESH_IDS(); pg8::Gemm g{XB, (const bf16*)(ws + WS_W + (size_t)l * W_LAYER + OW_IN), M, NIN, D}; pg8::StaticOrder S; S.init(M, NIN, (int)gridDim.x, (int)blockIdx.x); pg8::EpiProj E{QKV, Zb, RAW, DTb};
          pg8::gemm_phase<pg8::EpiProj, pg8::StaticOrder, true, true>(lds, g, S, E); }
        grid.sync();
        { FRESH_IDS(); const float* cw = KIN(8) + (size_t)l * 5 * 1024; const float* cb = KIN(9) + l * 1024;
          for (int u = bx; u < 36 * 8; u += G) { const int uu = (u + 32 * 8) % (36 * 8);
              scan_naive_unit(uu >> 3, uu & 7, RAW, DTb, Yb, cw, cb, KIN(10) + l * 16, KIN(11) + l * 16, KIN(12) + l * 8, (LAS float*)lds, tid, wave, lane); }
          { const int per = (5120 + G - 1) / G; const int u0 = bx * per, u1 = min(u0 + per, 5120);
            for (int u = u0; u < u1; ++u) attn_fast_unit(u, QKV, (const float*)(ws + WS_TB) + (size_t)l * 8 * 4 * 15 * 512, KIN(14) + l * 512, XB, (float*)(ws + WS_SSQ), lds, tid, wave, lane); } }
        grid.sync();
        { FRESH_IDS(); for (int m = gw; m < M; m += NGW) gate_norm_row(m, lane, Yb, Zb, KIN(13) + l * 512, XB); }
        grid.sync();
        { FRESH_IDS(); pg8::Gemm g{XB, (const bf16*)(ws + WS_W + (size_t)l * W_LAYER + OW_OUT), M, D, D}; pg8::StaticOrder S; S.init(M, D, (int)gridDim.x, (int)blockIdx.x); pg8::EpiResidMix E{out, out, (const float*)(ws + WS_SSQ), nullptr};
          pg8::gemm_phase<pg8::EpiResidMix, pg8::StaticOrder, true, true>(lds, g, S, E); }
        grid.sync();
        { FRESH_IDS(); const float* g_ = KIN(17) + l * D; const float* b_ = KIN(18) + l * D;
          for (int m = gw; m < M; m += NGW) ln_row(out + (size_t)m * D, XB + (size_t)m * D, g_, b_, lane); }
        grid.sync();
        { FRESH_IDS(); pg8::Gemm g{XB, (const bf16*)(ws + WS_W + (size_t)l * W_LAYER + OW_GU2), M, NGU, D}; pg8::StaticOrder S; S.init(M, NGU, (int)gridDim.x, (int)blockIdx.x); pg8::EpiSwiGLU E{Hb, FF};
          pg8::gemm_phase<pg8::EpiSwiGLU, pg8::StaticOrder, true, true>(lds, g, S, E); }
        grid.sync();
        { FRESH_IDS(); pg8::Gemm g{Hb, (const bf16*)(ws + WS_W + (size_t)l * W_LAYER + OW_D2), M, D, FF}; pg8::StaticOrder S; S.init(M, D, (int)gridDim.x, (int)blockIdx.x); pg8::EpiResid E{out, out, out, 0.5f};
          pg8::gemm_phase<pg8::EpiResid, pg8::StaticOrder, true, true>(lds, g, S, E); }
        grid.sync();
        { FRESH_IDS(); const float* g_ = KIN(22) + l * D; const float* b_ = KIN(23) + l * D;
          for (int m = gw; m < M; m += NGW) ln_row(out + (size_t)m * D, XB + (size_t)m * D, g_, b_, lane); }
        if (l == 0) grid.sync();
    }
}

extern "C" void kernel_launch(void* const* d_in, const int* in_sizes, int n_in, void* d_out, int out_size, void* d_ws, size_t ws_size, hipStream_t stream) {
    static int grid_blocks = 0;
    if (grid_blocks == 0) {
        if (n_in != 24 || out_size != M * D || ws_size < WS_END) { fprintf(stderr, "kernel_launch: unexpected shapes (n_in %d out %d ws %zu)\n", n_in, out_size, ws_size); grid_blocks = -1; return; }
        int dev = 0, cus = 0, per_cu = 0;
        (void)hipGetDevice(&dev); (void)hipDeviceGetAttribute(&cus, hipDeviceAttributeMultiprocessorCount, dev);
        if (hipFuncSetAttribute((const void*)fwd_mega, hipFuncAttributeMaxDynamicSharedMemorySize, LDS_BYTES) != hipSuccess) { fprintf(stderr, "kernel_launch: hipFuncSetAttribute failed\n"); grid_blocks = -1; return; }
        if (hipOccupancyMaxActiveBlocksPerMultiprocessor(&per_cu, (const void*)fwd_mega, NT, LDS_BYTES) != hipSuccess || per_cu < 1) { fprintf(stderr, "kernel_launch: occupancy query gave %d\n", per_cu); per_cu = 1; }
        (void)hipGetLastError();
        grid_blocks = cus * per_cu;
    }
    if (grid_blocks < 0) return;
    Params p{};
    for (int i = 0; i < 24; ++i) p.in[i] = (const float*)d_in[i];
    p.out = (float*)d_out; p.ws = (unsigned char*)d_ws;
    void* args[] = {&p};
    hipError_t e = hipLaunchCooperativeKernel((const void*)fwd_mega, dim3(grid_blocks), dim3(NT), args, LDS_BYTES, stream);
    if (e != hipSuccess) fprintf(stderr, "cooperative launch failed: %s (grid %d)\n", hipGetErrorString(e), grid_blocks);
}
```

```cpp
#include <hip/hip_runtime.h>
#include <hip/hip_cooperative_groups.h>
#include <cstdio>
#include <cstdint>
namespace cg = cooperative_groups;
namespace pg8 {
#define PG8_LAS __attribute__((address_space(3)))
typedef unsigned short bf16_t;
typedef short bf16x8 __attribute__((ext_vector_type(8)));
typedef float f32x4 __attribute__((ext_vector_type(4)));
typedef unsigned u32x4 __attribute__((ext_vector_type(4)));
constexpr int BM = 256, BK = 64, HALF = 128, HTB = HALF * BK * 2  , STAGE_BYTES = 8 * HTB, NXCD = 8, WGM = 8;

__host__ __device__ __forceinline__ int lds_byte(int r, int c) { const int st = (r >> 4) * 2 + (c >> 5), rr = r & 15, cc = c & 31, ob = rr * 64 + cc * 2; return st * 1024 + (ob ^ (((ob >> 9) & 1) << 5)); }
__host__ __device__ __forceinline__ void stage_rc(int b, int& R, int& C) { const int st = b / 1024, sb = b % 1024, swz = sb ^ (((sb >> 9) & 1) << 5); R = (st >> 1) * 16 + swz / 64; C = (st & 1) * 32 + (swz % 64) / 2; }
__host__ __device__ __forceinline__ int perm32(int rho) { const int n = rho >> 4, i = rho & 15; return 8 * (i >> 2) + 4 * n + (i & 3); }

struct Unit { int pm, pn; };
struct Gemm { const bf16_t* A; const bf16_t* Bt; int M, N, K; };

struct StaticOrder {
    int nM, nN, nwg, G, c;
    __host__ __device__ void init(int M, int N, int G_, int c_) { nM = M / BM; nN = N / BM; nwg = nM * nN; G = G_; c = c_; }
    __host__ __device__ bool next(int i, Unit& u) const {
        const long L = (long)i * G + c; if (L >= nwg) return false;
        int wgid = (int)L; { const int q = nwg / NXCD, r = nwg % NXCD, xcd = wgid % NXCD, off = wgid / NXCD; wgid = (xcd < r ? xcd * (q + 1) : r * (q + 1) + (xcd - r) * q) + off; }
        const int nig = WGM * nN, gid = wgid / nig, fm = gid * WGM, gsz = (nM - fm) < WGM ? (nM - fm) : WGM;
        u.pm = fm + ((wgid % nig) % gsz); u.pn = (wgid % nig) / gsz; return true;
    }
    __device__ __forceinline__ void a_ready(const Unit&) const {}
    __device__ __forceinline__ void done(const Unit&) const {}
};

typedef float f32x2e __attribute__((ext_vector_type(2)));
typedef __bf16 bf16x2e __attribute__((ext_vector_type(2)));
__device__ __forceinline__ unsigned pkbf(float a, float b) { f32x2e v = {a, b}; bf16x2e r = __builtin_convertvector(v, bf16x2e); return __builtin_bit_cast(unsigned, r); }
__device__ __forceinline__ float silu_f(float g) { return g * __builtin_amdgcn_rcpf(1.f + __builtin_amdgcn_exp2f(-1.4426950408889634f * g)); }
constexpr float ALPHA_F = 1.4142135623730951f;
constexpr int MPROMPT = 65536;

struct EpiSwiGLU {
    static constexpr bool PERM = true, AFTER_DRAIN = false, MID = false;
    bf16_t* H; int ldh;
    __device__ __forceinline__ void operator()(const f32x4 (&acc)[2][2][4][2], const Unit& u, int wr, int wc, int fr, int fq) const {
        const int row0 = u.pm * BM + wr * 64 + fr, col0 = u.pn * HALF + wc * 32 + 8 * fq;
#pragma unroll
        for (int ai = 0; ai < 2; ++ai)
#pragma unroll
            for (int m = 0; m < 4; ++m) {
                bf16_t* p = H + (size_t)(row0 + ai * HALF + m * 16) * ldh + col0;
                const f32x4 g0 = acc[ai][0][m][0], g1 = acc[ai][0][m][1], u0 = acc[ai][1][m][0], u1 = acc[ai][1][m][1];
                u32x4 w;
                w.x = pkbf(silu_f(g0[0]) * u0[0], silu_f(g0[1]) * u0[1]); w.y = pkbf(silu_f(g0[2]) * u0[2], silu_f(g0[3]) * u0[3]);
                w.z = pkbf(silu_f(g1[0]) * u1[0], silu_f(g1[1]) * u1[1]); w.w = pkbf(silu_f(g1[2]) * u1[2], silu_f(g1[3]) * u1[3]);
                *(u32x4*)p = w;
            }
    }
};
struct EpiResid {
    static constexpr bool PERM = false, AFTER_DRAIN = false, MID = false;
    const float* r0; const float* r1; float* out; float scale;
    __device__ __forceinline__ void operator()(const f32x4 (&acc)[2][2][4][2], const Unit& u, int wr, int wc, int fr, int fq) const {
        const float* rbase = (u.pm * BM < MPROMPT) ? r0 : r1;
#pragma unroll
        for (int ai = 0; ai < 2; ++ai)
#pragma unroll
            for (int m = 0; m < 4; ++m) {
                const size_t roff = (size_t)(u.pm * BM + ai * HALF + wr * 64 + m * 16 + fr) * 1024;
#pragma unroll
                for (int bj = 0; bj < 2; ++bj)
#pragma unroll
                    for (int n = 0; n < 2; ++n) {
                        const int c = u.pn * BM + bj * HALF + wc * 32 + n * 16 + 4 * fq;
                        const f32x4 b = *(const f32x4*)(rbase + roff + c);
                        *(f32x4*)(out + roff + c) = b * ALPHA_F + acc[ai][bj][m][n] * scale;
                    }
            }
    }
};
struct EpiResidMix {
    static constexpr bool PERM = false, AFTER_DRAIN = false, MID = true;
    float* out; const float* ssq;
    __device__ __forceinline__ void mid(f32x4 (&acc)[2][2][4][2], const Unit& u, int wr, int wc, int fr, int fq) const {
#pragma unroll
        for (int ai = 0; ai < 2; ++ai)
#pragma unroll
            for (int m = 0; m < 4; ++m) { const int r = u.pm * BM + ai * HALF + wr * 64 + m * 16 + fr;
                const float f = sqrtf((ssq[81920 + r] * (1.f / 512.f) + 1e-6f) / (ssq[r] * (1.f / 512.f) + 1e-6f));
#pragma unroll
                for (int bj = 0; bj < 2; ++bj)
#pragma unroll
                    for (int n = 0; n < 2; ++n) acc[ai][bj][m][n] = acc[ai][bj][m][n] * f; }
    }
    __device__ __forceinline__ void operator()(const f32x4 (&acc)[2][2][4][2], const Unit& u, int wr, int wc, int fr, int fq) const {
#pragma unroll
        for (int ai = 0; ai < 2; ++ai)
#pragma unroll
            for (int m = 0; m < 4; ++m) { const int r = u.pm * BM + ai * HALF + wr * 64 + m * 16 + fr; const size_t roff = (size_t)r * 1024;
                const float f = 1.f / sqrtf(ssq[81920 + r] * (1.f / 512.f) + 1e-6f);
#pragma unroll
                for (int bj = 0; bj < 2; ++bj)
#pragma unroll
                    for (int n = 0; n < 2; ++n) { const int c = u.pn * BM + bj * HALF + wc * 32 + n * 16 + 4 * fq;
                        const f32x4 b = *(const f32x4*)(out + roff + c);
                        *(f32x4*)(out + roff + c) = b * ALPHA_F + acc[ai][bj][m][n] * f; } }
    }
};
struct EpiProj {
    static constexpr bool PERM = true, AFTER_DRAIN = false, MID = false;
    bf16_t* QKV; bf16_t* Z; bf16_t* XBC; float* DT;
    __device__ __forceinline__ void operator()(const f32x4 (&acc)[2][2][4][2], const Unit& u, int wr, int wc, int fr, int fq) const {
        const int row0 = u.pm * BM + wr * 64 + fr, pn = u.pn;
        if (pn == 12) {
            if (wc == 0 && fq < 2) {
#pragma unroll
                for (int ai = 0; ai < 2; ++ai)
#pragma unroll
                    for (int m = 0; m < 4; ++m) { float* p = DT + (size_t)(row0 + ai * HALF + m * 16) * 16 + 8 * fq;
                        *(f32x4*)p = acc[ai][0][m][0]; *(f32x4*)(p + 4) = acc[ai][0][m][1]; }
            }
            return;
        }
        bf16_t* base; int ldc, colt; float sc = 1.f;
        if (pn < 6) { base = QKV; ldc = 1536; colt = pn * 256; if (pn < 2) sc = 0.125f * 1.4426950408889634f; }
        else if (pn < 8) { base = Z; ldc = 512; colt = (pn - 6) * 256; }
        else { base = XBC; ldc = 1024; colt = (pn - 8) * 256; }
        const int col0 = colt + wc * 32 + 8 * fq;
#pragma unroll
        for (int ai = 0; ai < 2; ++ai)
#pragma unroll
            for (int m = 0; m < 4; ++m) { bf16_t* rowp = base + (size_t)(row0 + ai * HALF + m * 16) * ldc + col0;
#pragma unroll
                for (int bj = 0; bj < 2; ++bj) { const f32x4 v0 = acc[ai][bj][m][0] * sc, v1 = acc[ai][bj][m][1] * sc;
                    u32x4 w; w.x = pkbf(v0[0], v0[1]); w.y = pkbf(v0[2], v0[3]); w.z = pkbf(v1[0], v1[1]); w.w = pkbf(v1[2], v1[3]);
                    *(u32x4*)(rowp + bj * HALF) = w; } }
    }
};

template <class Epi, class Sched, bool ALIGN_EPI = false, bool SP2 = false>
__device__ __forceinline__ void gemm_phase(PG8_LAS unsigned char* lds, const Gemm g, const Sched& S, const Epi& E) {
    int tid_ = threadIdx.x; asm volatile("" : "+v"(tid_));
    const int tid = tid_, wid = __builtin_amdgcn_readfirstlane(tid >> 6), lane = tid & 63, wr = wid >> 2, wc = wid & 3, fr = lane & 15, fq = lane >> 4;
    const int K = g.K, nt = K / BK;
    unsigned voffA[2], voffB[2];
#pragma unroll
    for (int i = 0; i < 2; ++i) { int R, C; stage_rc(tid * 16 + i * 8192, R, C); const int Rb = Epi::PERM ? ((R & ~31) + perm32(R & 31)) : R;
        voffA[i] = (unsigned)(R * K + C) * 2u; voffB[i] = (unsigned)(Rb * K + C) * 2u; }
    const size_t kstep = (size_t)(BK * 2);
    const size_t hstep = (size_t)HALF * K * 2;
    const size_t tstep = 2 * hstep;
    const unsigned ldsw = (unsigned)wid * 1024u;
    const int aoff = lds_byte(wr * 64 + fr, fq * 8), boff = lds_byte(wc * 32 + fr, fq * 8);
#define PG8_SA(b, h) (((b) * 2 + (h)) * HTB)
#define PG8_SB(b, h) ((4 + (b) * 2 + (h)) * HTB)
#define PG8_STAGE(bufoff, gbase, voff) do { _Pragma("unroll") for (int _i = 0; _i < 2; ++_i) \
        __builtin_amdgcn_global_load_lds((const unsigned*)((const char*)(gbase) + (voff)[_i]), (PG8_LAS unsigned*)(lds + (bufoff) + ldsw + _i * 8192), 16, 0, 0); } while (0)
#define PG8_LDA(dst, b, h) do { _Pragma("unroll") for (int m = 0; m < 4; ++m) _Pragma("unroll") for (int k = 0; k < 2; ++k) dst[m][k] = *(const PG8_LAS bf16x8*)(lds + PG8_SA(b, h) + aoff + m * 2048 + k * 1024); } while (0)
#define PG8_LDB(dst, b, h) do { _Pragma("unroll") for (int n = 0; n < 2; ++n) _Pragma("unroll") for (int k = 0; k < 2; ++k) dst[n][k] = *(const PG8_LAS bf16x8*)(lds + PG8_SB(b, h) + boff + n * 2048 + k * 1024); } while (0)
#define PG8_MMA(ai, bj, At, Bt) do { __builtin_amdgcn_s_setprio(1); _Pragma("unroll") for (int m = 0; m < 4; ++m) _Pragma("unroll") for (int n = 0; n < 2; ++n) _Pragma("unroll") for (int k = 0; k < 2; ++k) \
        acc[ai][bj][m][n] = __builtin_amdgcn_mfma_f32_16x16x32_bf16(Bt[n][k], At[m][k], acc[ai][bj][m][n], 0, 0, 0); __builtin_amdgcn_s_setprio(0); } while (0)
#define PG8_WAIT_V(n) asm volatile("s_waitcnt vmcnt(" #n ")" ::: "memory")
#define PG8_WAIT_L(n) asm volatile("s_waitcnt lgkmcnt(" #n ")" ::: "memory")
#define PG8_BAR __builtin_amdgcn_s_barrier()
#define PG8_SCHED __builtin_amdgcn_sched_barrier(0)
    Unit cur, nxt; int ui = 0;
    if (!S.next(0, cur)) return;
    f32x4 acc[2][2][4][2];
#pragma unroll
    for (int a = 0; a < 2; ++a)
#pragma unroll
        for (int b = 0; b < 2; ++b)
#pragma unroll
            for (int m = 0; m < 4; ++m)
#pragma unroll
                for (int n = 0; n < 2; ++n) acc[a][b][m][n] = (f32x4){0.f, 0.f, 0.f, 0.f};
    bf16x8 At[4][2], B0[2][2], B1[2][2];
    const char* cA = (const char*)g.A + (size_t)cur.pm * tstep; const char* cB = (const char*)g.Bt + (size_t)cur.pn * tstep;
    S.a_ready(cur);
    if constexpr (SP2) {
        PG8_STAGE(PG8_SB(0, 0), cB, voffB); PG8_STAGE(PG8_SB(0, 1), cB + hstep, voffB); PG8_STAGE(PG8_SA(0, 0), cA, voffA); PG8_STAGE(PG8_SA(0, 1), cA + hstep, voffA);
        if (wr == 1) PG8_BAR;
        PG8_WAIT_V(2); PG8_BAR;
        PG8_STAGE(PG8_SB(1, 0), cB + kstep, voffB); PG8_STAGE(PG8_SA(1, 0), cA + kstep, voffA); PG8_STAGE(PG8_SB(1, 1), cB + hstep + kstep, voffB);
        PG8_WAIT_V(6); PG8_BAR;
    } else {
        PG8_STAGE(PG8_SB(0, 0), cB, voffB); PG8_STAGE(PG8_SA(0, 0), cA, voffA); PG8_STAGE(PG8_SB(0, 1), cB + hstep, voffB); PG8_STAGE(PG8_SA(0, 1), cA + hstep, voffA);
        if (wr == 1) PG8_BAR;
        PG8_WAIT_V(4); PG8_BAR;
        PG8_STAGE(PG8_SB(1, 0), cB + kstep, voffB); PG8_STAGE(PG8_SA(1, 0), cA + kstep, voffA); PG8_STAGE(PG8_SB(1, 1), cB + hstep + kstep, voffB);
        PG8_WAIT_V(6); PG8_BAR;
    }
    for (;;) {
        const bool has_next = S.next(ui + 1, nxt);
        const char* nA = has_next ? (const char*)g.A + (size_t)nxt.pm * tstep : cA; const char* nB = has_next ? (const char*)g.Bt + (size_t)nxt.pn * tstep : cB;
        for (int t = 0; t < nt; t += 2) {
            if constexpr (Epi::MID) { if (t == (nt >> 1)) E.mid(acc, cur, wr, wc, fr, fq); }
            const bool last = (t == nt - 2);
            const char* a1 = cA + (size_t)(t + 1) * kstep;
            const char* a2 = last ? nA : cA + (size_t)(t + 2) * kstep; const char* b2 = last ? nB : cB + (size_t)(t + 2) * kstep;
            const char* a3 = a2 + kstep; const char* b3 = b2 + kstep;
            if (last && has_next) S.a_ready(nxt);
            if constexpr (SP2) {
            PG8_LDB(B0, 0, 0); PG8_LDB(B1, 0, 1); PG8_SCHED; PG8_LDA(At, 0, 0); PG8_STAGE(PG8_SA(1, 1), a1 + hstep, voffA);
            PG8_WAIT_V(8); PG8_WAIT_L(0); PG8_BAR; PG8_MMA(0, 0, At, B0); PG8_MMA(0, 1, At, B1); PG8_BAR; PG8_SCHED;
            PG8_LDA(At, 0, 1); PG8_STAGE(PG8_SB(0, 0), b2, voffB); PG8_STAGE(PG8_SB(0, 1), b2 + hstep, voffB); PG8_STAGE(PG8_SA(0, 0), a2, voffA);
            PG8_WAIT_V(8); PG8_WAIT_L(0); PG8_BAR; PG8_MMA(1, 0, At, B0); PG8_MMA(1, 1, At, B1); PG8_BAR; PG8_SCHED;
            PG8_LDB(B0, 1, 0); PG8_LDB(B1, 1, 1); PG8_SCHED; PG8_LDA(At, 1, 0); PG8_STAGE(PG8_SA(0, 1), a2 + hstep, voffA);
            PG8_WAIT_V(8); PG8_WAIT_L(0); PG8_BAR; PG8_MMA(0, 0, At, B0); PG8_MMA(0, 1, At, B1); PG8_BAR; PG8_SCHED;
            PG8_LDA(At, 1, 1); PG8_STAGE(PG8_SB(1, 0), b3, voffB); PG8_STAGE(PG8_SB(1, 1), b3 + hstep, voffB); PG8_STAGE(PG8_SA(1, 0), a3, voffA);
            PG8_WAIT_V(8); PG8_WAIT_L(0); PG8_BAR; PG8_MMA(1, 0, At, B0); PG8_MMA(1, 1, At, B1); PG8_BAR; PG8_SCHED;
            } else {
            PG8_LDB(B0, 0, 0); PG8_SCHED; PG8_LDA(At, 0, 0); PG8_STAGE(PG8_SA(1, 1), a1 + hstep, voffA);
            PG8_WAIT_L(8); PG8_BAR; PG8_WAIT_L(0); PG8_MMA(0, 0, At, B0); PG8_BAR; PG8_SCHED;
            PG8_LDB(B1, 0, 1); PG8_STAGE(PG8_SB(0, 0), b2, voffB);
            PG8_BAR; PG8_WAIT_L(0); PG8_MMA(0, 1, At, B1); PG8_BAR;
            PG8_LDA(At, 0, 1); PG8_STAGE(PG8_SA(0, 0), a2, voffA);
            PG8_BAR; PG8_WAIT_L(0); PG8_MMA(1, 0, At, B0); PG8_BAR; PG8_SCHED;
            PG8_STAGE(PG8_SB(0, 1), b2 + hstep, voffB);
            PG8_WAIT_V(6); PG8_BAR; PG8_MMA(1, 1, At, B1); PG8_BAR;
            PG8_LDB(B0, 1, 0); PG8_SCHED; PG8_LDA(At, 1, 0); PG8_STAGE(PG8_SA(0, 1), a2 + hstep, voffA);
            PG8_WAIT_L(8); PG8_BAR; PG8_WAIT_L(0); PG8_MMA(0, 0, At, B0); PG8_BAR; PG8_SCHED;
            PG8_LDB(B1, 1, 1); PG8_STAGE(PG8_SB(1, 0), b3, voffB);
            PG8_BAR; PG8_WAIT_L(0); PG8_MMA(0, 1, At, B1); PG8_BAR;
            PG8_LDA(At, 1, 1); PG8_STAGE(PG8_SA(1, 0), a3, voffA);
            PG8_BAR; PG8_WAIT_L(0); PG8_MMA(1, 0, At, B0); PG8_BAR; PG8_SCHED;
            PG8_STAGE(PG8_SB(1, 1), b3 + hstep, voffB);
            PG8_WAIT_V(6); PG8_BAR; PG8_MMA(1, 1, At, B1); PG8_BAR;
            }
        }
        if constexpr (ALIGN_EPI) { if (wr == 0) PG8_BAR; }
        if constexpr (!Epi::AFTER_DRAIN) { E(acc, cur, wr, wc, fr, fq); S.done(cur); }
        if (!has_next) break;
#pragma unroll
        for (int a = 0; a < 2; ++a)
#pragma unroll
            for (int b = 0; b < 2; ++b)
#pragma unroll
                for (int m = 0; m < 4; ++m)
#pragma unroll
                    for (int n = 0; n < 2; ++n) acc[a][b][m][n] = (f32x4){0.f, 0.f, 0.f, 0.f};
        cur = nxt; cA = nA; cB = nB; ++ui;
        if constexpr (ALIGN_EPI) { if (wr == 1) PG8_BAR; }
    }
    PG8_WAIT_V(0);
    if constexpr (!ALIGN_EPI) { if (wr == 0) PG8_BAR; }
    PG8_BAR;
    if constexpr (Epi::AFTER_DRAIN) { E.fused(acc, cur, wr, wc, fr, fq, lds, wid, lane); S.done(cur); }
#undef PG8_SA
#undef PG8_SB
#undef PG8_STAGE
#undef PG8_LDA
#undef PG8_LDB
#undef PG8_MMA
#undef PG8_WAIT_V
#undef PG8_WAIT_L
#undef PG8_BAR
#undef PG8_SCHED
}
}

#define LAS __attribute__((address_space(3)))
typedef unsigned short bf16;
using pg8::f32x4; using pg8::u32x4; using pg8::pkbf; using pg8::silu_f; using pg8::MPROMPT;
typedef unsigned u32x2 __attribute__((ext_vector_type(2)));
constexpr int NWAVES = 8, NT = 512;
constexpr int M = 81920, D = 1024, FF = 2816, NGU = 5632, NIN = 3328, NPROJ = 3088;
constexpr float LN_EPS = 1e-5f, RMS_EPS = 1e-6f;
constexpr size_t MiB = 1u << 20;
constexpr size_t WS_W = 1 * MiB, W_LAYER = 42 * MiB;
constexpr size_t OW_GU1 = 0, OW_D1 = 11534336, OW_IN = 17301504, OW_OUT = 24117248, OW_GU2 = 26214400, OW_D2 = 37748736;
constexpr size_t WS_XB = 85 * MiB, WS_R = 245 * MiB, WS_QKV = WS_R, WS_Z = WS_R + 240 * MiB, WS_RAW = WS_R + 320 * MiB, WS_H = WS_R;
constexpr size_t WS_Y = 725 * MiB;
constexpr size_t WS_XT = 725 * MiB, WS_BT = 805 * MiB, WS_BTOK = 845 * MiB, WS_CTOK = 885 * MiB;
constexpr size_t WS_CUM = 925 * MiB, WS_DTA = 930 * MiB, WS_WST = 935 * MiB;
constexpr size_t WS_DT = 940 * MiB, WS_SSQ = 945 * MiB, WS_TB = 946 * MiB, WS_END = 948 * MiB;
constexpr size_t WS_PREV = WS_RAW;
constexpr int LDS_BYTES = 155648;

#define LDS_WAIT() asm volatile("s_waitcnt lgkmcnt(0)" ::: "memory")
__device__ __forceinline__ float bf_lo(unsigned u) { return __uint_as_float(u << 16); }
__device__ __forceinline__ float bf_hi(unsigned u) { return __uint_as_float(u & 0xffff0000u); }
__device__ __forceinline__ float bf2f(bf16 v) { return __uint_as_float(((unsigned)v) << 16); }
__device__ __forceinline__ bf16 f2bf(float f) { return (bf16)(pkbf(f, 0.f) & 0xffffu); }
__device__ __forceinline__ float wave_sum(float v) {
#pragma unroll
    for (int o = 1; o < 64; o <<= 1) v += __shfl_xor(v, o);
    return v;
}
__device__ __forceinline__ float wave_max(float v) {
#pragma unroll
    for (int o = 1; o < 64; o <<= 1) v = fmaxf(v, __shfl_xor(v, o));
    return v;
}

struct Params { const float* in[24]; float* out; unsigned char* ws; };
__device__ __forceinline__ unsigned long long karg_u64(int i) { int j = i; asm volatile("" : "+s"(j)); const __attribute__((address_space(4))) unsigned long long* ka = (const __attribute__((address_space(4))) unsigned long long*)__builtin_amdgcn_kernarg_segment_ptr(); return ka[j]; }
#define KIN(i) ((const float*)karg_u64(i))
#define KOUT() ((float*)karg_u64(24))
#define KWS() ((unsigned char*)karg_u64(25))

__device__ __forceinline__ void tr_item(const float* W, int ldw, int ncols, bf16* WT, int Kdst, int k0, int n0, int drow, LAS float* scr, int lane) {
    int n = n0 + (lane & 31); n = n < ncols ? n : ncols - 1;
#pragma unroll 8
    for (int i = 0; i < 32; ++i) { const int kk = 2 * i + (lane >> 5); scr[kk * 33 + (lane & 31)] = W[(size_t)(k0 + kk) * ldw + n]; }
    LDS_WAIT(); asm volatile("" ::: "memory");
    const int c = lane & 7;
#pragma unroll
    for (int j = 0; j < 4; ++j) { const int nn = (lane >> 3) + 8 * j; const LAS float* s = scr + (8 * c) * 33 + nn;
        u32x4 o; o.x = pkbf(s[0 * 33], s[1 * 33]); o.y = pkbf(s[2 * 33], s[3 * 33]); o.z = pkbf(s[4 * 33], s[5 * 33]); o.w = pkbf(s[6 * 33], s[7 * 33]);
        *(u32x4*)(WT + (size_t)(drow + nn) * Kdst + k0 + 8 * c) = o; }
    LDS_WAIT(); asm volatile("" ::: "memory");
}
constexpr int IT_GU = 16 * 88, IT_D = 44 * 32, IT_IN = 16 * 97, IT_OUT = 16 * 32, IT_LAYER = 6 * IT_GU + IT_IN + IT_OUT;
__device__ __forceinline__ void prologue_item(unsigned char* wsb, int it, LAS float* scr, int lane) {
    const int l = it / IT_LAYER; int r = it % IT_LAYER;
    unsigned char* wl = wsb + WS_W + (size_t)l * W_LAYER;
    if (r < 2 * IT_GU) { const int up = r >= IT_GU; r -= up * IT_GU; const int kb = r / 88, nb = r % 88, n0 = 32 * nb;
        tr_item(KIN(up ? 3 : 2) + (size_t)l * D * FF, FF, FF, (bf16*)(wl + OW_GU1), D, 64 * kb, n0, 256 * (n0 >> 7) + (n0 & 127) + 128 * up, scr, lane); return; }
    r -= 2 * IT_GU;
    if (r < IT_D) { const int kb = r / 32, nb = r % 32; tr_item(KIN(4) + (size_t)l * FF * D, D, D, (bf16*)(wl + OW_D1), FF, 64 * kb, 32 * nb, 32 * nb, scr, lane); return; }
    r -= IT_D;
    if (r < IT_IN) { const int kb = r / 97, nb = r % 97; tr_item(KIN(7) + (size_t)l * D * NPROJ, NPROJ, NPROJ, (bf16*)(wl + OW_IN), D, 64 * kb, 32 * nb, 32 * nb, scr, lane); return; }
    r -= IT_IN;
    if (r < IT_OUT) { const int kb = r / 32, nb = r % 32; tr_item(KIN(16) + (size_t)l * D * D, D, D, (bf16*)(wl + OW_OUT), D, 64 * kb, 32 * nb, 32 * nb, scr, lane); return; }
    r -= IT_OUT;
    if (r < 2 * IT_GU) { const int up = r >= IT_GU; r -= up * IT_GU; const int kb = r / 88, nb = r % 88, n0 = 32 * nb;
        tr_item(KIN(up ? 20 : 19) + (size_t)l * D * FF, FF, FF, (bf16*)(wl + OW_GU2), D, 64 * kb, n0, 256 * (n0 >> 7) + (n0 & 127) + 128 * up, scr, lane); return; }
    r -= 2 * IT_GU;
    { const int kb = r / 32, nb = r % 32; tr_item(KIN(21) + (size_t)l * FF * D, D, D, (bf16*)(wl + OW_D2), FF, 64 * kb, 32 * nb, 32 * nb, scr, lane); }
}
__device__ __forceinline__ void row_to_bf16(const float* xrow, bf16* orow, int lane) {
    const f32x4* xr = (const f32x4*)xrow + lane; u32x2* o8 = (u32x2*)orow + lane;
#pragma unroll
    for (int j = 0; j < 4; ++j) { const f32x4 v = xr[64 * j]; u32x2 w; w.x = pkbf(v[0], v[1]); w.y = pkbf(v[2], v[3]); o8[64 * j] = w; }
}
__device__ __forceinline__ void ln_row(float* xrow, bf16* orow, const float* g, const float* b, int lane) {
    f32x4* xr = (f32x4*)xrow + lane; f32x4 v[4]; float s = 0.f;
#pragma unroll
    for (int j = 0; j < 4; ++j) { v[j] = xr[64 * j]; s += (v[j][0] + v[j][1]) + (v[j][2] + v[j][3]); }
    const float mean = wave_sum(s) * (1.f / D); float s2 = 0.f;
#pragma unroll
    for (int j = 0; j < 4; ++j) { v[j] = v[j] - mean; s2 += (v[j][0] * v[j][0] + v[j][1] * v[j][1]) + (v[j][2] * v[j][2] + v[j][3] * v[j][3]); }
    const float rstd = 1.f / sqrtf(wave_sum(s2) * (1.f / D) + LN_EPS);
    u32x2* o8 = (u32x2*)orow + lane;
#pragma unroll
    for (int j = 0; j < 4; ++j) { const f32x4 gv = ((const f32x4*)g)[lane + 64 * j], bv = ((const f32x4*)b)[lane + 64 * j];
        const f32x4 o = v[j] * rstd * gv + bv; xr[64 * j] = o; u32x2 w; w.x = pkbf(o[0], o[1]); w.y = pkbf(o[2], o[3]); o8[64 * j] = w; }
}

__device__ __forceinline__ void seq_of_row(int m, int& s0, int& T) { if (m < MPROMPT) { s0 = m & ~2047; T = 2048; } else { s0 = MPROMPT + ((m - MPROMPT) & ~4095); T = 4096; } }
__device__ __forceinline__ void conv8(const bf16* raw, int m, int tl, int T, int c0, const float* cw, const float* cb, float (&o)[8]) {
    const f32x4 b0 = *(const f32x4*)(cb + c0), b1 = *(const f32x4*)(cb + c0 + 4);
    float a[8] = {b0[0], b0[1], b0[2], b0[3], b1[0], b1[1], b1[2], b1[3]};
#pragma unroll
    for (int j = 0; j < 5; ++j) { const int tt = tl + j - 2;
        if (tt >= 0 && tt < T) { const u32x4 v = *(const u32x4*)(raw + (size_t)(m + j - 2) * 1024 + c0);
            const f32x4 w0 = *(const f32x4*)(cw + j * 1024 + c0), w1 = *(const f32x4*)(cw + j * 1024 + c0 + 4);
            a[0] += bf_lo(v.x) * w0[0]; a[1] += bf_hi(v.x) * w0[1]; a[2] += bf_lo(v.y) * w0[2]; a[3] += bf_hi(v.y) * w0[3];
            a[4] += bf_lo(v.z) * w1[0]; a[5] += bf_hi(v.z) * w1[1]; a[6] += bf_lo(v.w) * w1[2]; a[7] += bf_hi(v.w) * w1[3]; } }
#pragma unroll
    for (int e = 0; e < 8; ++e) o[e] = silu_f(a[e]);
}
__device__ __forceinline__ float softplus_f(float x) { return x > 20.f ? x : log1pf(expf(x)); }

constexpr int SCAN_DIR_F = 10368;
__device__ __forceinline__ void scan_naive_unit(int b, int h, const bf16* raw, const float* DT, float* Y, const float* cw, const float* cb, const float* dt_bias, const float* a_log, const float* d_skip, LAS float* L, int tid, int wave, int lane) {
    int s0, T; if (b < 32) { s0 = b * 2048; T = 2048; } else { s0 = MPROMPT + (b - 32) * 4096; T = 4096; }
    const int g = h >> 2, dir = wave >> 2, pb = wave & 3, p = pb * 16 + (lane & 15), nq = lane >> 4;
    const float a = -expf(a_log[dir * 8 + h]), dskip = d_skip[h], dtb = dt_bias[dir * 8 + h];
    float s[32];
#pragma unroll
    for (int k = 0; k < 32; ++k) s[k] = 0.f;
    LAS float* Lw = L + dir * SCAN_DIR_F;
    const int nblk = T >> 5;
    for (int blk = 0; blk < nblk; ++blk) {
        __syncthreads();
        const int tbase = dir == 0 ? 32 * blk : T - 32 * (blk + 1);
        { const int r_ = tid & 255, tok = r_ >> 3, part = r_ & 7, tl = tbase + tok, m = s0 + tl; float o[8];
          conv8(raw, m, tl, T, 512 + 128 * g + 16 * part, cw, cb, o);
#pragma unroll
          for (int e = 0; e < 8; ++e) Lw[tok * 128 + 16 * part + e] = o[e];
          conv8(raw, m, tl, T, 512 + 128 * g + 16 * part + 8, cw, cb, o);
#pragma unroll
          for (int e = 0; e < 8; ++e) Lw[tok * 128 + 16 * part + 8 + e] = o[e];
          conv8(raw, m, tl, T, 768 + 128 * g + 16 * part, cw, cb, o);
#pragma unroll
          for (int e = 0; e < 8; ++e) Lw[4096 + tok * 128 + 16 * part + e] = o[e];
          conv8(raw, m, tl, T, 768 + 128 * g + 16 * part + 8, cw, cb, o);
#pragma unroll
          for (int e = 0; e < 8; ++e) Lw[4096 + tok * 128 + 16 * part + 8 + e] = o[e];
          conv8(raw, m, tl, T, h * 64 + 8 * part, cw, cb, o);
#pragma unroll
          for (int e = 0; e < 8; ++e) Lw[8192 + tok * 64 + 8 * part + e] = o[e];
          if (part == 0) { const float dtv = softplus_f(DT[(size_t)m * 16 + dir * 8 + h] + dtb); Lw[10240 + tok] = dtv; Lw[10272 + tok] = expf(dtv * a); }
        }
        __syncthreads();
        for (int i = 0; i < 32; ++i) {
            const int ti = dir == 0 ? i : 31 - i;
            const float d = Lw[10272 + ti], dtv = Lw[10240 + ti], xv = Lw[8192 + ti * 64 + p], xdt = xv * dtv;
            float y = 0.f;
#pragma unroll
            for (int k4 = 0; k4 < 8; ++k4) { const f32x4 bv = *(const LAS f32x4*)(Lw + ti * 128 + 32 * nq + 4 * k4), cv = *(const LAS f32x4*)(Lw + 4096 + ti * 128 + 32 * nq + 4 * k4);
#pragma unroll
                for (int e = 0; e < 4; ++e) { s[4 * k4 + e] = s[4 * k4 + e] * d + xdt * bv[e]; y += s[4 * k4 + e] * cv[e]; } }
            y += __shfl_xor(y, 16); y += __shfl_xor(y, 32);
            if (nq == 0) atomicAdd(Y + (size_t)(s0 + tbase + ti) * 512 + h * 64 + p, y + (dir == 0 ? dskip * xv : 0.f));
        }
    }
}

__device__ __forceinline__ void attn_naive_unit(int m, int wave, int lane, const bf16* QKV, const float* rpb, const float* gattn, bf16* MIX, LAS float* Ps, volatile LAS float* exch, int parity) {
    const int h = wave; int s0, T; seq_of_row(m, s0, T);
    const int tl = m - s0, r = tl >> 6, qc = tl & 63, rows = T >> 6;
    const int cstart = min(max(qc - 8, 0), 48), rs = min(max(r - 4, 0), rows - 8);
    float q[64];
    { const bf16* qp = QKV + (size_t)m * 1536 + h * 64;
#pragma unroll
      for (int i = 0; i < 8; ++i) { const u32x4 v = *(const u32x4*)(qp + 8 * i); q[8 * i] = bf_lo(v.x); q[8 * i + 1] = bf_hi(v.x); q[8 * i + 2] = bf_lo(v.y); q[8 * i + 3] = bf_hi(v.y);
          q[8 * i + 4] = bf_lo(v.z); q[8 * i + 5] = bf_hi(v.z); q[8 * i + 6] = bf_lo(v.w); q[8 * i + 7] = bf_hi(v.w); } }
    float sc[2];
#pragma unroll
    for (int k2 = 0; k2 < 2; ++k2) { const int kk = lane + 64 * k2, kri = kk >> 4, kci = kk & 15; const int kt = s0 + (rs + kri) * 64 + cstart + kci;
        const bf16* kp = QKV + (size_t)kt * 1536 + 512 + h * 64; float d = 0.f;
#pragma unroll
        for (int i = 0; i < 8; ++i) { const u32x4 v = *(const u32x4*)(kp + 8 * i);
            d += q[8 * i] * bf_lo(v.x) + q[8 * i + 1] * bf_hi(v.x) + q[8 * i + 2] * bf_lo(v.y) + q[8 * i + 3] * bf_hi(v.y) + q[8 * i + 4] * bf_lo(v.z) + q[8 * i + 5] * bf_hi(v.z) + q[8 * i + 6] * bf_lo(v.w) + q[8 * i + 7] * bf_hi(v.w); }
        sc[k2] = d + rpb[h * 465 + (rs + kri - r + 7) * 31 + (cstart + kci - qc + 15)]; }
    const float mx = wave_max(fmaxf(sc[0], sc[1]));
    const float p0 = __expf(sc[0] - mx), p1 = __expf(sc[1] - mx);
    const float inv = 1.f / wave_sum(p0 + p1);
    Ps[lane] = p0 * inv; Ps[lane + 64] = p1 * inv;
    LDS_WAIT(); asm volatile("" ::: "memory");
    float o = 0.f; const bf16* vbase = QKV + 1024 + h * 64 + lane;
#pragma unroll 4
    for (int kk = 0; kk < 128; kk += 4) { const f32x4 pv = *(const LAS f32x4*)(Ps + kk); const int kt = s0 + (rs + (kk >> 4)) * 64 + cstart + (kk & 15);
#pragma unroll
        for (int e = 0; e < 4; ++e) o += pv[e] * bf2f(vbase[(size_t)(kt + e) * 1536]); }
    const float ssq = wave_sum(o * o);
    if (lane == 0) exch[parity * 8 + h] = ssq;
    __syncthreads();
    float tot = 0.f;
#pragma unroll
    for (int i = 0; i < 8; ++i) tot += exch[parity * 8 + i];
    const float scl = 1.f / sqrtf(tot * (1.f / 512.f) + RMS_EPS);
    MIX[(size_t)m * 1024 + h * 64 + lane] = f2bf(o * scl * gattn[h * 64 + lane]);
}


typedef short bf16x8v __attribute__((ext_vector_type(8)));
typedef short s16x4v __attribute__((ext_vector_type(4)));
#define MFMA16(a, b, c) __builtin_amdgcn_mfma_f32_16x16x32_bf16((a), (b), (c), 0, 0, 0)
constexpr int VPITCH = 144, VHEAD = 512 * VPITCH;
__device__ __forceinline__ void attn_fast_unit(int u, const bf16* QKV, const float* TB  , const float* gattn, bf16* MIX, float* SSQA, LAS unsigned char* lds, int tid, int wave, int lane) {
    const int hp = u / 1280, gr = u % 1280;
    int s0, rows, r;
    if (gr < 1024) { s0 = (gr >> 5) * 2048; r = gr & 31; rows = 32; } else { const int g2 = gr - 1024; s0 = MPROMPT + (g2 >> 6) * 4096; r = g2 & 63; rows = 64; }
    const int rs = min(max(r - 4, 0), rows - 8);
    __syncthreads();
    { u32x4 v[16];
#pragma unroll
      for (int i = 0; i < 16; ++i) { const int id = i * 512 + tid, c = id & 7, key = (id >> 3) & 511, hh = id >> 12;
          v[i] = *(const u32x4*)(QKV + (size_t)(s0 + rs * 64 + key) * 1536 + 1024 + (2 * hp + hh) * 64 + 8 * c); }
#pragma unroll
      for (int i = 0; i < 16; ++i) { const int id = i * 512 + tid, c = id & 7, key = (id >> 3) & 511, hh = id >> 12;
          *(LAS u32x4*)(lds + hh * VHEAD + key * VPITCH + 16 * c) = v[i]; } }
    __syncthreads();
    const int hh = wave >> 2, j = wave & 3, h = 2 * hp + hh, fr = lane & 15, fq = lane >> 4;
    const int kstart = j == 0 ? 0 : (j == 1 ? 8 : (j == 2 ? 24 : 32));
    const int qtok = s0 + r * 64 + 16 * j + fr;
    const bf16x8v q0 = *(const bf16x8v*)(QKV + (size_t)qtok * 1536 + h * 64 + 8 * fq), q1 = *(const bf16x8v*)(QKV + (size_t)qtok * 1536 + h * 64 + 32 + 8 * fq);
    f32x4 sacc[16];
    const float* tb = TB + (size_t)((h * 4 + j) * 15 + (rs - r + 7)) * 512 + fr * 32 + 4 * fq;
#pragma unroll
    for (int kt = 0; kt < 16; ++kt) { const int kri = kt >> 1; const size_t ktok = (size_t)(s0 + (rs + kri) * 64 + kstart + 16 * (kt & 1) + fr);
        const bf16x8v k0 = *(const bf16x8v*)(QKV + ktok * 1536 + 512 + h * 64 + 8 * fq), k1 = *(const bf16x8v*)(QKV + ktok * 1536 + 512 + h * 64 + 32 + 8 * fq);
        f32x4 a = {0.f, 0.f, 0.f, 0.f}; a = MFMA16(k0, q0, a); a = MFMA16(k1, q1, a);
        sacc[kt] = a + *(const f32x4*)(tb + kri * 512 + 16 * (kt & 1)); }
    float mx = -INFINITY;
#pragma unroll
    for (int kt = 0; kt < 16; ++kt) mx = fmaxf(mx, fmaxf(fmaxf(sacc[kt][0], sacc[kt][1]), fmaxf(sacc[kt][2], sacc[kt][3])));
    mx = fmaxf(mx, __shfl_xor(mx, 16)); mx = fmaxf(mx, __shfl_xor(mx, 32));
    float l = 0.f;
#pragma unroll
    for (int kt = 0; kt < 16; ++kt) {
#pragma unroll
        for (int i = 0; i < 4; ++i) { const float pz = __builtin_amdgcn_exp2f(sacc[kt][i] - mx); sacc[kt][i] = pz; l += pz; } }
    l += __shfl_xor(l, 16); l += __shfl_xor(l, 32);
    f32x4 o[4];
#pragma unroll
    for (int dt = 0; dt < 4; ++dt) o[dt] = (f32x4){0.f, 0.f, 0.f, 0.f};
    const LAS unsigned char* vb = lds + hh * VHEAD + (kstart + 4 * fq + ((lane & 15) >> 2)) * VPITCH + 8 * (lane & 3);
#pragma unroll
    for (int ks = 0; ks < 8; ++ks) {
        u32x4 pw; pw.x = pkbf(sacc[2 * ks][0], sacc[2 * ks][1]); pw.y = pkbf(sacc[2 * ks][2], sacc[2 * ks][3]); pw.z = pkbf(sacc[2 * ks + 1][0], sacc[2 * ks + 1][1]); pw.w = pkbf(sacc[2 * ks + 1][2], sacc[2 * ks + 1][3]);
        const bf16x8v pf = __builtin_bit_cast(bf16x8v, pw);
#pragma unroll
        for (int dt = 0; dt < 4; ++dt) {
            const s16x4v lo = __builtin_amdgcn_ds_read_tr16_b64_v4i16((LAS s16x4v*)(vb + ks * 64 * VPITCH + 32 * dt));
            const s16x4v hi = __builtin_amdgcn_ds_read_tr16_b64_v4i16((LAS s16x4v*)(vb + (ks * 64 + 16) * VPITCH + 32 * dt));
            const bf16x8v vf = __builtin_shufflevector(lo, hi, 0, 1, 2, 3, 4, 5, 6, 7);
            o[dt] = MFMA16(vf, pf, o[dt]); } }
    const float inv = 1.f / l; float ssq = 0.f;
#pragma unroll
    for (int dt = 0; dt < 4; ++dt) { o[dt] = o[dt] * inv; ssq += (o[dt][0] * o[dt][0] + o[dt][1] * o[dt][1]) + (o[dt][2] * o[dt][2] + o[dt][3] * o[dt][3]); }
    ssq += __shfl_xor(ssq, 16); ssq += __shfl_xor(ssq, 32);
    if (fq == 0) atomicAdd(SSQA + qtok, ssq);
#pragma unroll
    for (int dt = 0; dt < 4; ++dt) { const f32x4 gv = *(const f32x4*)(gattn + h * 64 + 16 * dt + 4 * fq); const f32x4 ov = o[dt] * gv;
        u32x2 w; w.x = pkbf(ov[0], ov[1]); w.y = pkbf(ov[2], ov[3]); *(u32x2*)(MIX + (size_t)qtok * 1024 + h * 64 + 16 * dt + 4 * fq) = w; }
}

typedef float f32x16 __attribute__((ext_vector_type(16)));
#define MFMA32(a, b, c) __builtin_amdgcn_mfma_f32_32x32x16_bf16((a), (b), (c), 0, 0, 0)
constexpr float LOG2E = 1.4426950408889634f;
constexpr int TPITCH = 272;
__device__ __forceinline__ void conv_item(int it, const bf16* RAW, const float* DTraw, const float* cw, const float* cb, const float* dt_bias, const float* a_log,
                                          bf16* XT, bf16* BT, bf16* BTOK, bf16* CTOK, float* CUM, float* DTA, float* WST, LAS unsigned char* lds, int tid, int wave, int lane) {
    const int ck = it >> 3, sl = it & 7, m0 = ck * 128; int s0, T; seq_of_row(m0, s0, T); const int tl0 = m0 - s0;
    const int cg = tid & 15, tg = tid >> 4, c0 = 128 * sl + 8 * cg;
    float x[8][8];
#pragma unroll
    for (int i = 0; i < 8; ++i) { const int tt = tl0 + 4 * tg - 2 + i; u32x4 v = {0u, 0u, 0u, 0u};
        if (tt >= 0 && tt < T) v = *(const u32x4*)(RAW + (size_t)(s0 + tt) * 1024 + c0);
        x[i][0] = bf_lo(v.x); x[i][1] = bf_hi(v.x); x[i][2] = bf_lo(v.y); x[i][3] = bf_hi(v.y); x[i][4] = bf_lo(v.z); x[i][5] = bf_hi(v.z); x[i][6] = bf_lo(v.w); x[i][7] = bf_hi(v.w); }
    float o[4][8];
    { const f32x4 b0 = *(const f32x4*)(cb + c0), b1 = *(const f32x4*)(cb + c0 + 4);
#pragma unroll
      for (int tk = 0; tk < 4; ++tk) { o[tk][0] = b0[0]; o[tk][1] = b0[1]; o[tk][2] = b0[2]; o[tk][3] = b0[3]; o[tk][4] = b1[0]; o[tk][5] = b1[1]; o[tk][6] = b1[2]; o[tk][7] = b1[3]; }
#pragma unroll
      for (int j = 0; j < 5; ++j) { const f32x4 w0 = *(const f32x4*)(cw + j * 1024 + c0), w1 = *(const f32x4*)(cw + j * 1024 + c0 + 4);
#pragma unroll
          for (int tk = 0; tk < 4; ++tk) { o[tk][0] += x[tk + j][0] * w0[0]; o[tk][1] += x[tk + j][1] * w0[1]; o[tk][2] += x[tk + j][2] * w0[2]; o[tk][3] += x[tk + j][3] * w0[3];
              o[tk][4] += x[tk + j][4] * w1[0]; o[tk][5] += x[tk + j][5] * w1[1]; o[tk][6] += x[tk + j][6] * w1[2]; o[tk][7] += x[tk + j][7] * w1[3]; } }
#pragma unroll
      for (int tk = 0; tk < 4; ++tk)
#pragma unroll
          for (int e = 0; e < 8; ++e) o[tk][e] = silu_f(o[tk][e]); }
    __syncthreads();
    if (sl >= 4) { bf16* dst = (sl < 6 ? BTOK : CTOK) + (size_t)(m0 + 4 * tg) * 256 + 128 * (sl & 1) + 8 * cg;
#pragma unroll
        for (int tk = 0; tk < 4; ++tk) { u32x4 w; w.x = pkbf(o[tk][0], o[tk][1]); w.y = pkbf(o[tk][2], o[tk][3]); w.z = pkbf(o[tk][4], o[tk][5]); w.w = pkbf(o[tk][6], o[tk][7]); *(u32x4*)(dst + (size_t)tk * 256) = w; } }
    if (sl < 6) {
#pragma unroll
        for (int e = 0; e < 8; ++e) { u32x2 w; w.x = pkbf(o[0][e], o[1][e]); w.y = pkbf(o[2][e], o[3][e]); *(LAS u32x2*)(lds + (8 * cg + e) * TPITCH + 8 * tg) = w; }
        __syncthreads();
        bf16* dbase = sl < 4 ? XT + ((size_t)ck * 512 + 128 * sl) * 128 : BT + ((size_t)ck * 256 + 128 * (sl - 4)) * 128;
#pragma unroll
        for (int i = 0; i < 4; ++i) { const int id = i * 512 + tid, row = id >> 4, pc = id & 15; *(u32x4*)(dbase + (size_t)row * 128 + 8 * pc) = *(const LAS u32x4*)(lds + row * TPITCH + 16 * pc); }
    }
    if (sl == 0) {
#pragma unroll
        for (int q = 0; q < 2; ++q) { const int sr = 2 * wave + q, dir = sr >> 3;
            const float a = -expf(a_log[sr]) * LOG2E, bias = dt_bias[sr];
            const float dt0 = softplus_f(DTraw[(size_t)(m0 + 2 * lane) * 16 + sr] + bias), dt1 = softplus_f(DTraw[(size_t)(m0 + 2 * lane + 1) * 16 + sr] + bias);
            const float v0 = dt0 * a, v1 = dt1 * a; float inc = v0 + v1;
#pragma unroll
            for (int ofs = 1; ofs < 64; ofs <<= 1) { const float t = __shfl_up(inc, ofs); if (lane >= ofs) inc += t; }
            const float excl = inc - (v0 + v1), total = __shfl(inc, 63);
            float c0_, c1_;
            if (dir == 0) { c0_ = excl + v0; c1_ = inc; } else { c0_ = total - excl; c1_ = total - excl - v0; }
            const float tot = total;
            const size_t off = ((size_t)ck * 16 + sr) * 128 + 2 * lane;
            *(pg8::f32x2e*)(CUM + off) = (pg8::f32x2e){c0_, c1_}; *(pg8::f32x2e*)(DTA + off) = (pg8::f32x2e){dt0, dt1};
            *(pg8::f32x2e*)(WST + off) = (pg8::f32x2e){__builtin_amdgcn_exp2f(tot - c0_) * dt0, __builtin_amdgcn_exp2f(tot - c1_) * dt1}; }
    }
}
__device__ __forceinline__ void s12_unit(int u, const bf16* XT, const bf16* BT, const float* CUM, const float* WST, bf16* PREV, int wave, int lane) {
    int b, h, dir, c0, nc;
    if (u < 64) { b = u >> 4; h = (u & 15) >> 1; dir = u & 1; c0 = 512 + b * 32; nc = 32; } else { const int v = u - 64; b = v >> 4; h = (v & 15) >> 1; dir = v & 1; c0 = b * 16; nc = 16; }
    const int g = h >> 2, sr = dir * 8 + h, pt = wave >> 2, nt = wave & 3, r = lane & 31, hh = lane >> 5;
    f32x16 prev;
#pragma unroll
    for (int i = 0; i < 16; ++i) prev[i] = 0.f;
    for (int ci = 0; ci < nc; ++ci) { const int ck = dir == 0 ? c0 + ci : c0 + nc - 1 - ci;
        bf16* pp = PREV + (((size_t)ck * 8 + h) * 2 + dir) * 8192 + (32 * pt + r) * 128 + 32 * nt + 4 * hh;
#pragma unroll
        for (int q = 0; q < 4; ++q) { u32x2 w; w.x = pkbf(prev[4 * q], prev[4 * q + 1]); w.y = pkbf(prev[4 * q + 2], prev[4 * q + 3]); *(u32x2*)(pp + 8 * q) = w; }
        f32x16 st;
#pragma unroll
        for (int i = 0; i < 16; ++i) st[i] = 0.f;
        const bf16* bp = BT + ((size_t)ck * 256 + 128 * g + 32 * nt + r) * 128 + 8 * hh;
        const bf16* xp = XT + ((size_t)ck * 512 + 64 * h + 32 * pt + r) * 128 + 8 * hh;
        const float* wp = WST + ((size_t)ck * 16 + sr) * 128 + 8 * hh;
#pragma unroll
        for (int kk = 0; kk < 8; ++kk) { const bf16x8v bf = *(const bf16x8v*)(bp + 16 * kk); const u32x4 xr = *(const u32x4*)(xp + 16 * kk);
            const f32x4 w0 = *(const f32x4*)(wp + 16 * kk), w1 = *(const f32x4*)(wp + 16 * kk + 4);
            u32x4 xw; xw.x = pkbf(bf_lo(xr.x) * w0[0], bf_hi(xr.x) * w0[1]); xw.y = pkbf(bf_lo(xr.y) * w0[2], bf_hi(xr.y) * w0[3]);
            xw.z = pkbf(bf_lo(xr.z) * w1[0], bf_hi(xr.z) * w1[1]); xw.w = pkbf(bf_lo(xr.w) * w1[2], bf_hi(xr.w) * w1[3]);
            st = MFMA32(bf, __builtin_bit_cast(bf16x8v, xw), st); }
        const float cd = __builtin_amdgcn_exp2f(CUM[((size_t)ck * 16 + sr) * 128 + (dir == 0 ? 127 : 0)]);
        prev = prev * cd + st;
    }
}
constexpr int S3_BM = 0, S3_CM = 34816, S3_XT = 69632, S3_CUM = 139264, S3_DT = 143360;
__device__ __forceinline__ void s3_unit(int u, const bf16* XT, const bf16* BTOK, const bf16* CTOK, const float* CUM, const float* DTA, const bf16* PREV, const bf16* Zb, const float* d_skip, const float* gssm,
                                        bf16* MIX, float* SSQS, LAS unsigned char* lds, int tid, int wave, int lane_) {
    int lane = lane_; asm volatile("" : "+v"(lane));
    const int ck = u >> 1, g = u & 1, m0 = ck * 128;
    __syncthreads();
    { asm volatile("" : "+v"(tid));
      u32x4 vb[4], vc[4], vx[8];
#pragma unroll
      for (int i = 0; i < 4; ++i) { const int id = i * 512 + tid, row = id >> 4, pc = id & 15; vb[i] = *(const u32x4*)(BTOK + (size_t)(m0 + row) * 256 + 128 * g + 8 * pc); vc[i] = *(const u32x4*)(CTOK + (size_t)(m0 + row) * 256 + 128 * g + 8 * pc); }
#pragma unroll
      for (int i = 0; i < 8; ++i) { const int id = i * 512 + tid, row = id >> 4, pc = id & 15; vx[i] = *(const u32x4*)(XT + ((size_t)ck * 512 + 256 * g + row) * 128 + 8 * pc); }
      const int a4 = tid & 255, hl_ = a4 >> 6, dr_ = (a4 >> 5) & 1, e4 = a4 & 31;
      const f32x4 vs = *(const f32x4*)((tid < 256 ? CUM : DTA) + ((size_t)ck * 16 + dr_ * 8 + 4 * g + hl_) * 128 + 4 * e4);
#pragma unroll
      for (int i = 0; i < 4; ++i) { const int id = i * 512 + tid, row = id >> 4, pc = id & 15; *(LAS u32x4*)(lds + S3_BM + row * TPITCH + 16 * pc) = vb[i]; *(LAS u32x4*)(lds + S3_CM + row * TPITCH + 16 * pc) = vc[i]; }
#pragma unroll
      for (int i = 0; i < 8; ++i) { const int id = i * 512 + tid, row = id >> 4, pc = id & 15; *(LAS u32x4*)(lds + S3_XT + row * TPITCH + 16 * pc) = vx[i]; }
      *(LAS f32x4*)(lds + (tid < 256 ? S3_CUM : S3_DT) + ((hl_ * 2 + dr_) * 128 + 4 * e4) * 4) = vs; }
    __syncthreads();
    const int hl = wave >> 1, half = wave & 1, h = 4 * g + hl, r = lane & 31, hh = lane >> 5;
    const float dskip = d_skip[h];
    const LAS float* cumf = (const LAS float*)(lds + S3_CUM) + (hl * 2) * 128; const LAS float* cumb = cumf + 128;
    const LAS float* dtf = (const LAS float*)(lds + S3_DT) + (hl * 2) * 128; const LAS float* dtb = dtf + 128;
    for (int lbi = 0; lbi < 2; ++lbi) { const int lb = 2 * half + lbi, l = 32 * lb + r;
        const float Af_l = cumf[l], Sb_l = cumb[l];
        bf16x8v cf[8];
#pragma unroll
        for (int kk = 0; kk < 8; ++kk) cf[kk] = *(const LAS bf16x8v*)(lds + S3_CM + l * TPITCH + 32 * kk + 16 * hh);
        f32x16 yacc[2];
#pragma unroll
        for (int pb = 0; pb < 2; ++pb)
#pragma unroll
            for (int i = 0; i < 16; ++i) yacc[pb][i] = 0.f;
#pragma unroll
        for (int sb = 0; sb < 4; ++sb) {
            f32x16 cbt;
#pragma unroll
            for (int i = 0; i < 16; ++i) cbt[i] = 0.f;
#pragma unroll
            for (int kk = 0; kk < 8; ++kk) { const bf16x8v bmf = *(const LAS bf16x8v*)(lds + S3_BM + (32 * sb + r) * TPITCH + 32 * kk + 16 * hh); cbt = MFMA32(bmf, cf[kk], cbt); }
#pragma unroll
            for (int q = 0; q < 4; ++q) { const int sbase = 32 * sb + 8 * q + 4 * hh;
                const f32x4 af = *(const LAS f32x4*)(cumf + sbase), sbv = *(const LAS f32x4*)(cumb + sbase), df = *(const LAS f32x4*)(dtf + sbase), db = *(const LAS f32x4*)(dtb + sbase);
#pragma unroll
                for (int e = 0; e < 4; ++e) { const int sidx = sbase + e;
                    const float fw = sidx <= l ? __builtin_amdgcn_exp2f(Af_l - af[e]) * df[e] : 0.f;
                    const float bw = sidx >= l ? __builtin_amdgcn_exp2f(Sb_l - sbv[e]) * db[e] : 0.f;
                    cbt[4 * q + e] = cbt[4 * q + e] * (fw + bw) + (sidx == l ? dskip : 0.f); } }
#pragma unroll
            for (int ks = 0; ks < 2; ++ks) {
                u32x4 gw_; gw_.x = pkbf(cbt[8 * ks], cbt[8 * ks + 1]); gw_.y = pkbf(cbt[8 * ks + 2], cbt[8 * ks + 3]); gw_.z = pkbf(cbt[8 * ks + 4], cbt[8 * ks + 5]); gw_.w = pkbf(cbt[8 * ks + 6], cbt[8 * ks + 7]);
                const bf16x8v gf = __builtin_bit_cast(bf16x8v, gw_);
#pragma unroll
                for (int pb = 0; pb < 2; ++pb) { const LAS unsigned char* xa = lds + S3_XT + (64 * hl + 32 * pb + r) * TPITCH + 2 * (32 * sb + 16 * ks + 4 * hh);
                    const s16x4v lo = *(const LAS s16x4v*)xa, hi = *(const LAS s16x4v*)(xa + 16);
                    yacc[pb] = MFMA32(__builtin_shufflevector(lo, hi, 0, 1, 2, 3, 4, 5, 6, 7), gf, yacc[pb]); } }
        }
#pragma unroll
        for (int dir = 0; dir < 2; ++dir) { const float el = __builtin_amdgcn_exp2f(dir == 0 ? Af_l : Sb_l);
#pragma unroll
            for (int pb = 0; pb < 2; ++pb) { f32x16 ua;
#pragma unroll
                for (int i = 0; i < 16; ++i) ua[i] = 0.f;
                const bf16* pp = PREV + (((size_t)ck * 8 + h) * 2 + dir) * 8192 + (32 * pb + r) * 128 + 8 * hh;
#pragma unroll
                for (int kk = 0; kk < 8; ++kk) { const bf16x8v pf = *(const bf16x8v*)(pp + 16 * kk); ua = MFMA32(pf, cf[kk], ua); }
                yacc[pb] = yacc[pb] + ua * el; } }
        const size_t mrow = (size_t)(m0 + l); float ssq = 0.f;
#pragma unroll
        for (int pb = 0; pb < 2; ++pb)
#pragma unroll
            for (int q = 0; q < 4; ++q) { const int pc = h * 64 + 32 * pb + 8 * q + 4 * hh; const u32x2 zv = *(const u32x2*)(Zb + mrow * 512 + pc); const f32x4 gv = *(const f32x4*)(gssm + pc);
                const float v0 = yacc[pb][4 * q] * silu_f(bf_lo(zv.x)), v1 = yacc[pb][4 * q + 1] * silu_f(bf_hi(zv.x)), v2 = yacc[pb][4 * q + 2] * silu_f(bf_lo(zv.y)), v3 = yacc[pb][4 * q + 3] * silu_f(bf_hi(zv.y));
                ssq += (v0 * v0 + v1 * v1) + (v2 * v2 + v3 * v3);
                u32x2 w; w.x = pkbf(v0 * gv[0], v1 * gv[1]); w.y = pkbf(v2 * gv[2], v3 * gv[3]); *(u32x2*)(MIX + mrow * 1024 + 512 + pc) = w; }
        ssq += __shfl_xor(ssq, 32);
        if (hh == 0) atomicAdd(SSQS + mrow, ssq);
    }
}

__device__ __forceinline__ void gate_norm_row(int m, int lane, const float* Y, const bf16* Z, const float* g, bf16* MIX) {
    const f32x4 y0 = *(const f32x4*)(Y + (size_t)m * 512 + 8 * lane), y1 = *(const f32x4*)(Y + (size_t)m * 512 + 8 * lane + 4);
    const u32x4 zv = *(const u32x4*)(Z + (size_t)m * 512 + 8 * lane);
    float v[8] = {y0[0] * silu_f(bf_lo(zv.x)), y0[1] * silu_f(bf_hi(zv.x)), y0[2] * silu_f(bf_lo(zv.y)), y0[3] * silu_f(bf_hi(zv.y)),
                  y1[0] * silu_f(bf_lo(zv.z)), y1[1] * silu_f(bf_hi(zv.z)), y1[2] * silu_f(bf_lo(zv.w)), y1[3] * silu_f(bf_hi(zv.w))};
    float ss = 0.f;
#pragma unroll
    for (int e = 0; e < 8; ++e) ss += v[e] * v[e];
    const float scl = 1.f / sqrtf(wave_sum(ss) * (1.f / 512.f) + RMS_EPS);
    const f32x4 g0 = *(const f32x4*)(g + 8 * lane), g1 = *(const f32x4*)(g + 8 * lane + 4);
    u32x4 w; w.x = pkbf(v[0] * scl * g0[0], v[1] * scl * g0[1]); w.y = pkbf(v[2] * scl * g0[2], v[3] * scl * g0[3]);
    w.z = pkbf(v[4] * scl * g1[0], v[5] * scl * g1[1]); w.w = pkbf(v[6] * scl * g1[2], v[7] * scl * g1[3]);
    *(u32x4*)(MIX + (size_t)m * 1024 + 512 + 8 * lane) = w;
}

#define FRESH_IDS() int tid = threadIdx.x; asm volatile("" : "+v"(tid)); int G = gridDim.x, bx = blockIdx.x; asm volatile("" : "+s"(G), "+s"(bx)); \
    const int lane = tid & 63, wave = __builtin_amdgcn_readfirstlane(tid >> 6), gw = bx * NWAVES + wave, NGW = G * NWAVES; (void)gw; (void)lane; (void)NGW; \
    unsigned char* ws = KWS(); float* out = KOUT(); (void)out; \
    bf16* XB = (bf16*)(ws + WS_XB); bf16* Hb = (bf16*)(ws + WS_H); bf16* QKV = (bf16*)(ws + WS_QKV); bf16* Zb = (bf16*)(ws + WS_Z); bf16* RAW = (bf16*)(ws + WS_RAW); \
    float* Yb = (float*)(ws + WS_Y); float* DTb = (float*)(ws + WS_DT); (void)XB; (void)Hb; (void)QKV; (void)Zb; (void)RAW; (void)Yb; (void)DTb
template <int l> __device__ __forceinline__ void layer_body(LAS unsigned char* lds) {
    cg::grid_group grid = cg::this_grid();
        { FRESH_IDS(); pg8::Gemm g{XB, (const bf16*)(ws + WS_W + (size_t)l * W_LAYER + OW_GU1), M, NGU, D}; pg8::StaticOrder S; S.init(M, NGU, (int)gridDim.x, (int)blockIdx.x); pg8::EpiSwiGLU E{Hb, FF};
          pg8::gemm_phase<pg8::EpiSwiGLU, pg8::StaticOrder, true, true>(lds, g, S, E); }
        grid.sync();
        { FRESH_IDS(); pg8::Gemm g{Hb, (const bf16*)(ws + WS_W + (size_t)l * W_LAYER + OW_D1), M, D, FF}; pg8::StaticOrder S; S.init(M, D, (int)gridDim.x, (int)blockIdx.x);
          pg8::EpiResid E{l == 0 ? KIN(0) : out, l == 0 ? KIN(1) - (size_t)MPROMPT * D : out, out, 0.5f};
          pg8::gemm_phase<pg8::EpiResid, pg8::StaticOrder, true, true>(lds, g, S, E); }
        grid.sync();
        { FRESH_IDS(); const float* g_ = KIN(5) + l * D; const float* b_ = KIN(6) + l * D;
          for (int m = gw; m < M; m += NGW) ln_row(out + (size_t)m * D, XB + (size_t)m * D, g_, b_, lane);
          const f32x4 z4 = {0.f, 0.f, 0.f, 0.f};
          f32x4* sz = (f32x4*)(ws + WS_SSQ); for (int i = bx * NT + tid; i < 2 * M / 4; i += G * NT) sz[i] = z4; }
        grid.sync();
        { FRESH_IDS(); pg8::Gemm g{XB, (const bf16*)(ws + WS_W + (size_t)l * W_LAYER + OW_IN), M, NIN, D}; pg8::StaticOrder S; S.init(M, NIN, (int)gridDim.x, (int)blockIdx.x); pg8::EpiProj E{QKV, Zb, RAW, DTb};
          pg8::gemm_phase<pg8::EpiProj, pg8::StaticOrder, true, true>(lds, g, S, E); }
        grid.sync();
        { FRESH_IDS();
          for (int it = bx; it < 640 * 8; it += G)
              conv_item(it, RAW, DTb, KIN(8) + (size_t)l * 5 * 1024, KIN(9) + l * 1024, KIN(10) + l * 16, KIN(11) + l * 16, (bf16*)(ws + WS_XT), (bf16*)(ws + WS_BT), (bf16*)(ws + WS_BTOK), (bf16*)(ws + WS_CTOK),
                        (float*)(ws + WS_CUM), (float*)(ws + WS_DTA), (float*)(ws + WS_WST), lds, tid, wave, lane);
          { const int per = (5120 + G - 1) / G; const int u0 = bx * per, u1 = min(u0 + per, 5120);
            for (int u = u0; u < u1; ++u) attn_fast_unit(u, QKV, (const float*)(ws + WS_TB) + (size_t)l * 8 * 4 * 15 * 512, KIN(14) + l * 512, XB, (float*)(ws + WS_SSQ), lds, tid, wave, lane); } }
        grid.sync();
        { FRESH_IDS();
          for (int i = 0; i < 3; ++i) { int u = bx + i * G; if (G == 256 && i == 2) u = (bx >= 64 && bx < 128) ? 512 + bx - 64 : 576; if (u >= 576) break;
              s12_unit(u, (const bf16*)(ws + WS_XT), (const bf16*)(ws + WS_BT), (const float*)(ws + WS_CUM), (const float*)(ws + WS_WST), (bf16*)(ws + WS_PREV), wave, lane); } }
        grid.sync();
        { FRESH_IDS();
          for (int u = bx; u < 1280; u += G)
              s3_unit(u, (const bf16*)(ws + WS_XT), (const bf16*)(ws + WS_BTOK), (const bf16*)(ws + WS_CTOK), (const float*)(ws + WS_CUM), (const float*)(ws + WS_DTA), (const bf16*)(ws + WS_PREV), Zb,
                      KIN(12) + l * 8, KIN(13) + l * 512, XB, (float*)(ws + WS_SSQ) + M, lds, tid, wave, lane); }
        grid.sync();
        { FRESH_IDS(); const float* ssq = (const float*)(ws + WS_SSQ);
          for (int m = gw; m < M; m += NGW) { const float sa = 1.f / sqrtf(ssq[m] * (1.f / 512.f) + RMS_EPS), ss = 1.f / sqrtf(ssq[M + m] * (1.f / 512.f) + RMS_EPS);
              u32x4* rowp = (u32x4*)(XB + (size_t)m * 1024) + lane;
#pragma unroll
              for (int hf = 0; hf < 2; ++hf) { const float f = hf ? ss : sa; u32x4 v = rowp[64 * hf];
                  v.x = pkbf(bf_lo(v.x) * f, bf_hi(v.x) * f); v.y = pkbf(bf_lo(v.y) * f, bf_hi(v.y) * f); v.z = pkbf(bf_lo(v.z) * f, bf_hi(v.z) * f); v.w = pkbf(bf_lo(v.w) * f, bf_hi(v.w) * f); rowp[64 * hf] = v; } } }
        grid.sync();
        { FRESH_IDS(); pg8::Gemm g{XB, (const bf16*)(ws + WS_W + (size_t)l * W_LAYER + OW_OUT), M, D, D}; pg8::StaticOrder S; S.init(M, D, (int)gridDim.x, (int)blockIdx.x); pg8::EpiResid E{out, out, out, 1.0f};
          pg8::gemm_phase<pg8::EpiResid, pg8::StaticOrder, true, true>(lds, g, S, E); }
        grid.sync();
        { FRESH_IDS(); const float* g_ = KIN(17) + l * D; const float* b_ = KIN(18) + l * D;
          for (int m = gw; m < M; m += NGW) ln_row(out + (size_t)m * D, XB + (size_t)m * D, g_, b_, lane); }
        grid.sync();
        { FRESH_IDS(); pg8::Gemm g{XB, (const bf16*)(ws + WS_W + (size_t)l * W_LAYER + OW_GU2), M, NGU, D}; pg8::StaticOrder S; S.init(M, NGU, (int)gridDim.x, (int)blockIdx.x); pg8::EpiSwiGLU E{Hb, FF};
          pg8::gemm_phase<pg8::EpiSwiGLU, pg8::StaticOrder, true, true>(lds, g, S, E); }
        grid.sync();
        { FRESH_IDS(); pg8::Gemm g{Hb, (const bf16*)(ws + WS_W + (size_t)l * W_LAYER + OW_D2), M, D, FF}; pg8::StaticOrder S; S.init(M, D, (int)gridDim.x, (int)blockIdx.x); pg8::EpiResid E{out, out, out, 0.5f};
          pg8::gemm_phase<pg8::EpiResid, pg8::StaticOrder, true, true>(lds, g, S, E); }
        grid.sync();
        { FRESH_IDS(); const float* g_ = KIN(22) + l * D; const float* b_ = KIN(23) + l * D;
          for (int m = gw; m < M; m += NGW) ln_row(out + (size_t)m * D, XB + (size_t)m * D, g_, b_, lane); }
        if (l == 0) grid.sync();
}

__global__ void __launch_bounds__(NT, 2) fwd_mega(Params P) {
    extern __shared__ __attribute__((aligned(16))) unsigned char lds_raw[];
    LAS unsigned char* lds = (LAS unsigned char*)lds_raw;
    cg::grid_group grid = cg::this_grid();
    { FRESH_IDS(); LAS float* scr = (LAS float*)(lds + wave * 16384);
      for (int it = gw; it < 2 * IT_LAYER; it += NGW) prologue_item(ws, it, scr, lane);
      { float* TBw = (float*)(ws + WS_TB);
        for (int i = bx * NT + tid; i < 2 * 8 * 4 * 15 * 512; i += G * NT) { const int kc = i & 31, q = (i >> 5) & 15; int t = i >> 9; const int ro = t % 15; t /= 15; const int j = t & 3; t >>= 2; const int h = t & 7, l = t >> 3;
            const int kstart = j == 0 ? 0 : (j == 1 ? 8 : (j == 2 ? 24 : 32)), qcol = 16 * j + q, kcol = kstart + kc, cst = min(max(qcol - 8, 0), 48);
            const bool valid = kcol >= cst && kcol < cst + 16;
            TBw[i] = valid ? 1.4426950408889634f * KIN(15)[((l * 8 + h) * 15 + ro) * 31 + (kcol - qcol + 15)] : -INFINITY; } }
      for (int m = gw; m < M; m += NGW) { const float* src = m < MPROMPT ? KIN(0) + (size_t)m * D : KIN(1) + (size_t)(m - MPROMPT) * D; row_to_bf16(src, XB + (size_t)m * D, lane); } }
    grid.sync();

    layer_body<0>(lds);
    layer_body<1>(lds);
}

extern "C" void kernel_launch(void* const* d_in, const int* in_sizes, int n_in, void* d_out, int out_size, void* d_ws, size_t ws_size, hipStream_t stream) {
    static int grid_blocks = 0;
    if (grid_blocks == 0) {
        if (n_in != 24 || out_size != M * D || ws_size < WS_END) { fprintf(stderr, "kernel_launch: unexpected shapes (n_in %d out %d ws %zu)\n", n_in, out_size, ws_size); grid_blocks = -1; return; }
        int dev = 0, cus = 0, per_cu = 0;
        (void)hipGetDevice(&dev); (void)hipDeviceGetAttribute(&cus, hipDeviceAttributeMultiprocessorCount, dev);
        if (hipFuncSetAttribute((const void*)fwd_mega, hipFuncAttributeMaxDynamicSharedMemorySize, LDS_BYTES) != hipSuccess) { fprintf(stderr, "kernel_launch: hipFuncSetAttribute failed\n"); grid_blocks = -1; return; }
        if (hipOccupancyMaxActiveBlocksPerMultiprocessor(&per_cu, (const void*)fwd_mega, NT, LDS_BYTES) != hipSuccess || per_cu < 1) { fprintf(stderr, "kernel_launch: occupancy query gave %d\n", per_cu); per_cu = 1; }
        (void)hipGetLastError();
        grid_blocks = cus * per_cu;
    }
    if (grid_blocks < 0) return;
    Params p{};
    for (int i = 0; i < 24; ++i) p.in[i] = (const float*)d_in[i];
    p.out = (float*)d_out; p.ws = (unsigned char*)d_ws;
    void* args[] = {&p};
    hipError_t e = hipLaunchCooperativeKernel((const void*)fwd_mega, dim3(grid_blocks), dim3(NT), args, LDS_BYTES, stream);
    if (e != hipSuccess) fprintf(stderr, "cooperative launch failed: %s (grid %d)\n", hipGetErrorString(e), grid_blocks);
}
```

```cpp
#include <hip/hip_runtime.h>
#include <hip/hip_cooperative_groups.h>
#include <cstdio>
#include <cstdint>
namespace cg = cooperative_groups;
namespace pg8 {
#define PG8_LAS __attribute__((address_space(3)))
typedef unsigned short bf16_t;
typedef short bf16x8 __attribute__((ext_vector_type(8)));
typedef float f32x4 __attribute__((ext_vector_type(4)));
typedef unsigned u32x4 __attribute__((ext_vector_type(4)));
constexpr int BM = 256, BK = 64, HALF = 128, HTB = HALF * BK * 2  , STAGE_BYTES = 8 * HTB, NXCD = 8, WGM = 8;

__host__ __device__ __forceinline__ int lds_byte(int r, int c) { const int st = (r >> 4) * 2 + (c >> 5), rr = r & 15, cc = c & 31, ob = rr * 64 + cc * 2; return st * 1024 + (ob ^ (((ob >> 9) & 1) << 5)); }
__host__ __device__ __forceinline__ void stage_rc(int b, int& R, int& C) { const int st = b / 1024, sb = b % 1024, swz = sb ^ (((sb >> 9) & 1) << 5); R = (st >> 1) * 16 + swz / 64; C = (st & 1) * 32 + (swz % 64) / 2; }
__host__ __device__ __forceinline__ int perm32(int rho) { const int n = rho >> 4, i = rho & 15; return 8 * (i >> 2) + 4 * n + (i & 3); }

struct Unit { int pm, pn; };
struct Gemm { const bf16_t* A; const bf16_t* Bt; int M, N, K; };

struct StaticOrder {
    int nM, nN, nwg, G, c;
    __host__ __device__ void init(int M, int N, int G_, int c_) { nM = M / BM; nN = N / BM; nwg = nM * nN; G = G_; c = c_; }
    __host__ __device__ bool next(int i, Unit& u) const {
        const long L = (long)i * G + c; if (L >= nwg) return false;
        int wgid = (int)L; { const int q = nwg / NXCD, r = nwg % NXCD, xcd = wgid % NXCD, off = wgid / NXCD; wgid = (xcd < r ? xcd * (q + 1) : r * (q + 1) + (xcd - r) * q) + off; }
        const int nig = WGM * nN, gid = wgid / nig, fm = gid * WGM, gsz = (nM - fm) < WGM ? (nM - fm) : WGM;
        u.pm = fm + ((wgid % nig) % gsz); u.pn = (wgid % nig) / gsz; return true;
    }
    __device__ __forceinline__ void a_ready(const Unit&) const {}
    __device__ __forceinline__ void done(const Unit&) const {}
};

typedef float f32x2e __attribute__((ext_vector_type(2)));
typedef __bf16 bf16x2e __attribute__((ext_vector_type(2)));
__device__ __forceinline__ unsigned pkbf(float a, float b) { f32x2e v = {a, b}; bf16x2e r = __builtin_convertvector(v, bf16x2e); return __builtin_bit_cast(unsigned, r); }
__device__ __forceinline__ float silu_f(float g) { return g * __builtin_amdgcn_rcpf(1.f + __builtin_amdgcn_exp2f(-1.4426950408889634f * g)); }
constexpr float ALPHA_F = 1.4142135623730951f;
constexpr int MPROMPT = 65536;

struct EpiSwiGLU {
    static constexpr bool PERM = true, AFTER_DRAIN = false, MID = false;
    bf16_t* H; int ldh;
    __device__ __forceinline__ void operator()(const f32x4 (&acc)[2][2][4][2], const Unit& u, int wr, int wc, int fr, int fq) const {
        const int row0 = u.pm * BM + wr * 64 + fr, col0 = u.pn * HALF + wc * 32 + 8 * fq;
#pragma unroll
        for (int ai = 0; ai < 2; ++ai)
#pragma unroll
            for (int m = 0; m < 4; ++m) {
                bf16_t* p = H + (size_t)(row0 + ai * HALF + m * 16) * ldh + col0;
                const f32x4 g0 = acc[ai][0][m][0], g1 = acc[ai][0][m][1], u0 = acc[ai][1][m][0], u1 = acc[ai][1][m][1];
                u32x4 w;
                w.x = pkbf(silu_f(g0[0]) * u0[0], silu_f(g0[1]) * u0[1]); w.y = pkbf(silu_f(g0[2]) * u0[2], silu_f(g0[3]) * u0[3]);
                w.z = pkbf(silu_f(g1[0]) * u1[0], silu_f(g1[1]) * u1[1]); w.w = pkbf(silu_f(g1[2]) * u1[2], silu_f(g1[3]) * u1[3]);
                *(u32x4*)p = w;
            }
    }
};
struct EpiResid {
    static constexpr bool PERM = false, AFTER_DRAIN = false, MID = false;
    const float* r0; const float* r1; float* out; float scale;
    __device__ __forceinline__ void operator()(const f32x4 (&acc)[2][2][4][2], const Unit& u, int wr, int wc, int fr, int fq) const {
        const float* rbase = (u.pm * BM < MPROMPT) ? r0 : r1;
#pragma unroll
        for (int ai = 0; ai < 2; ++ai)
#pragma unroll
            for (int m = 0; m < 4; ++m) {
                const size_t roff = (size_t)(u.pm * BM + ai * HALF + wr * 64 + m * 16 + fr) * 1024;
#pragma unroll
                for (int bj = 0; bj < 2; ++bj)
#pragma unroll
                    for (int n = 0; n < 2; ++n) {
                        const int c = u.pn * BM + bj * HALF + wc * 32 + n * 16 + 4 * fq;
                        const f32x4 b = *(const f32x4*)(rbase + roff + c);
                        *(f32x4*)(out + roff + c) = b * ALPHA_F + acc[ai][bj][m][n] * scale;
                    }
            }
    }
};
struct EpiResidBf {
    static constexpr bool PERM = true, AFTER_DRAIN = false, MID = false;
    bf16_t* X; float scale;
    __device__ __forceinline__ void operator()(const f32x4 (&acc)[2][2][4][2], const Unit& u, int wr, int wc, int fr, int fq) const {
        const int row0 = u.pm * BM + wr * 64 + fr, col0 = u.pn * BM + wc * 32 + 8 * fq;
#pragma unroll
        for (int ai = 0; ai < 2; ++ai)
#pragma unroll
            for (int m = 0; m < 4; ++m) { bf16_t* rowp = X + (size_t)(row0 + ai * HALF + m * 16) * 1024 + col0;
#pragma unroll
                for (int bj = 0; bj < 2; ++bj) { const u32x4 xv = *(const u32x4*)(rowp + bj * HALF); const f32x4 a0 = acc[ai][bj][m][0] * scale, a1 = acc[ai][bj][m][1] * scale;
                    u32x4 w;
                    w.x = pkbf(__uint_as_float(xv.x << 16) * ALPHA_F + a0[0], __uint_as_float(xv.x & 0xffff0000u) * ALPHA_F + a0[1]);
                    w.y = pkbf(__uint_as_float(xv.y << 16) * ALPHA_F + a0[2], __uint_as_float(xv.y & 0xffff0000u) * ALPHA_F + a0[3]);
                    w.z = pkbf(__uint_as_float(xv.z << 16) * ALPHA_F + a1[0], __uint_as_float(xv.z & 0xffff0000u) * ALPHA_F + a1[1]);
                    w.w = pkbf(__uint_as_float(xv.w << 16) * ALPHA_F + a1[2], __uint_as_float(xv.w & 0xffff0000u) * ALPHA_F + a1[3]);
                    *(u32x4*)(rowp + bj * HALF) = w; } }
    }
};
struct EpiResidMix {
    static constexpr bool PERM = false, AFTER_DRAIN = false, MID = true;
    float* out; const float* ssq;
    __device__ __forceinline__ void mid(f32x4 (&acc)[2][2][4][2], const Unit& u, int wr, int wc, int fr, int fq) const {
#pragma unroll
        for (int ai = 0; ai < 2; ++ai)
#pragma unroll
            for (int m = 0; m < 4; ++m) { const int r = u.pm * BM + ai * HALF + wr * 64 + m * 16 + fr;
                const float f = sqrtf((ssq[81920 + r] * (1.f / 512.f) + 1e-6f) / (ssq[r] * (1.f / 512.f) + 1e-6f));
#pragma unroll
                for (int bj = 0; bj < 2; ++bj)
#pragma unroll
                    for (int n = 0; n < 2; ++n) acc[ai][bj][m][n] = acc[ai][bj][m][n] * f; }
    }
    __device__ __forceinline__ void operator()(const f32x4 (&acc)[2][2][4][2], const Unit& u, int wr, int wc, int fr, int fq) const {
#pragma unroll
        for (int ai = 0; ai < 2; ++ai)
#pragma unroll
            for (int m = 0; m < 4; ++m) { const int r = u.pm * BM + ai * HALF + wr * 64 + m * 16 + fr; const size_t roff = (size_t)r * 1024;
                const float f = 1.f / sqrtf(ssq[81920 + r] * (1.f / 512.f) + 1e-6f);
#pragma unroll
                for (int bj = 0; bj < 2; ++bj)
#pragma unroll
                    for (int n = 0; n < 2; ++n) { const int c = u.pn * BM + bj * HALF + wc * 32 + n * 16 + 4 * fq;
                        const f32x4 b = *(const f32x4*)(out + roff + c);
                        *(f32x4*)(out + roff + c) = b * ALPHA_F + acc[ai][bj][m][n] * f; } }
    }
};
struct EpiProj {
    static constexpr bool PERM = true, AFTER_DRAIN = false, MID = false;
    bf16_t* QKV; bf16_t* Z; bf16_t* XBC; float* DT;
    __device__ __forceinline__ void operator()(const f32x4 (&acc)[2][2][4][2], const Unit& u, int wr, int wc, int fr, int fq) const {
        const int row0 = u.pm * BM + wr * 64 + fr, pn = u.pn;
        if (pn == 12) {
            if (wc == 0 && fq < 2) {
#pragma unroll
                for (int ai = 0; ai < 2; ++ai)
#pragma unroll
                    for (int m = 0; m < 4; ++m) { float* p = DT + (size_t)(row0 + ai * HALF + m * 16) * 16 + 8 * fq;
                        *(f32x4*)p = acc[ai][0][m][0]; *(f32x4*)(p + 4) = acc[ai][0][m][1]; }
            }
            return;
        }
        bf16_t* base; int ldc, colt; float sc = 1.f;
        if (pn < 6) { base = QKV; ldc = 1536; colt = pn * 256; if (pn < 2) sc = 0.125f * 1.4426950408889634f; }
        else if (pn < 8) { base = Z; ldc = 512; colt = (pn - 6) * 256; }
        else { base = XBC; ldc = 1024; colt = (pn - 8) * 256; }
        const int col0 = colt + wc * 32 + 8 * fq;
#pragma unroll
        for (int ai = 0; ai < 2; ++ai)
#pragma unroll
            for (int m = 0; m < 4; ++m) { bf16_t* rowp = base + (size_t)(row0 + ai * HALF + m * 16) * ldc + col0;
#pragma unroll
                for (int bj = 0; bj < 2; ++bj) { const f32x4 v0 = acc[ai][bj][m][0] * sc, v1 = acc[ai][bj][m][1] * sc;
                    u32x4 w; w.x = pkbf(v0[0], v0[1]); w.y = pkbf(v0[2], v0[3]); w.z = pkbf(v1[0], v1[1]); w.w = pkbf(v1[2], v1[3]);
                    *(u32x4*)(rowp + bj * HALF) = w; } }
    }
};

template <class Epi, class Sched, bool ALIGN_EPI = false, bool SP2 = false>
__device__ __forceinline__ void gemm_phase(PG8_LAS unsigned char* lds, const Gemm g, const Sched& S, const Epi& E) {
    int tid_ = threadIdx.x; asm volatile("" : "+v"(tid_));
    const int tid = tid_, wid = __builtin_amdgcn_readfirstlane(tid >> 6), lane = tid & 63, wr = wid >> 2, wc = wid & 3, fr = lane & 15, fq = lane >> 4;
    const int K = g.K, nt = K / BK;
    unsigned voffA[2], voffB[2];
#pragma unroll
    for (int i = 0; i < 2; ++i) { int R, C; stage_rc(tid * 16 + i * 8192, R, C); const int Rb = Epi::PERM ? ((R & ~31) + perm32(R & 31)) : R;
        voffA[i] = (unsigned)(R * K + C) * 2u; voffB[i] = (unsigned)(Rb * K + C) * 2u; }
    const size_t kstep = (size_t)(BK * 2);
    const size_t hstep = (size_t)HALF * K * 2;
    const size_t tstep = 2 * hstep;
    const unsigned ldsw = (unsigned)wid * 1024u;
    const int aoff = lds_byte(wr * 64 + fr, fq * 8), boff = lds_byte(wc * 32 + fr, fq * 8);
#define PG8_SA(b, h) (((b) * 2 + (h)) * HTB)
#define PG8_SB(b, h) ((4 + (b) * 2 + (h)) * HTB)
#define PG8_STAGE(bufoff, gbase, voff) do { _Pragma("unroll") for (int _i = 0; _i < 2; ++_i) \
        __builtin_amdgcn_global_load_lds((const unsigned*)((const char*)(gbase) + (voff)[_i]), (PG8_LAS unsigned*)(lds + (bufoff) + ldsw + _i * 8192), 16, 0, 0); } while (0)
#define PG8_LDA(dst, b, h) do { _Pragma("unroll") for (int m = 0; m < 4; ++m) _Pragma("unroll") for (int k = 0; k < 2; ++k) dst[m][k] = *(const PG8_LAS bf16x8*)(lds + PG8_SA(b, h) + aoff + m * 2048 + k * 1024); } while (0)
#define PG8_LDB(dst, b, h) do { _Pragma("unroll") for (int n = 0; n < 2; ++n) _Pragma("unroll") for (int k = 0; k < 2; ++k) dst[n][k] = *(const PG8_LAS bf16x8*)(lds + PG8_SB(b, h) + boff + n * 2048 + k * 1024); } while (0)
#define PG8_MMA(ai, bj, At, Bt) do { __builtin_amdgcn_s_setprio(1); _Pragma("unroll") for (int m = 0; m < 4; ++m) _Pragma("unroll") for (int n = 0; n < 2; ++n) _Pragma("unroll") for (int k = 0; k < 2; ++k) \
        acc[ai][bj][m][n] = __builtin_amdgcn_mfma_f32_16x16x32_bf16(Bt[n][k], At[m][k], acc[ai][bj][m][n], 0, 0, 0); __builtin_amdgcn_s_setprio(0); } while (0)
#define PG8_WAIT_V(n) asm volatile("s_waitcnt vmcnt(" #n ")" ::: "memory")
#define PG8_WAIT_L(n) asm volatile("s_waitcnt lgkmcnt(" #n ")" ::: "memory")
#define PG8_BAR __builtin_amdgcn_s_barrier()
#define PG8_SCHED __builtin_amdgcn_sched_barrier(0)
    Unit cur, nxt; int ui = 0;
    if (!S.next(0, cur)) return;
    f32x4 acc[2][2][4][2];
#pragma unroll
    for (int a = 0; a < 2; ++a)
#pragma unroll
        for (int b = 0; b < 2; ++b)
#pragma unroll
            for (int m = 0; m < 4; ++m)
#pragma unroll
                for (int n = 0; n < 2; ++n) acc[a][b][m][n] = (f32x4){0.f, 0.f, 0.f, 0.f};
    bf16x8 At[4][2], B0[2][2], B1[2][2];
    const char* cA = (const char*)g.A + (size_t)cur.pm * tstep; const char* cB = (const char*)g.Bt + (size_t)cur.pn * tstep;
    S.a_ready(cur);
    if constexpr (SP2) {
        PG8_STAGE(PG8_SB(0, 0), cB, voffB); PG8_STAGE(PG8_SB(0, 1), cB + hstep, voffB); PG8_STAGE(PG8_SA(0, 0), cA, voffA); PG8_STAGE(PG8_SA(0, 1), cA + hstep, voffA);
        if (wr == 1) PG8_BAR;
        PG8_WAIT_V(2); PG8_BAR;
        PG8_STAGE(PG8_SB(1, 0), cB + kstep, voffB); PG8_STAGE(PG8_SA(1, 0), cA + kstep, voffA); PG8_STAGE(PG8_SB(1, 1), cB + hstep + kstep, voffB);
        PG8_WAIT_V(6); PG8_BAR;
    } else {
        PG8_STAGE(PG8_SB(0, 0), cB, voffB); PG8_STAGE(PG8_SA(0, 0), cA, voffA); PG8_STAGE(PG8_SB(0, 1), cB + hstep, voffB); PG8_STAGE(PG8_SA(0, 1), cA + hstep, voffA);
        if (wr == 1) PG8_BAR;
        PG8_WAIT_V(4); PG8_BAR;
        PG8_STAGE(PG8_SB(1, 0), cB + kstep, voffB); PG8_STAGE(PG8_SA(1, 0), cA + kstep, voffA); PG8_STAGE(PG8_SB(1, 1), cB + hstep + kstep, voffB);
        PG8_WAIT_V(6); PG8_BAR;
    }
    for (;;) {
        const bool has_next = S.next(ui + 1, nxt);
        const char* nA = has_next ? (const char*)g.A + (size_t)nxt.pm * tstep : cA; const char* nB = has_next ? (const char*)g.Bt + (size_t)nxt.pn * tstep : cB;
        for (int t = 0; t < nt; t += 2) {
            if constexpr (Epi::MID) { if (t == (nt >> 1)) E.mid(acc, cur, wr, wc, fr, fq); }
            const bool last = (t == nt - 2);
            const char* a1 = cA + (size_t)(t + 1) * kstep;
            const char* a2 = last ? nA : cA + (size_t)(t + 2) * kstep; const char* b2 = last ? nB : cB + (size_t)(t + 2) * kstep;
            const char* a3 = a2 + kstep; const char* b3 = b2 + kstep;
            if (last && has_next) S.a_ready(nxt);
            if constexpr (SP2) {
            PG8_LDB(B0, 0, 0); PG8_LDB(B1, 0, 1); PG8_SCHED; PG8_LDA(At, 0, 0); PG8_STAGE(PG8_SA(1, 1), a1 + hstep, voffA);
            PG8_WAIT_V(8); PG8_WAIT_L(0); PG8_BAR; PG8_MMA(0, 0, At, B0); PG8_MMA(0, 1, At, B1); PG8_BAR; PG8_SCHED;
            PG8_LDA(At, 0, 1); PG8_STAGE(PG8_SB(0, 0), b2, voffB); PG8_STAGE(PG8_SB(0, 1), b2 + hstep, voffB); PG8_STAGE(PG8_SA(0, 0), a2, voffA);
            PG8_WAIT_V(8); PG8_WAIT_L(0); PG8_BAR; PG8_MMA(1, 0, At, B0); PG8_MMA(1, 1, At, B1); PG8_BAR; PG8_SCHED;
            PG8_LDB(B0, 1, 0); PG8_LDB(B1, 1, 1); PG8_SCHED; PG8_LDA(At, 1, 0); PG8_STAGE(PG8_SA(0, 1), a2 + hstep, voffA);
            PG8_WAIT_V(8); PG8_WAIT_L(0); PG8_BAR; PG8_MMA(0, 0, At, B0); PG8_MMA(0, 1, At, B1); PG8_BAR; PG8_SCHED;
            PG8_LDA(At, 1, 1); PG8_STAGE(PG8_SB(1, 0), b3, voffB); PG8_STAGE(PG8_SB(1, 1), b3 + hstep, voffB); PG8_STAGE(PG8_SA(1, 0), a3, voffA);
            PG8_WAIT_V(8); PG8_WAIT_L(0); PG8_BAR; PG8_MMA(1, 0, At, B0); PG8_MMA(1, 1, At, B1); PG8_BAR; PG8_SCHED;
            } else {
            PG8_LDB(B0, 0, 0); PG8_SCHED; PG8_LDA(At, 0, 0); PG8_STAGE(PG8_SA(1, 1), a1 + hstep, voffA);
            PG8_WAIT_L(8); PG8_BAR; PG8_WAIT_L(0); PG8_MMA(0, 0, At, B0); PG8_BAR; PG8_SCHED;
            PG8_LDB(B1, 0, 1); PG8_STAGE(PG8_SB(0, 0), b2, voffB);
            PG8_BAR; PG8_WAIT_L(0); PG8_MMA(0, 1, At, B1); PG8_BAR;
            PG8_LDA(At, 0, 1); PG8_STAGE(PG8_SA(0, 0), a2, voffA);
            PG8_BAR; PG8_WAIT_L(0); PG8_MMA(1, 0, At, B0); PG8_BAR; PG8_SCHED;
            PG8_STAGE(PG8_SB(0, 1), b2 + hstep, voffB);
            PG8_WAIT_V(6); PG8_BAR; PG8_MMA(1, 1, At, B1); PG8_BAR;
            PG8_LDB(B0, 1, 0); PG8_SCHED; PG8_LDA(At, 1, 0); PG8_STAGE(PG8_SA(0, 1), a2 + hstep, voffA);
            PG8_WAIT_L(8); PG8_BAR; PG8_WAIT_L(0); PG8_MMA(0, 0, At, B0); PG8_BAR; PG8_SCHED;
            PG8_LDB(B1, 1, 1); PG8_STAGE(PG8_SB(1, 0), b3, voffB);
            PG8_BAR; PG8_WAIT_L(0); PG8_MMA(0, 1, At, B1); PG8_BAR;
            PG8_LDA(At, 1, 1); PG8_STAGE(PG8_SA(1, 0), a3, voffA);
            PG8_BAR; PG8_WAIT_L(0); PG8_MMA(1, 0, At, B0); PG8_BAR; PG8_SCHED;
            PG8_STAGE(PG8_SB(1, 1), b3 + hstep, voffB);
            PG8_WAIT_V(6); PG8_BAR; PG8_MMA(1, 1, At, B1); PG8_BAR;
            }
        }
        if constexpr (ALIGN_EPI) { if (wr == 0) PG8_BAR; }
        if constexpr (!Epi::AFTER_DRAIN) { E(acc, cur, wr, wc, fr, fq); S.done(cur); }
        if (!has_next) break;
#pragma unroll
        for (int a = 0; a < 2; ++a)
#pragma unroll
            for (int b = 0; b < 2; ++b)
#pragma unroll
                for (int m = 0; m < 4; ++m)
#pragma unroll
                    for (int n = 0; n < 2; ++n) acc[a][b][m][n] = (f32x4){0.f, 0.f, 0.f, 0.f};
        cur = nxt; cA = nA; cB = nB; ++ui;
        if constexpr (ALIGN_EPI) { if (wr == 1) PG8_BAR; }
    }
    PG8_WAIT_V(0);
    if constexpr (!ALIGN_EPI) { if (wr == 0) PG8_BAR; }
    PG8_BAR;
    if constexpr (Epi::AFTER_DRAIN) { E.fused(acc, cur, wr, wc, fr, fq, lds, wid, lane); S.done(cur); }
#undef PG8_SA
#undef PG8_SB
#undef PG8_STAGE
#undef PG8_LDA
#undef PG8_LDB
#undef PG8_MMA
#undef PG8_WAIT_V
#undef PG8_WAIT_L
#undef PG8_BAR
#undef PG8_SCHED
}
}

#define LAS __attribute__((address_space(3)))
typedef unsigned short bf16;
using pg8::f32x4; using pg8::u32x4; using pg8::pkbf; using pg8::silu_f; using pg8::MPROMPT;
typedef unsigned u32x2 __attribute__((ext_vector_type(2)));
constexpr int NWAVES = 8, NT = 512;
constexpr int M = 81920, D = 1024, FF = 2816, NGU = 5632, NIN = 3328, NPROJ = 3088;
constexpr float LN_EPS = 1e-5f, RMS_EPS = 1e-6f;
constexpr size_t MiB = 1u << 20;
constexpr size_t WS_W = 1 * MiB, W_LAYER = 42 * MiB;
constexpr size_t OW_GU1 = 0, OW_D1 = 11534336, OW_IN = 17301504, OW_OUT = 24117248, OW_GU2 = 26214400, OW_D2 = 37748736;
constexpr size_t WS_XB = 85 * MiB, WS_R = 245 * MiB, WS_QKV = WS_R, WS_Z = WS_R + 240 * MiB, WS_RAW = WS_R + 320 * MiB, WS_H = WS_R;
constexpr size_t WS_Y = 725 * MiB;
constexpr size_t WS_XT = 725 * MiB, WS_BT = 805 * MiB, WS_BTOK = 845 * MiB, WS_CTOK = 885 * MiB;
constexpr size_t WS_CUM = 925 * MiB, WS_DTA = 930 * MiB, WS_WST = 935 * MiB;
constexpr size_t WS_DT = 940 * MiB, WS_SSQ = 945 * MiB, WS_TB = 946 * MiB, WS_END = 948 * MiB;
constexpr size_t WS_PREV = WS_RAW;
constexpr int LDS_BYTES = 155648;

#define LDS_WAIT() asm volatile("s_waitcnt lgkmcnt(0)" ::: "memory")
__device__ __forceinline__ float bf_lo(unsigned u) { return __uint_as_float(u << 16); }
__device__ __forceinline__ float bf_hi(unsigned u) { return __uint_as_float(u & 0xffff0000u); }
__device__ __forceinline__ float bf2f(bf16 v) { return __uint_as_float(((unsigned)v) << 16); }
__device__ __forceinline__ bf16 f2bf(float f) { return (bf16)(pkbf(f, 0.f) & 0xffffu); }
__device__ __forceinline__ float wave_sum(float v) {
#pragma unroll
    for (int o = 1; o < 64; o <<= 1) v += __shfl_xor(v, o);
    return v;
}
__device__ __forceinline__ float wave_max(float v) {
#pragma unroll
    for (int o = 1; o < 64; o <<= 1) v = fmaxf(v, __shfl_xor(v, o));
    return v;
}

struct Params { const float* in[24]; float* out; unsigned char* ws; };
__device__ __forceinline__ unsigned long long karg_u64(int i) { int j = i; asm volatile("" : "+s"(j)); const __attribute__((address_space(4))) unsigned long long* ka = (const __attribute__((address_space(4))) unsigned long long*)__builtin_amdgcn_kernarg_segment_ptr(); return ka[j]; }
#define KIN(i) ((const float*)karg_u64(i))
#define KOUT() ((float*)karg_u64(24))
#define KWS() ((unsigned char*)karg_u64(25))

__device__ __forceinline__ void tr_item(const float* W, int ldw, int ncols, bf16* WT, int Kdst, int k0, int n0, int drow, LAS float* scr, int lane) {
    int n = n0 + (lane & 31); n = n < ncols ? n : ncols - 1;
#pragma unroll 8
    for (int i = 0; i < 32; ++i) { const int kk = 2 * i + (lane >> 5); scr[kk * 33 + (lane & 31)] = W[(size_t)(k0 + kk) * ldw + n]; }
    LDS_WAIT(); asm volatile("" ::: "memory");
    const int c = lane & 7;
#pragma unroll
    for (int j = 0; j < 4; ++j) { const int nn = (lane >> 3) + 8 * j; const LAS float* s = scr + (8 * c) * 33 + nn;
        u32x4 o; o.x = pkbf(s[0 * 33], s[1 * 33]); o.y = pkbf(s[2 * 33], s[3 * 33]); o.z = pkbf(s[4 * 33], s[5 * 33]); o.w = pkbf(s[6 * 33], s[7 * 33]);
        *(u32x4*)(WT + (size_t)(drow + nn) * Kdst + k0 + 8 * c) = o; }
    LDS_WAIT(); asm volatile("" ::: "memory");
}
constexpr int IT_GU = 16 * 88, IT_D = 44 * 32, IT_IN = 16 * 97, IT_OUT = 16 * 32, IT_LAYER = 6 * IT_GU + IT_IN + IT_OUT;
__device__ __forceinline__ void prologue_item(unsigned char* wsb, int it, LAS float* scr, int lane) {
    const int l = it / IT_LAYER; int r = it % IT_LAYER;
    unsigned char* wl = wsb + WS_W + (size_t)l * W_LAYER;
    if (r < 2 * IT_GU) { const int up = r >= IT_GU; r -= up * IT_GU; const int kb = r / 88, nb = r % 88, n0 = 32 * nb;
        tr_item(KIN(up ? 3 : 2) + (size_t)l * D * FF, FF, FF, (bf16*)(wl + OW_GU1), D, 64 * kb, n0, 256 * (n0 >> 7) + (n0 & 127) + 128 * up, scr, lane); return; }
    r -= 2 * IT_GU;
    if (r < IT_D) { const int kb = r / 32, nb = r % 32; tr_item(KIN(4) + (size_t)l * FF * D, D, D, (bf16*)(wl + OW_D1), FF, 64 * kb, 32 * nb, 32 * nb, scr, lane); return; }
    r -= IT_D;
    if (r < IT_IN) { const int kb = r / 97, nb = r % 97; tr_item(KIN(7) + (size_t)l * D * NPROJ, NPROJ, NPROJ, (bf16*)(wl + OW_IN), D, 64 * kb, 32 * nb, 32 * nb, scr, lane); return; }
    r -= IT_IN;
    if (r < IT_OUT) { const int kb = r / 32, nb = r % 32; tr_item(KIN(16) + (size_t)l * D * D, D, D, (bf16*)(wl + OW_OUT), D, 64 * kb, 32 * nb, 32 * nb, scr, lane); return; }
    r -= IT_OUT;
    if (r < 2 * IT_GU) { const int up = r >= IT_GU; r -= up * IT_GU; const int kb = r / 88, nb = r % 88, n0 = 32 * nb;
        tr_item(KIN(up ? 20 : 19) + (size_t)l * D * FF, FF, FF, (bf16*)(wl + OW_GU2), D, 64 * kb, n0, 256 * (n0 >> 7) + (n0 & 127) + 128 * up, scr, lane); return; }
    r -= 2 * IT_GU;
    { const int kb = r / 32, nb = r % 32; tr_item(KIN(21) + (size_t)l * FF * D, D, D, (bf16*)(wl + OW_D2), FF, 64 * kb, 32 * nb, 32 * nb, scr, lane); }
}
__device__ __forceinline__ void row_to_bf16(const float* xrow, bf16* orow, int lane) {
    const f32x4* xr = (const f32x4*)xrow + lane; u32x2* o8 = (u32x2*)orow + lane;
#pragma unroll
    for (int j = 0; j < 4; ++j) { const f32x4 v = xr[64 * j]; u32x2 w; w.x = pkbf(v[0], v[1]); w.y = pkbf(v[2], v[3]); o8[64 * j] = w; }
}
__device__ __forceinline__ void ln_row(float* xrow, bf16* orow, const float* g, const float* b, int lane) {
    f32x4* xr = (f32x4*)xrow + lane; f32x4 v[4]; float s = 0.f;
#pragma unroll
    for (int j = 0; j < 4; ++j) { v[j] = xr[64 * j]; s += (v[j][0] + v[j][1]) + (v[j][2] + v[j][3]); }
    const float mean = wave_sum(s) * (1.f / D); float s2 = 0.f;
#pragma unroll
    for (int j = 0; j < 4; ++j) { v[j] = v[j] - mean; s2 += (v[j][0] * v[j][0] + v[j][1] * v[j][1]) + (v[j][2] * v[j][2] + v[j][3] * v[j][3]); }
    const float rstd = 1.f / sqrtf(wave_sum(s2) * (1.f / D) + LN_EPS);
    u32x2* o8 = (u32x2*)orow + lane;
#pragma unroll
    for (int j = 0; j < 4; ++j) { const f32x4 gv = ((const f32x4*)g)[lane + 64 * j], bv = ((const f32x4*)b)[lane + 64 * j];
        const f32x4 o = v[j] * rstd * gv + bv; xr[64 * j] = o; u32x2 w; w.x = pkbf(o[0], o[1]); w.y = pkbf(o[2], o[3]); o8[64 * j] = w; }
}

__device__ __forceinline__ void ln_row_bf(bf16* xrow, float* fout, const float* g, const float* b, int lane) {
    u32x4* xr = (u32x4*)xrow + lane; float v[16]; float s = 0.f;
#pragma unroll
    for (int j = 0; j < 2; ++j) { const u32x4 t = xr[64 * j]; v[8 * j] = bf_lo(t.x); v[8 * j + 1] = bf_hi(t.x); v[8 * j + 2] = bf_lo(t.y); v[8 * j + 3] = bf_hi(t.y); v[8 * j + 4] = bf_lo(t.z); v[8 * j + 5] = bf_hi(t.z); v[8 * j + 6] = bf_lo(t.w); v[8 * j + 7] = bf_hi(t.w); }
#pragma unroll
    for (int e = 0; e < 16; ++e) s += v[e];
    const float mean = wave_sum(s) * (1.f / D); float s2 = 0.f;
#pragma unroll
    for (int e = 0; e < 16; ++e) { v[e] -= mean; s2 += v[e] * v[e]; }
    const float rstd = 1.f / sqrtf(wave_sum(s2) * (1.f / D) + LN_EPS);
#pragma unroll
    for (int j = 0; j < 2; ++j) { const int c = 512 * j + 8 * lane; const f32x4 g0 = *(const f32x4*)(g + c), g1 = *(const f32x4*)(g + c + 4), b0 = *(const f32x4*)(b + c), b1 = *(const f32x4*)(b + c + 4);
        const f32x4 o0 = {v[8 * j] * rstd * g0[0] + b0[0], v[8 * j + 1] * rstd * g0[1] + b0[1], v[8 * j + 2] * rstd * g0[2] + b0[2], v[8 * j + 3] * rstd * g0[3] + b0[3]};
        const f32x4 o1 = {v[8 * j + 4] * rstd * g1[0] + b1[0], v[8 * j + 5] * rstd * g1[1] + b1[1], v[8 * j + 6] * rstd * g1[2] + b1[2], v[8 * j + 7] * rstd * g1[3] + b1[3]};
        if (fout) { *(f32x4*)(fout + c) = o0; *(f32x4*)(fout + c + 4) = o1; }
        else { u32x4 w; w.x = pkbf(o0[0], o0[1]); w.y = pkbf(o0[2], o0[3]); w.z = pkbf(o1[0], o1[1]); w.w = pkbf(o1[2], o1[3]); xr[64 * j] = w; } }
}

__device__ __forceinline__ void seq_of_row(int m, int& s0, int& T) { if (m < MPROMPT) { s0 = m & ~2047; T = 2048; } else { s0 = MPROMPT + ((m - MPROMPT) & ~4095); T = 4096; } }
__device__ __forceinline__ void conv8(const bf16* raw, int m, int tl, int T, int c0, const float* cw, const float* cb, float (&o)[8]) {
    const f32x4 b0 = *(const f32x4*)(cb + c0), b1 = *(const f32x4*)(cb + c0 + 4);
    float a[8] = {b0[0], b0[1], b0[2], b0[3], b1[0], b1[1], b1[2], b1[3]};
#pragma unroll
    for (int j = 0; j < 5; ++j) { const int tt = tl + j - 2;
        if (tt >= 0 && tt < T) { const u32x4 v = *(const u32x4*)(raw + (size_t)(m + j - 2) * 1024 + c0);
            const f32x4 w0 = *(const f32x4*)(cw + j * 1024 + c0), w1 = *(const f32x4*)(cw + j * 1024 + c0 + 4);
            a[0] += bf_lo(v.x) * w0[0]; a[1] += bf_hi(v.x) * w0[1]; a[2] += bf_lo(v.y) * w0[2]; a[3] += bf_hi(v.y) * w0[3];
            a[4] += bf_lo(v.z) * w1[0]; a[5] += bf_hi(v.z) * w1[1]; a[6] += bf_lo(v.w) * w1[2]; a[7] += bf_hi(v.w) * w1[3]; } }
#pragma unroll
    for (int e = 0; e < 8; ++e) o[e] = silu_f(a[e]);
}
__device__ __forceinline__ float softplus_f(float x) { return x > 20.f ? x : log1pf(expf(x)); }

constexpr int SCAN_DIR_F = 10368;
__device__ __forceinline__ void scan_naive_unit(int b, int h, const bf16* raw, const float* DT, float* Y, const float* cw, const float* cb, const float* dt_bias, const float* a_log, const float* d_skip, LAS float* L, int tid, int wave, int lane) {
    int s0, T; if (b < 32) { s0 = b * 2048; T = 2048; } else { s0 = MPROMPT + (b - 32) * 4096; T = 4096; }
    const int g = h >> 2, dir = wave >> 2, pb = wave & 3, p = pb * 16 + (lane & 15), nq = lane >> 4;
    const float a = -expf(a_log[dir * 8 + h]), dskip = d_skip[h], dtb = dt_bias[dir * 8 + h];
    float s[32];
#pragma unroll
    for (int k = 0; k < 32; ++k) s[k] = 0.f;
    LAS float* Lw = L + dir * SCAN_DIR_F;
    const int nblk = T >> 5;
    for (int blk = 0; blk < nblk; ++blk) {
        __syncthreads();
        const int tbase = dir == 0 ? 32 * blk : T - 32 * (blk + 1);
        { const int r_ = tid & 255, tok = r_ >> 3, part = r_ & 7, tl = tbase + tok, m = s0 + tl; float o[8];
          conv8(raw, m, tl, T, 512 + 128 * g + 16 * part, cw, cb, o);
#pragma unroll
          for (int e = 0; e < 8; ++e) Lw[tok * 128 + 16 * part + e] = o[e];
          conv8(raw, m, tl, T, 512 + 128 * g + 16 * part + 8, cw, cb, o);
#pragma unroll
          for (int e = 0; e < 8; ++e) Lw[tok * 128 + 16 * part + 8 + e] = o[e];
          conv8(raw, m, tl, T, 768 + 128 * g + 16 * part, cw, cb, o);
#pragma unroll
          for (int e = 0; e < 8; ++e) Lw[4096 + tok * 128 + 16 * part + e] = o[e];
          conv8(raw, m, tl, T, 768 + 128 * g + 16 * part + 8, cw, cb, o);
#pragma unroll
          for (int e = 0; e < 8; ++e) Lw[4096 + tok * 128 + 16 * part + 8 + e] = o[e];
          conv8(raw, m, tl, T, h * 64 + 8 * part, cw, cb, o);
#pragma unroll
          for (int e = 0; e < 8; ++e) Lw[8192 + tok * 64 + 8 * part + e] = o[e];
          if (part == 0) { const float dtv = softplus_f(DT[(size_t)m * 16 + dir * 8 + h] + dtb); Lw[10240 + tok] = dtv; Lw[10272 + tok] = expf(dtv * a); }
        }
        __syncthreads();
        for (int i = 0; i < 32; ++i) {
            const int ti = dir == 0 ? i : 31 - i;
            const float d = Lw[10272 + ti], dtv = Lw[10240 + ti], xv = Lw[8192 + ti * 64 + p], xdt = xv * dtv;
            float y = 0.f;
#pragma unroll
            for (int k4 = 0; k4 < 8; ++k4) { const f32x4 bv = *(const LAS f32x4*)(Lw + ti * 128 + 32 * nq + 4 * k4), cv = *(const LAS f32x4*)(Lw + 4096 + ti * 128 + 32 * nq + 4 * k4);
#pragma unroll
                for (int e = 0; e < 4; ++e) { s[4 * k4 + e] = s[4 * k4 + e] * d + xdt * bv[e]; y += s[4 * k4 + e] * cv[e]; } }
            y += __shfl_xor(y, 16); y += __shfl_xor(y, 32);
            if (nq == 0) atomicAdd(Y + (size_t)(s0 + tbase + ti) * 512 + h * 64 + p, y + (dir == 0 ? dskip * xv : 0.f));
        }
    }
}

__device__ __forceinline__ void attn_naive_unit(int m, int wave, int lane, const bf16* QKV, const float* rpb, const float* gattn, bf16* MIX, LAS float* Ps, volatile LAS float* exch, int parity) {
    const int h = wave; int s0, T; seq_of_row(m, s0, T);
    const int tl = m - s0, r = tl >> 6, qc = tl & 63, rows = T >> 6;
    const int cstart = min(max(qc - 8, 0), 48), rs = min(max(r - 4, 0), rows - 8);
    float q[64];
    { const bf16* qp = QKV + (size_t)m * 1536 + h * 64;
#pragma unroll
      for (int i = 0; i < 8; ++i) { const u32x4 v = *(const u32x4*)(qp + 8 * i); q[8 * i] = bf_lo(v.x); q[8 * i + 1] = bf_hi(v.x); q[8 * i + 2] = bf_lo(v.y); q[8 * i + 3] = bf_hi(v.y);
          q[8 * i + 4] = bf_lo(v.z); q[8 * i + 5] = bf_hi(v.z); q[8 * i + 6] = bf_lo(v.w); q[8 * i + 7] = bf_hi(v.w); } }
    float sc[2];
#pragma unroll
    for (int k2 = 0; k2 < 2; ++k2) { const int kk = lane + 64 * k2, kri = kk >> 4, kci = kk & 15; const int kt = s0 + (rs + kri) * 64 + cstart + kci;
        const bf16* kp = QKV + (size_t)kt * 1536 + 512 + h * 64; float d = 0.f;
#pragma unroll
        for (int i = 0; i < 8; ++i) { const u32x4 v = *(const u32x4*)(kp + 8 * i);
            d += q[8 * i] * bf_lo(v.x) + q[8 * i + 1] * bf_hi(v.x) + q[8 * i + 2] * bf_lo(v.y) + q[8 * i + 3] * bf_hi(v.y) + q[8 * i + 4] * bf_lo(v.z) + q[8 * i + 5] * bf_hi(v.z) + q[8 * i + 6] * bf_lo(v.w) + q[8 * i + 7] * bf_hi(v.w); }
        sc[k2] = d + rpb[h * 465 + (rs + kri - r + 7) * 31 + (cstart + kci - qc + 15)]; }
    const float mx = wave_max(fmaxf(sc[0], sc[1]));
    const float p0 = __expf(sc[0] - mx), p1 = __expf(sc[1] - mx);
    const float inv = 1.f / wave_sum(p0 + p1);
    Ps[lane] = p0 * inv; Ps[lane + 64] = p1 * inv;
    LDS_WAIT(); asm volatile("" ::: "memory");
    float o = 0.f; const bf16* vbase = QKV + 1024 + h * 64 + lane;
#pragma unroll 4
    for (int kk = 0; kk < 128; kk += 4) { const f32x4 pv = *(const LAS f32x4*)(Ps + kk); const int kt = s0 + (rs + (kk >> 4)) * 64 + cstart + (kk & 15);
#pragma unroll
        for (int e = 0; e < 4; ++e) o += pv[e] * bf2f(vbase[(size_t)(kt + e) * 1536]); }
    const float ssq = wave_sum(o * o);
    if (lane == 0) exch[parity * 8 + h] = ssq;
    __syncthreads();
    float tot = 0.f;
#pragma unroll
    for (int i = 0; i < 8; ++i) tot += exch[parity * 8 + i];
    const float scl = 1.f / sqrtf(tot * (1.f / 512.f) + RMS_EPS);
    MIX[(size_t)m * 1024 + h * 64 + lane] = f2bf(o * scl * gattn[h * 64 + lane]);
}


typedef short bf16x8v __attribute__((ext_vector_type(8)));
typedef short s16x4v __attribute__((ext_vector_type(4)));
#define MFMA16(a, b, c) __builtin_amdgcn_mfma_f32_16x16x32_bf16((a), (b), (c), 0, 0, 0)
constexpr int VPITCH = 144, VHEAD = 512 * VPITCH;
__device__ __forceinline__ void attn_fast_unit(int u, const bf16* QKV, const float* TB  , const float* gattn, bf16* MIX, float* SSQA, LAS unsigned char* lds, int tid, int wave, int lane) {
    const int hp = u / 1280, gr = u % 1280;
    int s0, rows, r;
    if (gr < 1024) { s0 = (gr >> 5) * 2048; r = gr & 31; rows = 32; } else { const int g2 = gr - 1024; s0 = MPROMPT + (g2 >> 6) * 4096; r = g2 & 63; rows = 64; }
    const int rs = min(max(r - 4, 0), rows - 8);
    __syncthreads();
    { u32x4 v[16];
#pragma unroll
      for (int i = 0; i < 16; ++i) { const int id = i * 512 + tid, c = id & 7, key = (id >> 3) & 511, hh = id >> 12;
          v[i] = *(const u32x4*)(QKV + (size_t)(s0 + rs * 64 + key) * 1536 + 1024 + (2 * hp + hh) * 64 + 8 * c); }
#pragma unroll
      for (int i = 0; i < 16; ++i) { const int id = i * 512 + tid, c = id & 7, key = (id >> 3) & 511, hh = id >> 12;
          *(LAS u32x4*)(lds + hh * VHEAD + key * VPITCH + 16 * c) = v[i]; } }
    __syncthreads();
    const int hh = wave >> 2, j = wave & 3, h = 2 * hp + hh, fr = lane & 15, fq = lane >> 4;
    const int kstart = j == 0 ? 0 : (j == 1 ? 8 : (j == 2 ? 24 : 32));
    const int qtok = s0 + r * 64 + 16 * j + fr;
    const bf16x8v q0 = *(const bf16x8v*)(QKV + (size_t)qtok * 1536 + h * 64 + 8 * fq), q1 = *(const bf16x8v*)(QKV + (size_t)qtok * 1536 + h * 64 + 32 + 8 * fq);
    f32x4 sacc[16];
    const float* tb = TB + (size_t)((h * 4 + j) * 15 + (rs - r + 7)) * 512 + fr * 32 + 4 * fq;
#pragma unroll
    for (int kt = 0; kt < 16; ++kt) { const int kri = kt >> 1; const size_t ktok = (size_t)(s0 + (rs + kri) * 64 + kstart + 16 * (kt & 1) + fr);
        const bf16x8v k0 = *(const bf16x8v*)(QKV + ktok * 1536 + 512 + h * 64 + 8 * fq), k1 = *(const bf16x8v*)(QKV + ktok * 1536 + 512 + h * 64 + 32 + 8 * fq);
        f32x4 a = {0.f, 0.f, 0.f, 0.f}; a = MFMA16(k0, q0, a); a = MFMA16(k1, q1, a);
        sacc[kt] = a + *(const f32x4*)(tb + kri * 512 + 16 * (kt & 1)); }
    float mx = -INFINITY;
#pragma unroll
    for (int kt = 0; kt < 16; ++kt) mx = fmaxf(mx, fmaxf(fmaxf(sacc[kt][0], sacc[kt][1]), fmaxf(sacc[kt][2], sacc[kt][3])));
    mx = fmaxf(mx, __shfl_xor(mx, 16)); mx = fmaxf(mx, __shfl_xor(mx, 32));
    float l = 0.f;
#pragma unroll
    for (int kt = 0; kt < 16; ++kt) {
#pragma unroll
        for (int i = 0; i < 4; ++i) { const float pz = __builtin_amdgcn_exp2f(sacc[kt][i] - mx); sacc[kt][i] = pz; l += pz; } }
    l += __shfl_xor(l, 16); l += __shfl_xor(l, 32);
    f32x4 o[4];
#pragma unroll
    for (int dt = 0; dt < 4; ++dt) o[dt] = (f32x4){0.f, 0.f, 0.f, 0.f};
    const LAS unsigned char* vb = lds + hh * VHEAD + (kstart + 4 * fq + ((lane & 15) >> 2)) * VPITCH + 8 * (lane & 3);
#pragma unroll
    for (int ks = 0; ks < 8; ++ks) {
        u32x4 pw; pw.x = pkbf(sacc[2 * ks][0], sacc[2 * ks][1]); pw.y = pkbf(sacc[2 * ks][2], sacc[2 * ks][3]); pw.z = pkbf(sacc[2 * ks + 1][0], sacc[2 * ks + 1][1]); pw.w = pkbf(sacc[2 * ks + 1][2], sacc[2 * ks + 1][3]);
        const bf16x8v pf = __builtin_bit_cast(bf16x8v, pw);
#pragma unroll
        for (int dt = 0; dt < 4; ++dt) {
            const s16x4v lo = __builtin_amdgcn_ds_read_tr16_b64_v4i16((LAS s16x4v*)(vb + ks * 64 * VPITCH + 32 * dt));
            const s16x4v hi = __builtin_amdgcn_ds_read_tr16_b64_v4i16((LAS s16x4v*)(vb + (ks * 64 + 16) * VPITCH + 32 * dt));
            const bf16x8v vf = __builtin_shufflevector(lo, hi, 0, 1, 2, 3, 4, 5, 6, 7);
            o[dt] = MFMA16(vf, pf, o[dt]); } }
    const float inv = 1.f / l; float ssq = 0.f;
#pragma unroll
    for (int dt = 0; dt < 4; ++dt) { o[dt] = o[dt] * inv; ssq += (o[dt][0] * o[dt][0] + o[dt][1] * o[dt][1]) + (o[dt][2] * o[dt][2] + o[dt][3] * o[dt][3]); }
    ssq += __shfl_xor(ssq, 16); ssq += __shfl_xor(ssq, 32);
    if (fq == 0) atomicAdd(SSQA + qtok, ssq);
#pragma unroll
    for (int dt = 0; dt < 4; ++dt) { const f32x4 gv = *(const f32x4*)(gattn + h * 64 + 16 * dt + 4 * fq); const f32x4 ov = o[dt] * gv;
        u32x2 w; w.x = pkbf(ov[0], ov[1]); w.y = pkbf(ov[2], ov[3]); *(u32x2*)(MIX + (size_t)qtok * 1024 + h * 64 + 16 * dt + 4 * fq) = w; }
}

typedef float f32x16 __attribute__((ext_vector_type(16)));
#define MFMA32(a, b, c) __builtin_amdgcn_mfma_f32_32x32x16_bf16((a), (b), (c), 0, 0, 0)
constexpr float LOG2E = 1.4426950408889634f;
constexpr int TPITCH = 272;
__device__ __forceinline__ void conv_item(int it, const bf16* RAW, const float* DTraw, const float* cw, const float* cb, const float* dt_bias, const float* a_log,
                                          bf16* XT, bf16* BT, bf16* BTOK, bf16* CTOK, float* CUM, float* DTA, float* WST, LAS unsigned char* lds, int tid, int wave, int lane) {
    const int ck = it >> 3, sl = it & 7, m0 = ck * 128; int s0, T; seq_of_row(m0, s0, T); const int tl0 = m0 - s0;
    const int cg = tid & 15, tg = tid >> 4, c0 = 128 * sl + 8 * cg;
    float x[8][8];
#pragma unroll
    for (int i = 0; i < 8; ++i) { const int tt = tl0 + 4 * tg - 2 + i; u32x4 v = {0u, 0u, 0u, 0u};
        if (tt >= 0 && tt < T) v = *(const u32x4*)(RAW + (size_t)(s0 + tt) * 1024 + c0);
        x[i][0] = bf_lo(v.x); x[i][1] = bf_hi(v.x); x[i][2] = bf_lo(v.y); x[i][3] = bf_hi(v.y); x[i][4] = bf_lo(v.z); x[i][5] = bf_hi(v.z); x[i][6] = bf_lo(v.w); x[i][7] = bf_hi(v.w); }
    float o[4][8];
    { const f32x4 b0 = *(const f32x4*)(cb + c0), b1 = *(const f32x4*)(cb + c0 + 4);
#pragma unroll
      for (int tk = 0; tk < 4; ++tk) { o[tk][0] = b0[0]; o[tk][1] = b0[1]; o[tk][2] = b0[2]; o[tk][3] = b0[3]; o[tk][4] = b1[0]; o[tk][5] = b1[1]; o[tk][6] = b1[2]; o[tk][7] = b1[3]; }
#pragma unroll
      for (int j = 0; j < 5; ++j) { const f32x4 w0 = *(const f32x4*)(cw + j * 1024 + c0), w1 = *(const f32x4*)(cw + j * 1024 + c0 + 4);
#pragma unroll
          for (int tk = 0; tk < 4; ++tk) { o[tk][0] += x[tk + j][0] * w0[0]; o[tk][1] += x[tk + j][1] * w0[1]; o[tk][2] += x[tk + j][2] * w0[2]; o[tk][3] += x[tk + j][3] * w0[3];
              o[tk][4] += x[tk + j][4] * w1[0]; o[tk][5] += x[tk + j][5] * w1[1]; o[tk][6] += x[tk + j][6] * w1[2]; o[tk][7] += x[tk + j][7] * w1[3]; } }
#pragma unroll
      for (int tk = 0; tk < 4; ++tk)
#pragma unroll
          for (int e = 0; e < 8; ++e) o[tk][e] = silu_f(o[tk][e]); }
    __syncthreads();
    if (sl >= 4) { bf16* dst = (sl < 6 ? BTOK : CTOK) + (size_t)(m0 + 4 * tg) * 256 + 128 * (sl & 1) + 8 * cg;
#pragma unroll
        for (int tk = 0; tk < 4; ++tk) { u32x4 w; w.x = pkbf(o[tk][0], o[tk][1]); w.y = pkbf(o[tk][2], o[tk][3]); w.z = pkbf(o[tk][4], o[tk][5]); w.w = pkbf(o[tk][6], o[tk][7]); *(u32x4*)(dst + (size_t)tk * 256) = w; } }
    if (sl < 6) {
#pragma unroll
        for (int e = 0; e < 8; ++e) { u32x2 w; w.x = pkbf(o[0][e], o[1][e]); w.y = pkbf(o[2][e], o[3][e]); *(LAS u32x2*)(lds + (8 * cg + e) * TPITCH + 8 * tg) = w; }
        __syncthreads();
        bf16* dbase = sl < 4 ? XT + ((size_t)ck * 512 + 128 * sl) * 128 : BT + ((size_t)ck * 256 + 128 * (sl - 4)) * 128;
#pragma unroll
        for (int i = 0; i < 4; ++i) { const int id = i * 512 + tid, row = id >> 4, pc = id & 15; *(u32x4*)(dbase + (size_t)row * 128 + 8 * pc) = *(const LAS u32x4*)(lds + row * TPITCH + 16 * pc); }
    }
    if (sl == 0) {
#pragma unroll
        for (int q = 0; q < 2; ++q) { const int sr = 2 * wave + q, dir = sr >> 3;
            const float a = -expf(a_log[sr]) * LOG2E, bias = dt_bias[sr];
            const float dt0 = softplus_f(DTraw[(size_t)(m0 + 2 * lane) * 16 + sr] + bias), dt1 = softplus_f(DTraw[(size_t)(m0 + 2 * lane + 1) * 16 + sr] + bias);
            const float v0 = dt0 * a, v1 = dt1 * a; float inc = v0 + v1;
#pragma unroll
            for (int ofs = 1; ofs < 64; ofs <<= 1) { const float t = __shfl_up(inc, ofs); if (lane >= ofs) inc += t; }
            const float excl = inc - (v0 + v1), total = __shfl(inc, 63);
            float c0_, c1_;
            if (dir == 0) { c0_ = excl + v0; c1_ = inc; } else { c0_ = total - excl; c1_ = total - excl - v0; }
            const float tot = total;
            const size_t off = ((size_t)ck * 16 + sr) * 128 + 2 * lane;
            *(pg8::f32x2e*)(CUM + off) = (pg8::f32x2e){c0_, c1_}; *(pg8::f32x2e*)(DTA + off) = (pg8::f32x2e){dt0, dt1};
            *(pg8::f32x2e*)(WST + off) = (pg8::f32x2e){__builtin_amdgcn_exp2f(tot - c0_) * dt0, __builtin_amdgcn_exp2f(tot - c1_) * dt1}; }
    }
}
__device__ __forceinline__ void s12_unit(int u, const bf16* XT, const bf16* BT, const float* CUM, const float* WST, bf16* PREV, int wave, int lane) {
    int b, h, dir, c0, nc;
    if (u < 64) { b = u >> 4; h = (u & 15) >> 1; dir = u & 1; c0 = 512 + b * 32; nc = 32; } else { const int v = u - 64; b = v >> 4; h = (v & 15) >> 1; dir = v & 1; c0 = b * 16; nc = 16; }
    const int g = h >> 2, sr = dir * 8 + h, pt = wave >> 2, nt = wave & 3, r = lane & 31, hh = lane >> 5;
    f32x16 prev;
#pragma unroll
    for (int i = 0; i < 16; ++i) prev[i] = 0.f;
    for (int ci = 0; ci < nc; ++ci) { const int ck = dir == 0 ? c0 + ci : c0 + nc - 1 - ci;
        bf16* pp = PREV + (((size_t)ck * 8 + h) * 2 + dir) * 8192 + (32 * pt + r) * 128 + 32 * nt + 4 * hh;
#pragma unroll
        for (int q = 0; q < 4; ++q) { u32x2 w; w.x = pkbf(prev[4 * q], prev[4 * q + 1]); w.y = pkbf(prev[4 * q + 2], prev[4 * q + 3]); *(u32x2*)(pp + 8 * q) = w; }
        f32x16 st;
#pragma unroll
        for (int i = 0; i < 16; ++i) st[i] = 0.f;
        const bf16* bp = BT + ((size_t)ck * 256 + 128 * g + 32 * nt + r) * 128 + 8 * hh;
        const bf16* xp = XT + ((size_t)ck * 512 + 64 * h + 32 * pt + r) * 128 + 8 * hh;
        const float* wp = WST + ((size_t)ck * 16 + sr) * 128 + 8 * hh;
#pragma unroll
        for (int kk = 0; kk < 8; ++kk) { const bf16x8v bf = *(const bf16x8v*)(bp + 16 * kk); const u32x4 xr = *(const u32x4*)(xp + 16 * kk);
            const f32x4 w0 = *(const f32x4*)(wp + 16 * kk), w1 = *(const f32x4*)(wp + 16 * kk + 4);
            u32x4 xw; xw.x = pkbf(bf_lo(xr.x) * w0[0], bf_hi(xr.x) * w0[1]); xw.y = pkbf(bf_lo(xr.y) * w0[2], bf_hi(xr.y) * w0[3]);
            xw.z = pkbf(bf_lo(xr.z) * w1[0], bf_hi(xr.z) * w1[1]); xw.w = pkbf(bf_lo(xr.w) * w1[2], bf_hi(xr.w) * w1[3]);
            st = MFMA32(bf, __builtin_bit_cast(bf16x8v, xw), st); }
        const float cd = __builtin_amdgcn_exp2f(CUM[((size_t)ck * 16 + sr) * 128 + (dir == 0 ? 127 : 0)]);
        prev = prev * cd + st;
    }
}
constexpr int S3_BM = 0, S3_CM = 34816, S3_XT = 69632, S3_CUM = 139264, S3_DT = 143360;
__device__ __forceinline__ void s3_unit(int u, const bf16* XT, const bf16* BTOK, const bf16* CTOK, const float* CUM, const float* DTA, const bf16* PREV, const bf16* Zb, const float* d_skip, const float* gssm,
                                        bf16* MIX, float* SSQS, LAS unsigned char* lds, int tid, int wave, int lane_) {
    int lane = lane_; asm volatile("" : "+v"(lane));
    const int ck = u >> 1, g = u & 1, m0 = ck * 128;
    __syncthreads();
    { asm volatile("" : "+v"(tid));
      u32x4 vb[4], vc[4], vx[8];
#pragma unroll
      for (int i = 0; i < 4; ++i) { const int id = i * 512 + tid, row = id >> 4, pc = id & 15; vb[i] = *(const u32x4*)(BTOK + (size_t)(m0 + row) * 256 + 128 * g + 8 * pc); vc[i] = *(const u32x4*)(CTOK + (size_t)(m0 + row) * 256 + 128 * g + 8 * pc); }
#pragma unroll
      for (int i = 0; i < 8; ++i) { const int id = i * 512 + tid, row = id >> 4, pc = id & 15; vx[i] = *(const u32x4*)(XT + ((size_t)ck * 512 + 256 * g + row) * 128 + 8 * pc); }
      const int a4 = tid & 255, hl_ = a4 >> 6, dr_ = (a4 >> 5) & 1, e4 = a4 & 31;
      const f32x4 vs = *(const f32x4*)((tid < 256 ? CUM : DTA) + ((size_t)ck * 16 + dr_ * 8 + 4 * g + hl_) * 128 + 4 * e4);
#pragma unroll
      for (int i = 0; i < 4; ++i) { const int id = i * 512 + tid, row = id >> 4, pc = id & 15; *(LAS u32x4*)(lds + S3_BM + row * TPITCH + 16 * pc) = vb[i]; *(LAS u32x4*)(lds + S3_CM + row * TPITCH + 16 * pc) = vc[i]; }
#pragma unroll
      for (int i = 0; i < 8; ++i) { const int id = i * 512 + tid, row = id >> 4, pc = id & 15; *(LAS u32x4*)(lds + S3_XT + row * TPITCH + 16 * pc) = vx[i]; }
      *(LAS f32x4*)(lds + (tid < 256 ? S3_CUM : S3_DT) + ((hl_ * 2 + dr_) * 128 + 4 * e4) * 4) = vs; }
    __syncthreads();
    const int hl = wave >> 1, half = wave & 1, h = 4 * g + hl, r = lane & 31, hh = lane >> 5;
    const float dskip = d_skip[h];
    const LAS float* cumf = (const LAS float*)(lds + S3_CUM) + (hl * 2) * 128; const LAS float* cumb = cumf + 128;
    const LAS float* dtf = (const LAS float*)(lds + S3_DT) + (hl * 2) * 128; const LAS float* dtb = dtf + 128;
    for (int lbi = 0; lbi < 2; ++lbi) { const int lb = 2 * half + lbi, l = 32 * lb + r;
        const float Af_l = cumf[l], Sb_l = cumb[l];
        bf16x8v cf[8];
#pragma unroll
        for (int kk = 0; kk < 8; ++kk) cf[kk] = *(const LAS bf16x8v*)(lds + S3_CM + l * TPITCH + 32 * kk + 16 * hh);
        f32x16 yacc[2];
#pragma unroll
        for (int pb = 0; pb < 2; ++pb)
#pragma unroll
            for (int i = 0; i < 16; ++i) yacc[pb][i] = 0.f;
#pragma unroll
        for (int sb = 0; sb < 4; ++sb) {
            f32x16 cbt;
#pragma unroll
            for (int i = 0; i < 16; ++i) cbt[i] = 0.f;
#pragma unroll
            for (int kk = 0; kk < 8; ++kk) { const bf16x8v bmf = *(const LAS bf16x8v*)(lds + S3_BM + (32 * sb + r) * TPITCH + 32 * kk + 16 * hh); cbt = MFMA32(bmf, cf[kk], cbt); }
#pragma unroll
            for (int q = 0; q < 4; ++q) { const int sbase = 32 * sb + 8 * q + 4 * hh;
                const f32x4 af = *(const LAS f32x4*)(cumf + sbase), sbv = *(const LAS f32x4*)(cumb + sbase), df = *(const LAS f32x4*)(dtf + sbase), db = *(const LAS f32x4*)(dtb + sbase);
#pragma unroll
                for (int e = 0; e < 4; ++e) { const int sidx = sbase + e;
                    const float fw = sidx <= l ? __builtin_amdgcn_exp2f(Af_l - af[e]) * df[e] : 0.f;
                    const float bw = sidx >= l ? __builtin_amdgcn_exp2f(Sb_l - sbv[e]) * db[e] : 0.f;
                    cbt[4 * q + e] = cbt[4 * q + e] * (fw + bw) + (sidx == l ? dskip : 0.f); } }
#pragma unroll
            for (int ks = 0; ks < 2; ++ks) {
                u32x4 gw_; gw_.x = pkbf(cbt[8 * ks], cbt[8 * ks + 1]); gw_.y = pkbf(cbt[8 * ks + 2], cbt[8 * ks + 3]); gw_.z = pkbf(cbt[8 * ks + 4], cbt[8 * ks + 5]); gw_.w = pkbf(cbt[8 * ks + 6], cbt[8 * ks + 7]);
                const bf16x8v gf = __builtin_bit_cast(bf16x8v, gw_);
#pragma unroll
                for (int pb = 0; pb < 2; ++pb) { const LAS unsigned char* xa = lds + S3_XT + (64 * hl + 32 * pb + r) * TPITCH + 2 * (32 * sb + 16 * ks + 4 * hh);
                    const s16x4v lo = *(const LAS s16x4v*)xa, hi = *(const LAS s16x4v*)(xa + 16);
                    yacc[pb] = MFMA32(__builtin_shufflevector(lo, hi, 0, 1, 2, 3, 4, 5, 6, 7), gf, yacc[pb]); } }
        }
#pragma unroll
        for (int dir = 0; dir < 2; ++dir) { const float el = __builtin_amdgcn_exp2f(dir == 0 ? Af_l : Sb_l);
#pragma unroll
            for (int pb = 0; pb < 2; ++pb) { f32x16 ua;
#pragma unroll
                for (int i = 0; i < 16; ++i) ua[i] = 0.f;
                const bf16* pp = PREV + (((size_t)ck * 8 + h) * 2 + dir) * 8192 + (32 * pb + r) * 128 + 8 * hh;
#pragma unroll
                for (int kk = 0; kk < 8; ++kk) { const bf16x8v pf = *(const bf16x8v*)(pp + 16 * kk); ua = MFMA32(pf, cf[kk], ua); }
                yacc[pb] = yacc[pb] + ua * el; } }
        const size_t mrow = (size_t)(m0 + l); float ssq = 0.f;
#pragma unroll
        for (int pb = 0; pb < 2; ++pb)
#pragma unroll
            for (int q = 0; q < 4; ++q) { const int pc = h * 64 + 32 * pb + 8 * q + 4 * hh; const u32x2 zv = *(const u32x2*)(Zb + mrow * 512 + pc); const f32x4 gv = *(const f32x4*)(gssm + pc);
                const float v0 = yacc[pb][4 * q] * silu_f(bf_lo(zv.x)), v1 = yacc[pb][4 * q + 1] * silu_f(bf_hi(zv.x)), v2 = yacc[pb][4 * q + 2] * silu_f(bf_lo(zv.y)), v3 = yacc[pb][4 * q + 3] * silu_f(bf_hi(zv.y));
                ssq += (v0 * v0 + v1 * v1) + (v2 * v2 + v3 * v3);
                u32x2 w; w.x = pkbf(v0 * gv[0], v1 * gv[1]); w.y = pkbf(v2 * gv[2], v3 * gv[3]); *(u32x2*)(MIX + mrow * 1024 + 512 + pc) = w; }
        ssq += __shfl_xor(ssq, 32);
        if (hh == 0) atomicAdd(SSQS + mrow, ssq);
    }
}

__device__ __forceinline__ void gate_norm_row(int m, int lane, const float* Y, const bf16* Z, const float* g, bf16* MIX) {
    const f32x4 y0 = *(const f32x4*)(Y + (size_t)m * 512 + 8 * lane), y1 = *(const f32x4*)(Y + (size_t)m * 512 + 8 * lane + 4);
    const u32x4 zv = *(const u32x4*)(Z + (size_t)m * 512 + 8 * lane);
    float v[8] = {y0[0] * silu_f(bf_lo(zv.x)), y0[1] * silu_f(bf_hi(zv.x)), y0[2] * silu_f(bf_lo(zv.y)), y0[3] * silu_f(bf_hi(zv.y)),
                  y1[0] * silu_f(bf_lo(zv.z)), y1[1] * silu_f(bf_hi(zv.z)), y1[2] * silu_f(bf_lo(zv.w)), y1[3] * silu_f(bf_hi(zv.w))};
    float ss = 0.f;
#pragma unroll
    for (int e = 0; e < 8; ++e) ss += v[e] * v[e];
    const float scl = 1.f / sqrtf(wave_sum(ss) * (1.f / 512.f) + RMS_EPS);
    const f32x4 g0 = *(const f32x4*)(g + 8 * lane), g1 = *(const f32x4*)(g + 8 * lane + 4);
    u32x4 w; w.x = pkbf(v[0] * scl * g0[0], v[1] * scl * g0[1]); w.y = pkbf(v[2] * scl * g0[2], v[3] * scl * g0[3]);
    w.z = pkbf(v[4] * scl * g1[0], v[5] * scl * g1[1]); w.w = pkbf(v[6] * scl * g1[2], v[7] * scl * g1[3]);
    *(u32x4*)(MIX + (size_t)m * 1024 + 512 + 8 * lane) = w;
}

#define FRESH_IDS() int tid = threadIdx.x; asm volatile("" : "+v"(tid)); int G = gridDim.x, bx = blockIdx.x; asm volatile("" : "+s"(G), "+s"(bx)); \
    const int lane = tid & 63, wave = __builtin_amdgcn_readfirstlane(tid >> 6), gw = bx * NWAVES + wave, NGW = G * NWAVES; (void)gw; (void)lane; (void)NGW; \
    unsigned char* ws = KWS(); float* out = KOUT(); (void)out; \
    bf16* XB = (bf16*)(ws + WS_XB); bf16* Hb = (bf16*)(ws + WS_H); bf16* QKV = (bf16*)(ws + WS_QKV); bf16* Zb = (bf16*)(ws + WS_Z); bf16* RAW = (bf16*)(ws + WS_RAW); \
    float* Yb = (float*)(ws + WS_Y); float* DTb = (float*)(ws + WS_DT); (void)XB; (void)Hb; (void)QKV; (void)Zb; (void)RAW; (void)Yb; (void)DTb
template <int l> __device__ __forceinline__ void layer_body(LAS unsigned char* lds) {
    cg::grid_group grid = cg::this_grid();
        { FRESH_IDS(); pg8::Gemm g{XB, (const bf16*)(ws + WS_W + (size_t)l * W_LAYER + OW_GU1), M, NGU, D}; pg8::StaticOrder S; S.init(M, NGU, (int)gridDim.x, (int)blockIdx.x); pg8::EpiSwiGLU E{Hb, FF};
          pg8::gemm_phase<pg8::EpiSwiGLU, pg8::StaticOrder, true, true>(lds, g, S, E); }
        grid.sync();
        { FRESH_IDS(); pg8::Gemm g{Hb, (const bf16*)(ws + WS_W + (size_t)l * W_LAYER + OW_D1), M, D, FF}; pg8::StaticOrder S; S.init(M, D, (int)gridDim.x, (int)blockIdx.x);
          pg8::EpiResidBf E{XB, 0.5f};
          pg8::gemm_phase<pg8::EpiResidBf, pg8::StaticOrder, true, true>(lds, g, S, E); }
        grid.sync();
        { FRESH_IDS(); const float* g_ = KIN(5) + l * D; const float* b_ = KIN(6) + l * D;
          for (int m = gw; m < M; m += NGW) ln_row_bf(XB + (size_t)m * D, nullptr, g_, b_, lane);
          const f32x4 z4 = {0.f, 0.f, 0.f, 0.f};
          f32x4* sz = (f32x4*)(ws + WS_SSQ); for (int i = bx * NT + tid; i < 2 * M / 4; i += G * NT) sz[i] = z4; }
        grid.sync();
        { FRESH_IDS(); pg8::Gemm g{XB, (const bf16*)(ws + WS_W + (size_t)l * W_LAYER + OW_IN), M, NIN, D}; pg8::StaticOrder S; S.init(M, NIN, (int)gridDim.x, (int)blockIdx.x); pg8::EpiProj E{QKV, Zb, RAW, DTb};
          pg8::gemm_phase<pg8::EpiProj, pg8::StaticOrder, true, true>(lds, g, S, E); }
        grid.sync();
#ifndef MIXREP
#define MIXREP 1
#endif
        for (int rep = 0; rep < MIXREP; ++rep) {
        if (rep > 0) { { FRESH_IDS(); const f32x4 z4 = {0.f, 0.f, 0.f, 0.f}; f32x4* sz = (f32x4*)(ws + WS_SSQ); for (int i = bx * NT + tid; i < 2 * M / 4; i += G * NT) sz[i] = z4; } grid.sync(); }
        { FRESH_IDS();
          for (int it = bx; it < 640 * 8; it += G)
              conv_item(it, RAW, DTb, KIN(8) + (size_t)l * 5 * 1024, KIN(9) + l * 1024, KIN(10) + l * 16, KIN(11) + l * 16, (bf16*)(ws + WS_XT), (bf16*)(ws + WS_BT), (bf16*)(ws + WS_BTOK), (bf16*)(ws + WS_CTOK),
                        (float*)(ws + WS_CUM), (float*)(ws + WS_DTA), (float*)(ws + WS_WST), lds, tid, wave, lane);
          { const int per = (5120 + G - 1) / G; const int u0 = bx * per, u1 = min(u0 + per, 5120);
            for (int u = u0; u < u1; ++u) attn_fast_unit(u, QKV, (const float*)(ws + WS_TB) + (size_t)l * 8 * 4 * 15 * 512, KIN(14) + l * 512, (bf16*)out, (float*)(ws + WS_SSQ), lds, tid, wave, lane); } }
        grid.sync();
        { FRESH_IDS();
          for (int i = 0; i < 3; ++i) { int u = bx + i * G; if (G == 256 && i == 2) u = (bx >= 64 && bx < 128) ? 512 + bx - 64 : 576; if (u >= 576) break;
              s12_unit(u, (const bf16*)(ws + WS_XT), (const bf16*)(ws + WS_BT), (const float*)(ws + WS_CUM), (const float*)(ws + WS_WST), (bf16*)(ws + WS_PREV), wave, lane); } }
        grid.sync();
        { FRESH_IDS();
          for (int u = bx; u < 1280; u += G)
              s3_unit(u, (const bf16*)(ws + WS_XT), (const bf16*)(ws + WS_BTOK), (const bf16*)(ws + WS_CTOK), (const float*)(ws + WS_CUM), (const float*)(ws + WS_DTA), (const bf16*)(ws + WS_PREV), Zb,
                      KIN(12) + l * 8, KIN(13) + l * 512, (bf16*)out, (float*)(ws + WS_SSQ) + M, lds, tid, wave, lane); }
        grid.sync();
        }
        { FRESH_IDS(); const float* ssq = (const float*)(ws + WS_SSQ);
          for (int m = gw; m < M; m += NGW) { const float sa = 1.f / sqrtf(ssq[m] * (1.f / 512.f) + RMS_EPS), ss = 1.f / sqrtf(ssq[M + m] * (1.f / 512.f) + RMS_EPS);
              u32x4* rowp = (u32x4*)((bf16*)out + (size_t)m * 1024) + lane;
#pragma unroll
              for (int hf = 0; hf < 2; ++hf) { const float f = hf ? ss : sa; u32x4 v = rowp[64 * hf];
                  v.x = pkbf(bf_lo(v.x) * f, bf_hi(v.x) * f); v.y = pkbf(bf_lo(v.y) * f, bf_hi(v.y) * f); v.z = pkbf(bf_lo(v.z) * f, bf_hi(v.z) * f); v.w = pkbf(bf_lo(v.w) * f, bf_hi(v.w) * f); rowp[64 * hf] = v; } } }
        grid.sync();
        { FRESH_IDS(); pg8::Gemm g{(const bf16*)out, (const bf16*)(ws + WS_W + (size_t)l * W_LAYER + OW_OUT), M, D, D}; pg8::StaticOrder S; S.init(M, D, (int)gridDim.x, (int)blockIdx.x); pg8::EpiResidBf E{XB, 1.0f};
          pg8::gemm_phase<pg8::EpiResidBf, pg8::StaticOrder, true, true>(lds, g, S, E); }
        grid.sync();
        { FRESH_IDS(); const float* g_ = KIN(17) + l * D; const float* b_ = KIN(18) + l * D;
          for (int m = gw; m < M; m += NGW) ln_row_bf(XB + (size_t)m * D, nullptr, g_, b_, lane); }
        grid.sync();
        { FRESH_IDS(); pg8::Gemm g{XB, (const bf16*)(ws + WS_W + (size_t)l * W_LAYER + OW_GU2), M, NGU, D}; pg8::StaticOrder S; S.init(M, NGU, (int)gridDim.x, (int)blockIdx.x); pg8::EpiSwiGLU E{Hb, FF};
          pg8::gemm_phase<pg8::EpiSwiGLU, pg8::StaticOrder, true, true>(lds, g, S, E); }
        grid.sync();
        { FRESH_IDS(); pg8::Gemm g{Hb, (const bf16*)(ws + WS_W + (size_t)l * W_LAYER + OW_D2), M, D, FF}; pg8::StaticOrder S; S.init(M, D, (int)gridDim.x, (int)blockIdx.x); pg8::EpiResidBf E{XB, 0.5f};
          pg8::gemm_phase<pg8::EpiResidBf, pg8::StaticOrder, true, true>(lds, g, S, E); }
        grid.sync();
        { FRESH_IDS(); const float* g_ = KIN(22) + l * D; const float* b_ = KIN(23) + l * D;
          for (int m = gw; m < M; m += NGW) ln_row_bf(XB + (size_t)m * D, l == 1 ? out + (size_t)m * D : nullptr, g_, b_, lane); }
        if (l == 0) grid.sync();
}

__global__ void __launch_bounds__(NT, 2) fwd_mega(Params P) {
    extern __shared__ __attribute__((aligned(16))) unsigned char lds_raw[];
    LAS unsigned char* lds = (LAS unsigned char*)lds_raw;
    cg::grid_group grid = cg::this_grid();
    { FRESH_IDS(); LAS float* scr = (LAS float*)(lds + wave * 16384);
      for (int it = gw; it < 2 * IT_LAYER; it += NGW) prologue_item(ws, it, scr, lane);
      { float* TBw = (float*)(ws + WS_TB);
        for (int i = bx * NT + tid; i < 2 * 8 * 4 * 15 * 512; i += G * NT) { const int kc = i & 31, q = (i >> 5) & 15; int t = i >> 9; const int ro = t % 15; t /= 15; const int j = t & 3; t >>= 2; const int h = t & 7, l = t >> 3;
            const int kstart = j == 0 ? 0 : (j == 1 ? 8 : (j == 2 ? 24 : 32)), qcol = 16 * j + q, kcol = kstart + kc, cst = min(max(qcol - 8, 0), 48);
            const bool valid = kcol >= cst && kcol < cst + 16;
            TBw[i] = valid ? 1.4426950408889634f * KIN(15)[((l * 8 + h) * 15 + ro) * 31 + (kcol - qcol + 15)] : -INFINITY; } }
      for (int m = gw; m < M; m += NGW) { const float* src = m < MPROMPT ? KIN(0) + (size_t)m * D : KIN(1) + (size_t)(m - MPROMPT) * D; row_to_bf16(src, XB + (size_t)m * D, lane); } }
    grid.sync();

    layer_body<0>(lds);
    layer_body<1>(lds);
}

extern "C" void kernel_launch(void* const* d_in, const int* in_sizes, int n_in, void* d_out, int out_size, void* d_ws, size_t ws_size, hipStream_t stream) {
    static int grid_blocks = 0;
    if (grid_blocks == 0) {
        if (n_in != 24 || out_size != M * D || ws_size < WS_END) { fprintf(stderr, "kernel_launch: unexpected shapes (n_in %d out %d ws %zu)\n", n_in, out_size, ws_size); grid_blocks = -1; return; }
        int dev = 0, cus = 0, per_cu = 0;
        (void)hipGetDevice(&dev); (void)hipDeviceGetAttribute(&cus, hipDeviceAttributeMultiprocessorCount, dev);
        if (hipFuncSetAttribute((const void*)fwd_mega, hipFuncAttributeMaxDynamicSharedMemorySize, LDS_BYTES) != hipSuccess) { fprintf(stderr, "kernel_launch: hipFuncSetAttribute failed\n"); grid_blocks = -1; return; }
        if (hipOccupancyMaxActiveBlocksPerMultiprocessor(&per_cu, (const void*)fwd_mega, NT, LDS_BYTES) != hipSuccess || per_cu < 1) { fprintf(stderr, "kernel_launch: occupancy query gave %d\n", per_cu); per_cu = 1; }
        (void)hipGetLastError();
        grid_blocks = cus * per_cu;
    }
    if (grid_blocks < 0) return;
    Params p{};
    for (int i = 0; i < 24; ++i) p.in[i] = (const float*)d_in[i];
    p.out = (float*)d_out; p.ws = (unsigned char*)d_ws;
    void* args[] = {&p};
    hipError_t e = hipLaunchCooperativeKernel((const void*)fwd_mega, dim3(grid_blocks), dim3(NT), args, LDS_BYTES, stream);
    if (e != hipSuccess) fprintf(stderr, "cooperative launch failed: %s (grid %d)\n", hipGetErrorString(e), grid_blocks);
}
```

```cpp
#include <hip/hip_runtime.h>
#include <hip/hip_cooperative_groups.h>
#include <cstdio>
#include <cstdint>
namespace cg = cooperative_groups;
namespace pg8 {
#define PG8_LAS __attribute__((address_space(3)))
typedef unsigned short bf16_t;
typedef short bf16x8 __attribute__((ext_vector_type(8)));
typedef float f32x4 __attribute__((ext_vector_type(4)));
typedef unsigned u32x4 __attribute__((ext_vector_type(4)));
constexpr int BM = 256, BK = 64, HALF = 128, HTB = HALF * BK * 2  , STAGE_BYTES = 8 * HTB, NXCD = 8, WGM = 8;

__host__ __device__ __forceinline__ int lds_byte(int r, int c) { const int st = (r >> 4) * 2 + (c >> 5), rr = r & 15, cc = c & 31, ob = rr * 64 + cc * 2; return st * 1024 + (ob ^ (((ob >> 9) & 1) << 5)); }
__host__ __device__ __forceinline__ void stage_rc(int b, int& R, int& C) { const int st = b / 1024, sb = b % 1024, swz = sb ^ (((sb >> 9) & 1) << 5); R = (st >> 1) * 16 + swz / 64; C = (st & 1) * 32 + (swz % 64) / 2; }
__host__ __device__ __forceinline__ int perm32(int rho) { const int n = rho >> 4, i = rho & 15; return 8 * (i >> 2) + 4 * n + (i & 3); }

struct Unit { int pm, pn; };
struct Gemm { const bf16_t* A; const bf16_t* Bt; int M, N, K; };

struct StaticOrder {
    int nM, nN, nwg, G, c;
    __host__ __device__ void init(int M, int N, int G_, int c_) { nM = M / BM; nN = N / BM; nwg = nM * nN; G = G_; c = c_; }
    __host__ __device__ bool next(int i, Unit& u) const {
        const long L = (long)i * G + c; if (L >= nwg) return false;
        int wgid = (int)L; { const int q = nwg / NXCD, r = nwg % NXCD, xcd = wgid % NXCD, off = wgid / NXCD; wgid = (xcd < r ? xcd * (q + 1) : r * (q + 1) + (xcd - r) * q) + off; }
        const int nig = WGM * nN, gid = wgid / nig, fm = gid * WGM, gsz = (nM - fm) < WGM ? (nM - fm) : WGM;
        u.pm = fm + ((wgid % nig) % gsz); u.pn = (wgid % nig) / gsz; return true;
    }
    __device__ __forceinline__ void a_ready(const Unit&) const {}
    __device__ __forceinline__ void done(const Unit&) const {}
};

typedef float f32x2e __attribute__((ext_vector_type(2)));
typedef __bf16 bf16x2e __attribute__((ext_vector_type(2)));
__device__ __forceinline__ unsigned pkbf(float a, float b) { f32x2e v = {a, b}; bf16x2e r = __builtin_convertvector(v, bf16x2e); return __builtin_bit_cast(unsigned, r); }
__device__ __forceinline__ float silu_f(float g) { return g * __builtin_amdgcn_rcpf(1.f + __builtin_amdgcn_exp2f(-1.4426950408889634f * g)); }
constexpr float ALPHA_F = 1.4142135623730951f;
constexpr int MPROMPT = 65536;

struct EpiSwiGLU {
    static constexpr bool PERM = true, AFTER_DRAIN = false, MID = false;
    bf16_t* H; int ldh;
    __device__ __forceinline__ void operator()(const f32x4 (&acc)[2][2][4][2], const Unit& u, int wr, int wc, int fr, int fq) const {
        const int row0 = u.pm * BM + wr * 64 + fr, col0 = u.pn * HALF + wc * 32 + 8 * fq;
#pragma unroll
        for (int ai = 0; ai < 2; ++ai)
#pragma unroll
            for (int m = 0; m < 4; ++m) {
                bf16_t* p = H + (size_t)(row0 + ai * HALF + m * 16) * ldh + col0;
                const f32x4 g0 = acc[ai][0][m][0], g1 = acc[ai][0][m][1], u0 = acc[ai][1][m][0], u1 = acc[ai][1][m][1];
                u32x4 w;
                w.x = pkbf(silu_f(g0[0]) * u0[0], silu_f(g0[1]) * u0[1]); w.y = pkbf(silu_f(g0[2]) * u0[2], silu_f(g0[3]) * u0[3]);
                w.z = pkbf(silu_f(g1[0]) * u1[0], silu_f(g1[1]) * u1[1]); w.w = pkbf(silu_f(g1[2]) * u1[2], silu_f(g1[3]) * u1[3]);
                *(u32x4*)p = w;
            }
    }
};
struct EpiResid {
    static constexpr bool PERM = false, AFTER_DRAIN = false, MID = false;
    const float* r0; const float* r1; float* out; float scale;
    __device__ __forceinline__ void operator()(const f32x4 (&acc)[2][2][4][2], const Unit& u, int wr, int wc, int fr, int fq) const {
        const float* rbase = (u.pm * BM < MPROMPT) ? r0 : r1;
#pragma unroll
        for (int ai = 0; ai < 2; ++ai)
#pragma unroll
            for (int m = 0; m < 4; ++m) {
                const size_t roff = (size_t)(u.pm * BM + ai * HALF + wr * 64 + m * 16 + fr) * 1024;
#pragma unroll
                for (int bj = 0; bj < 2; ++bj)
#pragma unroll
                    for (int n = 0; n < 2; ++n) {
                        const int c = u.pn * BM + bj * HALF + wc * 32 + n * 16 + 4 * fq;
                        const f32x4 b = *(const f32x4*)(rbase + roff + c);
                        *(f32x4*)(out + roff + c) = b * ALPHA_F + acc[ai][bj][m][n] * scale;
                    }
            }
    }
};
struct EpiResidBf {
    static constexpr bool PERM = true, AFTER_DRAIN = false, MID = false;
    bf16_t* X; float scale;
    __device__ __forceinline__ void operator()(const f32x4 (&acc)[2][2][4][2], const Unit& u, int wr, int wc, int fr, int fq) const {
        const int row0 = u.pm * BM + wr * 64 + fr, col0 = u.pn * BM + wc * 32 + 8 * fq;
#pragma unroll
        for (int ai = 0; ai < 2; ++ai)
#pragma unroll
            for (int m = 0; m < 4; ++m) { bf16_t* rowp = X + (size_t)(row0 + ai * HALF + m * 16) * 1024 + col0;
#pragma unroll
                for (int bj = 0; bj < 2; ++bj) { const u32x4 xv = *(const u32x4*)(rowp + bj * HALF); const f32x4 a0 = acc[ai][bj][m][0] * scale, a1 = acc[ai][bj][m][1] * scale;
                    u32x4 w;
                    w.x = pkbf(__uint_as_float(xv.x << 16) * ALPHA_F + a0[0], __uint_as_float(xv.x & 0xffff0000u) * ALPHA_F + a0[1]);
                    w.y = pkbf(__uint_as_float(xv.y << 16) * ALPHA_F + a0[2], __uint_as_float(xv.y & 0xffff0000u) * ALPHA_F + a0[3]);
                    w.z = pkbf(__uint_as_float(xv.z << 16) * ALPHA_F + a1[0], __uint_as_float(xv.z & 0xffff0000u) * ALPHA_F + a1[1]);
                    w.w = pkbf(__uint_as_float(xv.w << 16) * ALPHA_F + a1[2], __uint_as_float(xv.w & 0xffff0000u) * ALPHA_F + a1[3]);
                    *(u32x4*)(rowp + bj * HALF) = w; } }
    }
};
struct EpiResidMix {
    static constexpr bool PERM = false, AFTER_DRAIN = false, MID = true;
    float* out; const float* ssq;
    __device__ __forceinline__ void mid(f32x4 (&acc)[2][2][4][2], const Unit& u, int wr, int wc, int fr, int fq) const {
#pragma unroll
        for (int ai = 0; ai < 2; ++ai)
#pragma unroll
            for (int m = 0; m < 4; ++m) { const int r = u.pm * BM + ai * HALF + wr * 64 + m * 16 + fr;
                const float f = sqrtf((ssq[81920 + r] * (1.f / 512.f) + 1e-6f) / (ssq[r] * (1.f / 512.f) + 1e-6f));
#pragma unroll
                for (int bj = 0; bj < 2; ++bj)
#pragma unroll
                    for (int n = 0; n < 2; ++n) acc[ai][bj][m][n] = acc[ai][bj][m][n] * f; }
    }
    __device__ __forceinline__ void operator()(const f32x4 (&acc)[2][2][4][2], const Unit& u, int wr, int wc, int fr, int fq) const {
#pragma unroll
        for (int ai = 0; ai < 2; ++ai)
#pragma unroll
            for (int m = 0; m < 4; ++m) { const int r = u.pm * BM + ai * HALF + wr * 64 + m * 16 + fr; const size_t roff = (size_t)r * 1024;
                const float f = 1.f / sqrtf(ssq[81920 + r] * (1.f / 512.f) + 1e-6f);
#pragma unroll
                for (int bj = 0; bj < 2; ++bj)
#pragma unroll
                    for (int n = 0; n < 2; ++n) { const int c = u.pn * BM + bj * HALF + wc * 32 + n * 16 + 4 * fq;
                        const f32x4 b = *(const f32x4*)(out + roff + c);
                        *(f32x4*)(out + roff + c) = b * ALPHA_F + acc[ai][bj][m][n] * f; } }
    }
};
struct EpiProj {
    static constexpr bool PERM = true, AFTER_DRAIN = false, MID = false;
    bf16_t* QKV; bf16_t* Z; bf16_t* XBC; float* DT;
    __device__ __forceinline__ void operator()(const f32x4 (&acc)[2][2][4][2], const Unit& u, int wr, int wc, int fr, int fq) const {
        const int row0 = u.pm * BM + wr * 64 + fr, pn = u.pn;
        if (pn == 12) {
            if (wc == 0 && fq < 2) {
#pragma unroll
                for (int ai = 0; ai < 2; ++ai)
#pragma unroll
                    for (int m = 0; m < 4; ++m) { float* p = DT + (size_t)(row0 + ai * HALF + m * 16) * 16 + 8 * fq;
                        *(f32x4*)p = acc[ai][0][m][0]; *(f32x4*)(p + 4) = acc[ai][0][m][1]; }
            }
            return;
        }
        bf16_t* base; int ldc, colt; float sc = 1.f;
        if (pn < 6) { base = QKV; ldc = 1536; colt = pn * 256; if (pn < 2) sc = 0.125f * 1.4426950408889634f; }
        else if (pn < 8) { base = Z; ldc = 512; colt = (pn - 6) * 256; }
        else { base = XBC; ldc = 1024; colt = (pn - 8) * 256; }
        const int col0 = colt + wc * 32 + 8 * fq;
#pragma unroll
        for (int ai = 0; ai < 2; ++ai)
#pragma unroll
            for (int m = 0; m < 4; ++m) { bf16_t* rowp = base + (size_t)(row0 + ai * HALF + m * 16) * ldc + col0;
#pragma unroll
                for (int bj = 0; bj < 2; ++bj) { const f32x4 v0 = acc[ai][bj][m][0] * sc, v1 = acc[ai][bj][m][1] * sc;
                    u32x4 w; w.x = pkbf(v0[0], v0[1]); w.y = pkbf(v0[2], v0[3]); w.z = pkbf(v1[0], v1[1]); w.w = pkbf(v1[2], v1[3]);
                    *(u32x4*)(rowp + bj * HALF) = w; } }
    }
};

template <class Epi, class Sched, bool ALIGN_EPI = false, bool SP2 = false>
__device__ __forceinline__ void gemm_phase(PG8_LAS unsigned char* lds, const Gemm g, const Sched& S, const Epi& E) {
    int tid_ = threadIdx.x; asm volatile("" : "+v"(tid_));
    const int tid = tid_, wid = __builtin_amdgcn_readfirstlane(tid >> 6), lane = tid & 63, wr = wid >> 2, wc = wid & 3, fr = lane & 15, fq = lane >> 4;
    const int K = g.K, nt = K / BK;
    unsigned voffA[2], voffB[2];
#pragma unroll
    for (int i = 0; i < 2; ++i) { int R, C; stage_rc(tid * 16 + i * 8192, R, C); const int Rb = Epi::PERM ? ((R & ~31) + perm32(R & 31)) : R;
        voffA[i] = (unsigned)(R * K + C) * 2u; voffB[i] = (unsigned)(Rb * K + C) * 2u; }
    const size_t kstep = (size_t)(BK * 2);
    const size_t hstep = (size_t)HALF * K * 2;
    const size_t tstep = 2 * hstep;
    const unsigned ldsw = (unsigned)wid * 1024u;
    const int aoff = lds_byte(wr * 64 + fr, fq * 8), boff = lds_byte(wc * 32 + fr, fq * 8);
#define PG8_SA(b, h) (((b) * 2 + (h)) * HTB)
#define PG8_SB(b, h) ((4 + (b) * 2 + (h)) * HTB)
#define PG8_STAGE(bufoff, gbase, voff) do { _Pragma("unroll") for (int _i = 0; _i < 2; ++_i) \
        __builtin_amdgcn_global_load_lds((const unsigned*)((const char*)(gbase) + (voff)[_i]), (PG8_LAS unsigned*)(lds + (bufoff) + ldsw + _i * 8192), 16, 0, 0); } while (0)
#define PG8_LDA(dst, b, h) do { _Pragma("unroll") for (int m = 0; m < 4; ++m) _Pragma("unroll") for (int k = 0; k < 2; ++k) dst[m][k] = *(const PG8_LAS bf16x8*)(lds + PG8_SA(b, h) + aoff + m * 2048 + k * 1024); } while (0)
#define PG8_LDB(dst, b, h) do { _Pragma("unroll") for (int n = 0; n < 2; ++n) _Pragma("unroll") for (int k = 0; k < 2; ++k) dst[n][k] = *(const PG8_LAS bf16x8*)(lds + PG8_SB(b, h) + boff + n * 2048 + k * 1024); } while (0)
#define PG8_MMA(ai, bj, At, Bt) do { __builtin_amdgcn_s_setprio(1); _Pragma("unroll") for (int m = 0; m < 4; ++m) _Pragma("unroll") for (int n = 0; n < 2; ++n) _Pragma("unroll") for (int k = 0; k < 2; ++k) \
        acc[ai][bj][m][n] = __builtin_amdgcn_mfma_f32_16x16x32_bf16(Bt[n][k], At[m][k], acc[ai][bj][m][n], 0, 0, 0); __builtin_amdgcn_s_setprio(0); } while (0)
#define PG8_WAIT_V(n) asm volatile("s_waitcnt vmcnt(" #n ")" ::: "memory")
#define PG8_WAIT_L(n) asm volatile("s_waitcnt lgkmcnt(" #n ")" ::: "memory")
#define PG8_BAR __builtin_amdgcn_s_barrier()
#define PG8_SCHED __builtin_amdgcn_sched_barrier(0)
    Unit cur, nxt; int ui = 0;
    if (!S.next(0, cur)) return;
    f32x4 acc[2][2][4][2];
#pragma unroll
    for (int a = 0; a < 2; ++a)
#pragma unroll
        for (int b = 0; b < 2; ++b)
#pragma unroll
            for (int m = 0; m < 4; ++m)
#pragma unroll
                for (int n = 0; n < 2; ++n) acc[a][b][m][n] = (f32x4){0.f, 0.f, 0.f, 0.f};
    bf16x8 At[4][2], B0[2][2], B1[2][2];
    const char* cA = (const char*)g.A + (size_t)cur.pm * tstep; const char* cB = (const char*)g.Bt + (size_t)cur.pn * tstep;
    S.a_ready(cur);
    if constexpr (SP2) {
        PG8_STAGE(PG8_SB(0, 0), cB, voffB); PG8_STAGE(PG8_SB(0, 1), cB + hstep, voffB); PG8_STAGE(PG8_SA(0, 0), cA, voffA); PG8_STAGE(PG8_SA(0, 1), cA + hstep, voffA);
        if (wr == 1) PG8_BAR;
        PG8_WAIT_V(2); PG8_BAR;
        PG8_STAGE(PG8_SB(1, 0), cB + kstep, voffB); PG8_STAGE(PG8_SA(1, 0), cA + kstep, voffA); PG8_STAGE(PG8_SB(1, 1), cB + hstep + kstep, voffB);
        PG8_WAIT_V(6); PG8_BAR;
    } else {
        PG8_STAGE(PG8_SB(0, 0), cB, voffB); PG8_STAGE(PG8_SA(0, 0), cA, voffA); PG8_STAGE(PG8_SB(0, 1), cB + hstep, voffB); PG8_STAGE(PG8_SA(0, 1), cA + hstep, voffA);
        if (wr == 1) PG8_BAR;
        PG8_WAIT_V(4); PG8_BAR;
        PG8_STAGE(PG8_SB(1, 0), cB + kstep, voffB); PG8_STAGE(PG8_SA(1, 0), cA + kstep, voffA); PG8_STAGE(PG8_SB(1, 1), cB + hstep + kstep, voffB);
        PG8_WAIT_V(6); PG8_BAR;
    }
    for (;;) {
        const bool has_next = S.next(ui + 1, nxt);
        const char* nA = has_next ? (const char*)g.A + (size_t)nxt.pm * tstep : cA; const char* nB = has_next ? (const char*)g.Bt + (size_t)nxt.pn * tstep : cB;
        for (int t = 0; t < nt; t += 2) {
            if constexpr (Epi::MID) { if (t == (nt >> 1)) E.mid(acc, cur, wr, wc, fr, fq); }
            const bool last = (t == nt - 2);
            const char* a1 = cA + (size_t)(t + 1) * kstep;
            const char* a2 = last ? nA : cA + (size_t)(t + 2) * kstep; const char* b2 = last ? nB : cB + (size_t)(t + 2) * kstep;
            const char* a3 = a2 + kstep; const char* b3 = b2 + kstep;
            if (last && has_next) S.a_ready(nxt);
            if constexpr (SP2) {
            PG8_LDB(B0, 0, 0); PG8_LDB(B1, 0, 1); PG8_SCHED; PG8_LDA(At, 0, 0); PG8_STAGE(PG8_SA(1, 1), a1 + hstep, voffA);
            PG8_WAIT_V(8); PG8_WAIT_L(0); PG8_BAR; PG8_MMA(0, 0, At, B0); PG8_MMA(0, 1, At, B1); PG8_BAR; PG8_SCHED;
            PG8_LDA(At, 0, 1); PG8_STAGE(PG8_SB(0, 0), b2, voffB); PG8_STAGE(PG8_SB(0, 1), b2 + hstep, voffB); PG8_STAGE(PG8_SA(0, 0), a2, voffA);
            PG8_WAIT_V(8); PG8_WAIT_L(0); PG8_BAR; PG8_MMA(1, 0, At, B0); PG8_MMA(1, 1, At, B1); PG8_BAR; PG8_SCHED;
            PG8_LDB(B0, 1, 0); PG8_LDB(B1, 1, 1); PG8_SCHED; PG8_LDA(At, 1, 0); PG8_STAGE(PG8_SA(0, 1), a2 + hstep, voffA);
            PG8_WAIT_V(8); PG8_WAIT_L(0); PG8_BAR; PG8_MMA(0, 0, At, B0); PG8_MMA(0, 1, At, B1); PG8_BAR; PG8_SCHED;
            PG8_LDA(At, 1, 1); PG8_STAGE(PG8_SB(1, 0), b3, voffB); PG8_STAGE(PG8_SB(1, 1), b3 + hstep, voffB); PG8_STAGE(PG8_SA(1, 0), a3, voffA);
            PG8_WAIT_V(8); PG8_WAIT_L(0); PG8_BAR; PG8_MMA(1, 0, At, B0); PG8_MMA(1, 1, At, B1); PG8_BAR; PG8_SCHED;
            } else {
            PG8_LDB(B0, 0, 0); PG8_SCHED; PG8_LDA(At, 0, 0); PG8_STAGE(PG8_SA(1, 1), a1 + hstep, voffA);
            PG8_WAIT_L(8); PG8_BAR; PG8_WAIT_L(0); PG8_MMA(0, 0, At, B0); PG8_BAR; PG8_SCHED;
            PG8_LDB(B1, 0, 1); PG8_STAGE(PG8_SB(0, 0), b2, voffB);
            PG8_BAR; PG8_WAIT_L(0); PG8_MMA(0, 1, At, B1); PG8_BAR;
            PG8_LDA(At, 0, 1); PG8_STAGE(PG8_SA(0, 0), a2, voffA);
            PG8_BAR; PG8_WAIT_L(0); PG8_MMA(1, 0, At, B0); PG8_BAR; PG8_SCHED;
            PG8_STAGE(PG8_SB(0, 1), b2 + hstep, voffB);
            PG8_WAIT_V(6); PG8_BAR; PG8_MMA(1, 1, At, B1); PG8_BAR;
            PG8_LDB(B0, 1, 0); PG8_SCHED; PG8_LDA(At, 1, 0); PG8_STAGE(PG8_SA(0, 1), a2 + hstep, voffA);
            PG8_WAIT_L(8); PG8_BAR; PG8_WAIT_L(0); PG8_MMA(0, 0, At, B0); PG8_BAR; PG8_SCHED;
            PG8_LDB(B1, 1, 1); PG8_STAGE(PG8_SB(1, 0), b3, voffB);
            PG8_BAR; PG8_WAIT_L(0); PG8_MMA(0, 1, At, B1); PG8_BAR;
            PG8_LDA(At, 1, 1); PG8_STAGE(PG8_SA(1, 0), a3, voffA);
            PG8_BAR; PG8_WAIT_L(0); PG8_MMA(1, 0, At, B0); PG8_BAR; PG8_SCHED;
            PG8_STAGE(PG8_SB(1, 1), b3 + hstep, voffB);
            PG8_WAIT_V(6); PG8_BAR; PG8_MMA(1, 1, At, B1); PG8_BAR;
            }
        }
        if constexpr (ALIGN_EPI) { if (wr == 0) PG8_BAR; }
        if constexpr (!Epi::AFTER_DRAIN) { E(acc, cur, wr, wc, fr, fq); S.done(cur); }
        if (!has_next) break;
#pragma unroll
        for (int a = 0; a < 2; ++a)
#pragma unroll
            for (int b = 0; b < 2; ++b)
#pragma unroll
                for (int m = 0; m < 4; ++m)
#pragma unroll
                    for (int n = 0; n < 2; ++n) acc[a][b][m][n] = (f32x4){0.f, 0.f, 0.f, 0.f};
        cur = nxt; cA = nA; cB = nB; ++ui;
        if constexpr (ALIGN_EPI) { if (wr == 1) PG8_BAR; }
    }
    PG8_WAIT_V(0);
    if constexpr (!ALIGN_EPI) { if (wr == 0) PG8_BAR; }
    PG8_BAR;
    if constexpr (Epi::AFTER_DRAIN) { E.fused(acc, cur, wr, wc, fr, fq, lds, wid, lane); S.done(cur); }
#undef PG8_SA
#undef PG8_SB
#undef PG8_STAGE
#undef PG8_LDA
#undef PG8_LDB
#undef PG8_MMA
#undef PG8_WAIT_V
#undef PG8_WAIT_L
#undef PG8_BAR
#undef PG8_SCHED
}
}

#define LAS __attribute__((address_space(3)))
typedef unsigned short bf16;
using pg8::f32x4; using pg8::u32x4; using pg8::pkbf; using pg8::silu_f; using pg8::MPROMPT;
typedef unsigned u32x2 __attribute__((ext_vector_type(2)));
constexpr int NWAVES = 8, NT = 512;
constexpr int M = 81920, D = 1024, FF = 2816, NGU = 5632, NIN = 3328, NPROJ = 3088;
constexpr float LN_EPS = 1e-5f, RMS_EPS = 1e-6f;
constexpr size_t MiB = 1u << 20;
constexpr size_t WS_W = 1 * MiB, W_LAYER = 42 * MiB;
constexpr size_t OW_GU1 = 0, OW_D1 = 11534336, OW_IN = 17301504, OW_OUT = 24117248, OW_GU2 = 26214400, OW_D2 = 37748736;
constexpr size_t WS_XB = 85 * MiB, WS_R = 245 * MiB, WS_QKV = WS_R, WS_Z = WS_R + 240 * MiB, WS_RAW = WS_R + 320 * MiB, WS_H = WS_R;
constexpr size_t WS_Y = 725 * MiB;
constexpr size_t WS_XT = 725 * MiB, WS_BT = 805 * MiB, WS_BTOK = 845 * MiB, WS_CTOK = 885 * MiB;
constexpr size_t WS_CUM = 925 * MiB, WS_DTA = 930 * MiB, WS_WST = 935 * MiB;
constexpr size_t WS_DT = 940 * MiB, WS_SSQ = 945 * MiB, WS_TB = 946 * MiB, WS_END = 948 * MiB;
constexpr size_t WS_PREV = WS_RAW;
constexpr int LDS_BYTES = 155648;

#define LDS_WAIT() asm volatile("s_waitcnt lgkmcnt(0)" ::: "memory")
__device__ __forceinline__ float bf_lo(unsigned u) { return __uint_as_float(u << 16); }
__device__ __forceinline__ float bf_hi(unsigned u) { return __uint_as_float(u & 0xffff0000u); }
__device__ __forceinline__ float bf2f(bf16 v) { return __uint_as_float(((unsigned)v) << 16); }
__device__ __forceinline__ bf16 f2bf(float f) { return (bf16)(pkbf(f, 0.f) & 0xffffu); }
__device__ __forceinline__ float wave_sum(float v) {
#pragma unroll
    for (int o = 1; o < 64; o <<= 1) v += __shfl_xor(v, o);
    return v;
}
__device__ __forceinline__ float wave_max(float v) {
#pragma unroll
    for (int o = 1; o < 64; o <<= 1) v = fmaxf(v, __shfl_xor(v, o));
    return v;
}

struct Params { const float* in[24]; float* out; unsigned char* ws; };
__device__ __forceinline__ unsigned long long karg_u64(int i) { int j = i; asm volatile("" : "+s"(j)); const __attribute__((address_space(4))) unsigned long long* ka = (const __attribute__((address_space(4))) unsigned long long*)__builtin_amdgcn_kernarg_segment_ptr(); return ka[j]; }
#define KIN(i) ((const float*)karg_u64(i))
#define KOUT() ((float*)karg_u64(24))
#define KWS() ((unsigned char*)karg_u64(25))

__device__ __forceinline__ void tr_item(const float* W, int ldw, int ncols, bf16* WT, int Kdst, int k0, int n0, int drow, LAS float* scr, int lane) {
    int n = n0 + (lane & 31); n = n < ncols ? n : ncols - 1;
#pragma unroll 8
    for (int i = 0; i < 32; ++i) { const int kk = 2 * i + (lane >> 5); scr[kk * 33 + (lane & 31)] = W[(size_t)(k0 + kk) * ldw + n]; }
    LDS_WAIT(); asm volatile("" ::: "memory");
    const int c = lane & 7;
#pragma unroll
    for (int j = 0; j < 4; ++j) { const int nn = (lane >> 3) + 8 * j; const LAS float* s = scr + (8 * c) * 33 + nn;
        u32x4 o; o.x = pkbf(s[0 * 33], s[1 * 33]); o.y = pkbf(s[2 * 33], s[3 * 33]); o.z = pkbf(s[4 * 33], s[5 * 33]); o.w = pkbf(s[6 * 33], s[7 * 33]);
        *(u32x4*)(WT + (size_t)(drow + nn) * Kdst + k0 + 8 * c) = o; }
    LDS_WAIT(); asm volatile("" ::: "memory");
}
constexpr int IT_GU = 16 * 88, IT_D = 44 * 32, IT_IN = 16 * 97, IT_OUT = 16 * 32, IT_LAYER = 6 * IT_GU + IT_IN + IT_OUT;
__device__ __forceinline__ void prologue_item(unsigned char* wsb, int it, LAS float* scr, int lane) {
    const int l = it / IT_LAYER; int r = it % IT_LAYER;
    unsigned char* wl = wsb + WS_W + (size_t)l * W_LAYER;
    if (r < 2 * IT_GU) { const int up = r >= IT_GU; r -= up * IT_GU; const int kb = r / 88, nb = r % 88, n0 = 32 * nb;
        tr_item(KIN(up ? 3 : 2) + (size_t)l * D * FF, FF, FF, (bf16*)(wl + OW_GU1), D, 64 * kb, n0, 256 * (n0 >> 7) + (n0 & 127) + 128 * up, scr, lane); return; }
    r -= 2 * IT_GU;
    if (r < IT_D) { const int kb = r / 32, nb = r % 32; tr_item(KIN(4) + (size_t)l * FF * D, D, D, (bf16*)(wl + OW_D1), FF, 64 * kb, 32 * nb, 32 * nb, scr, lane); return; }
    r -= IT_D;
    if (r < IT_IN) { const int kb = r / 97, nb = r % 97; tr_item(KIN(7) + (size_t)l * D * NPROJ, NPROJ, NPROJ, (bf16*)(wl + OW_IN), D, 64 * kb, 32 * nb, 32 * nb, scr, lane); return; }
    r -= IT_IN;
    if (r < IT_OUT) { const int kb = r / 32, nb = r % 32; tr_item(KIN(16) + (size_t)l * D * D, D, D, (bf16*)(wl + OW_OUT), D, 64 * kb, 32 * nb, 32 * nb, scr, lane); return; }
    r -= IT_OUT;
    if (r < 2 * IT_GU) { const int up = r >= IT_GU; r -= up * IT_GU; const int kb = r / 88, nb = r % 88, n0 = 32 * nb;
        tr_item(KIN(up ? 20 : 19) + (size_t)l * D * FF, FF, FF, (bf16*)(wl + OW_GU2), D, 64 * kb, n0, 256 * (n0 >> 7) + (n0 & 127) + 128 * up, scr, lane); return; }
    r -= 2 * IT_GU;
    { const int kb = r / 32, nb = r % 32; tr_item(KIN(21) + (size_t)l * FF * D, D, D, (bf16*)(wl + OW_D2), FF, 64 * kb, 32 * nb, 32 * nb, scr, lane); }
}
__device__ __forceinline__ void row_to_bf16(const float* xrow, bf16* orow, int lane) {
    const f32x4* xr = (const f32x4*)xrow + lane; u32x2* o8 = (u32x2*)orow + lane;
#pragma unroll
    for (int j = 0; j < 4; ++j) { const f32x4 v = xr[64 * j]; u32x2 w; w.x = pkbf(v[0], v[1]); w.y = pkbf(v[2], v[3]); o8[64 * j] = w; }
}
__device__ __forceinline__ void ln_row(float* xrow, bf16* orow, const float* g, const float* b, int lane) {
    f32x4* xr = (f32x4*)xrow + lane; f32x4 v[4]; float s = 0.f;
#pragma unroll
    for (int j = 0; j < 4; ++j) { v[j] = xr[64 * j]; s += (v[j][0] + v[j][1]) + (v[j][2] + v[j][3]); }
    const float mean = wave_sum(s) * (1.f / D); float s2 = 0.f;
#pragma unroll
    for (int j = 0; j < 4; ++j) { v[j] = v[j] - mean; s2 += (v[j][0] * v[j][0] + v[j][1] * v[j][1]) + (v[j][2] * v[j][2] + v[j][3] * v[j][3]); }
    const float rstd = 1.f / sqrtf(wave_sum(s2) * (1.f / D) + LN_EPS);
    u32x2* o8 = (u32x2*)orow + lane;
#pragma unroll
    for (int j = 0; j < 4; ++j) { const f32x4 gv = ((const f32x4*)g)[lane + 64 * j], bv = ((const f32x4*)b)[lane + 64 * j];
        const f32x4 o = v[j] * rstd * gv + bv; xr[64 * j] = o; u32x2 w; w.x = pkbf(o[0], o[1]); w.y = pkbf(o[2], o[3]); o8[64 * j] = w; }
}

__device__ __forceinline__ void ln_row_bf(bf16* xrow, float* fout, const float* g, const float* b, int lane) {
    u32x4* xr = (u32x4*)xrow + lane; float v[16]; float s = 0.f;
#pragma unroll
    for (int j = 0; j < 2; ++j) { const u32x4 t = xr[64 * j]; v[8 * j] = bf_lo(t.x); v[8 * j + 1] = bf_hi(t.x); v[8 * j + 2] = bf_lo(t.y); v[8 * j + 3] = bf_hi(t.y); v[8 * j + 4] = bf_lo(t.z); v[8 * j + 5] = bf_hi(t.z); v[8 * j + 6] = bf_lo(t.w); v[8 * j + 7] = bf_hi(t.w); }
#pragma unroll
    for (int e = 0; e < 16; ++e) s += v[e];
    const float mean = wave_sum(s) * (1.f / D); float s2 = 0.f;
#pragma unroll
    for (int e = 0; e < 16; ++e) { v[e] -= mean; s2 += v[e] * v[e]; }
    const float rstd = 1.f / sqrtf(wave_sum(s2) * (1.f / D) + LN_EPS);
#pragma unroll
    for (int j = 0; j < 2; ++j) { const int c = 512 * j + 8 * lane; const f32x4 g0 = *(const f32x4*)(g + c), g1 = *(const f32x4*)(g + c + 4), b0 = *(const f32x4*)(b + c), b1 = *(const f32x4*)(b + c + 4);
        const f32x4 o0 = {v[8 * j] * rstd * g0[0] + b0[0], v[8 * j + 1] * rstd * g0[1] + b0[1], v[8 * j + 2] * rstd * g0[2] + b0[2], v[8 * j + 3] * rstd * g0[3] + b0[3]};
        const f32x4 o1 = {v[8 * j + 4] * rstd * g1[0] + b1[0], v[8 * j + 5] * rstd * g1[1] + b1[1], v[8 * j + 6] * rstd * g1[2] + b1[2], v[8 * j + 7] * rstd * g1[3] + b1[3]};
        if (fout) { *(f32x4*)(fout + c) = o0; *(f32x4*)(fout + c + 4) = o1; }
        else { u32x4 w; w.x = pkbf(o0[0], o0[1]); w.y = pkbf(o0[2], o0[3]); w.z = pkbf(o1[0], o1[1]); w.w = pkbf(o1[2], o1[3]); xr[64 * j] = w; } }
}

__device__ __forceinline__ void seq_of_row(int m, int& s0, int& T) { if (m < MPROMPT) { s0 = m & ~2047; T = 2048; } else { s0 = MPROMPT + ((m - MPROMPT) & ~4095); T = 4096; } }
__device__ __forceinline__ void conv8(const bf16* raw, int m, int tl, int T, int c0, const float* cw, const float* cb, float (&o)[8]) {
    const f32x4 b0 = *(const f32x4*)(cb + c0), b1 = *(const f32x4*)(cb + c0 + 4);
    float a[8] = {b0[0], b0[1], b0[2], b0[3], b1[0], b1[1], b1[2], b1[3]};
#pragma unroll
    for (int j = 0; j < 5; ++j) { const int tt = tl + j - 2;
        if (tt >= 0 && tt < T) { const u32x4 v = *(const u32x4*)(raw + (size_t)(m + j - 2) * 1024 + c0);
            const f32x4 w0 = *(const f32x4*)(cw + j * 1024 + c0), w1 = *(const f32x4*)(cw + j * 1024 + c0 + 4);
            a[0] += bf_lo(v.x) * w0[0]; a[1] += bf_hi(v.x) * w0[1]; a[2] += bf_lo(v.y) * w0[2]; a[3] += bf_hi(v.y) * w0[3];
            a[4] += bf_lo(v.z) * w1[0]; a[5] += bf_hi(v.z) * w1[1]; a[6] += bf_lo(v.w) * w1[2]; a[7] += bf_hi(v.w) * w1[3]; } }
#pragma unroll
    for (int e = 0; e < 8; ++e) o[e] = silu_f(a[e]);
}
__device__ __forceinline__ float softplus_f(float x) { return x > 20.f ? x : log1pf(expf(x)); }

constexpr int SCAN_DIR_F = 10368;
__device__ __forceinline__ void scan_naive_unit(int b, int h, const bf16* raw, const float* DT, float* Y, const float* cw, const float* cb, const float* dt_bias, const float* a_log, const float* d_skip, LAS float* L, int tid, int wave, int lane) {
    int s0, T; if (b < 32) { s0 = b * 2048; T = 2048; } else { s0 = MPROMPT + (b - 32) * 4096; T = 4096; }
    const int g = h >> 2, dir = wave >> 2, pb = wave & 3, p = pb * 16 + (lane & 15), nq = lane >> 4;
    const float a = -expf(a_log[dir * 8 + h]), dskip = d_skip[h], dtb = dt_bias[dir * 8 + h];
    float s[32];
#pragma unroll
    for (int k = 0; k < 32; ++k) s[k] = 0.f;
    LAS float* Lw = L + dir * SCAN_DIR_F;
    const int nblk = T >> 5;
    for (int blk = 0; blk < nblk; ++blk) {
        __syncthreads();
        const int tbase = dir == 0 ? 32 * blk : T - 32 * (blk + 1);
        { const int r_ = tid & 255, tok = r_ >> 3, part = r_ & 7, tl = tbase + tok, m = s0 + tl; float o[8];
          conv8(raw, m, tl, T, 512 + 128 * g + 16 * part, cw, cb, o);
#pragma unroll
          for (int e = 0; e < 8; ++e) Lw[tok * 128 + 16 * part + e] = o[e];
          conv8(raw, m, tl, T, 512 + 128 * g + 16 * part + 8, cw, cb, o);
#pragma unroll
          for (int e = 0; e < 8; ++e) Lw[tok * 128 + 16 * part + 8 + e] = o[e];
          conv8(raw, m, tl, T, 768 + 128 * g + 16 * part, cw, cb, o);
#pragma unroll
          for (int e = 0; e < 8; ++e) Lw[4096 + tok * 128 + 16 * part + e] = o[e];
          conv8(raw, m, tl, T, 768 + 128 * g + 16 * part + 8, cw, cb, o);
#pragma unroll
          for (int e = 0; e < 8; ++e) Lw[4096 + tok * 128 + 16 * part + 8 + e] = o[e];
          conv8(raw, m, tl, T, h * 64 + 8 * part, cw, cb, o);
#pragma unroll
          for (int e = 0; e < 8; ++e) Lw[8192 + tok * 64 + 8 * part + e] = o[e];
          if (part == 0) { const float dtv = softplus_f(DT[(size_t)m * 16 + dir * 8 + h] + dtb); Lw[10240 + tok] = dtv; Lw[10272 + tok] = expf(dtv * a); }
        }
        __syncthreads();
        for (int i = 0; i < 32; ++i) {
            const int ti = dir == 0 ? i : 31 - i;
            const float d = Lw[10272 + ti], dtv = Lw[10240 + ti], xv = Lw[8192 + ti * 64 + p], xdt = xv * dtv;
            float y = 0.f;
#pragma unroll
            for (int k4 = 0; k4 < 8; ++k4) { const f32x4 bv = *(const LAS f32x4*)(Lw + ti * 128 + 32 * nq + 4 * k4), cv = *(const LAS f32x4*)(Lw + 4096 + ti * 128 + 32 * nq + 4 * k4);
#pragma unroll
                for (int e = 0; e < 4; ++e) { s[4 * k4 + e] = s[4 * k4 + e] * d + xdt * bv[e]; y += s[4 * k4 + e] * cv[e]; } }
            y += __shfl_xor(y, 16); y += __shfl_xor(y, 32);
            if (nq == 0) atomicAdd(Y + (size_t)(s0 + tbase + ti) * 512 + h * 64 + p, y + (dir == 0 ? dskip * xv : 0.f));
        }
    }
}

__device__ __forceinline__ void attn_naive_unit(int m, int wave, int lane, const bf16* QKV, const float* rpb, const float* gattn, bf16* MIX, LAS float* Ps, volatile LAS float* exch, int parity) {
    const int h = wave; int s0, T; seq_of_row(m, s0, T);
    const int tl = m - s0, r = tl >> 6, qc = tl & 63, rows = T >> 6;
    const int cstart = min(max(qc - 8, 0), 48), rs = min(max(r - 4, 0), rows - 8);
    float q[64];
    { const bf16* qp = QKV + (size_t)m * 1536 + h * 64;
#pragma unroll
      for (int i = 0; i < 8; ++i) { const u32x4 v = *(const u32x4*)(qp + 8 * i); q[8 * i] = bf_lo(v.x); q[8 * i + 1] = bf_hi(v.x); q[8 * i + 2] = bf_lo(v.y); q[8 * i + 3] = bf_hi(v.y);
          q[8 * i + 4] = bf_lo(v.z); q[8 * i + 5] = bf_hi(v.z); q[8 * i + 6] = bf_lo(v.w); q[8 * i + 7] = bf_hi(v.w); } }
    float sc[2];
#pragma unroll
    for (int k2 = 0; k2 < 2; ++k2) { const int kk = lane + 64 * k2, kri = kk >> 4, kci = kk & 15; const int kt = s0 + (rs + kri) * 64 + cstart + kci;
        const bf16* kp = QKV + (size_t)kt * 1536 + 512 + h * 64; float d = 0.f;
#pragma unroll
        for (int i = 0; i < 8; ++i) { const u32x4 v = *(const u32x4*)(kp + 8 * i);
            d += q[8 * i] * bf_lo(v.x) + q[8 * i + 1] * bf_hi(v.x) + q[8 * i + 2] * bf_lo(v.y) + q[8 * i + 3] * bf_hi(v.y) + q[8 * i + 4] * bf_lo(v.z) + q[8 * i + 5] * bf_hi(v.z) + q[8 * i + 6] * bf_lo(v.w) + q[8 * i + 7] * bf_hi(v.w); }
        sc[k2] = d + rpb[h * 465 + (rs + kri - r + 7) * 31 + (cstart + kci - qc + 15)]; }
    const float mx = wave_max(fmaxf(sc[0], sc[1]));
    const float p0 = __expf(sc[0] - mx), p1 = __expf(sc[1] - mx);
    const float inv = 1.f / wave_sum(p0 + p1);
    Ps[lane] = p0 * inv; Ps[lane + 64] = p1 * inv;
    LDS_WAIT(); asm volatile("" ::: "memory");
    float o = 0.f; const bf16* vbase = QKV + 1024 + h * 64 + lane;
#pragma unroll 4
    for (int kk = 0; kk < 128; kk += 4) { const f32x4 pv = *(const LAS f32x4*)(Ps + kk); const int kt = s0 + (rs + (kk >> 4)) * 64 + cstart + (kk & 15);
#pragma unroll
        for (int e = 0; e < 4; ++e) o += pv[e] * bf2f(vbase[(size_t)(kt + e) * 1536]); }
    const float ssq = wave_sum(o * o);
    if (lane == 0) exch[parity * 8 + h] = ssq;
    __syncthreads();
    float tot = 0.f;
#pragma unroll
    for (int i = 0; i < 8; ++i) tot += exch[parity * 8 + i];
    const float scl = 1.f / sqrtf(tot * (1.f / 512.f) + RMS_EPS);
    MIX[(size_t)m * 1024 + h * 64 + lane] = f2bf(o * scl * gattn[h * 64 + lane]);
}


typedef short bf16x8v __attribute__((ext_vector_type(8)));
typedef short s16x4v __attribute__((ext_vector_type(4)));
#define MFMA16(a, b, c) __builtin_amdgcn_mfma_f32_16x16x32_bf16((a), (b), (c), 0, 0, 0)
constexpr int VPITCH = 144, VHEAD = 512 * VPITCH;
__device__ __forceinline__ void attn_fast_unit(int u, const bf16* QKV, const float* TB  , const float* gattn, bf16* MIX, float* SSQA, LAS unsigned char* lds, int tid, int wave, int lane) {
    const int hp = u / 1280, gr = u % 1280;
    int s0, rows, r;
    if (gr < 1024) { s0 = (gr >> 5) * 2048; r = gr & 31; rows = 32; } else { const int g2 = gr - 1024; s0 = MPROMPT + (g2 >> 6) * 4096; r = g2 & 63; rows = 64; }
    const int rs = min(max(r - 4, 0), rows - 8);
    __syncthreads();
    { u32x4 v[16];
#pragma unroll
      for (int i = 0; i < 16; ++i) { const int id = i * 512 + tid, c = id & 7, key = (id >> 3) & 511, hh = id >> 12;
          v[i] = *(const u32x4*)(QKV + (size_t)(s0 + rs * 64 + key) * 1536 + 1024 + (2 * hp + hh) * 64 + 8 * c); }
#pragma unroll
      for (int i = 0; i < 16; ++i) { const int id = i * 512 + tid, c = id & 7, key = (id >> 3) & 511, hh = id >> 12;
          *(LAS u32x4*)(lds + hh * VHEAD + key * VPITCH + 16 * c) = v[i]; } }
    __syncthreads();
    const int hh = wave >> 2, j = wave & 3, h = 2 * hp + hh, fr = lane & 15, fq = lane >> 4;
    const int kstart = j == 0 ? 0 : (j == 1 ? 8 : (j == 2 ? 24 : 32));
    const int qtok = s0 + r * 64 + 16 * j + fr;
    const bf16x8v q0 = *(const bf16x8v*)(QKV + (size_t)qtok * 1536 + h * 64 + 8 * fq), q1 = *(const bf16x8v*)(QKV + (size_t)qtok * 1536 + h * 64 + 32 + 8 * fq);
    f32x4 sacc[16];
    const float* tb = TB + (size_t)((h * 4 + j) * 15 + (rs - r + 7)) * 512 + fr * 32 + 4 * fq;
#pragma unroll
    for (int kt = 0; kt < 16; ++kt) { const int kri = kt >> 1; const size_t ktok = (size_t)(s0 + (rs + kri) * 64 + kstart + 16 * (kt & 1) + fr);
        const bf16x8v k0 = *(const bf16x8v*)(QKV + ktok * 1536 + 512 + h * 64 + 8 * fq), k1 = *(const bf16x8v*)(QKV + ktok * 1536 + 512 + h * 64 + 32 + 8 * fq);
        f32x4 a = {0.f, 0.f, 0.f, 0.f}; a = MFMA16(k0, q0, a); a = MFMA16(k1, q1, a);
        sacc[kt] = a + *(const f32x4*)(tb + kri * 512 + 16 * (kt & 1)); }
    float mx = -INFINITY;
#pragma unroll
    for (int kt = 0; kt < 16; ++kt) mx = fmaxf(mx, fmaxf(fmaxf(sacc[kt][0], sacc[kt][1]), fmaxf(sacc[kt][2], sacc[kt][3])));
    mx = fmaxf(mx, __shfl_xor(mx, 16)); mx = fmaxf(mx, __shfl_xor(mx, 32));
    float l = 0.f;
#pragma unroll
    for (int kt = 0; kt < 16; ++kt) {
#pragma unroll
        for (int i = 0; i < 4; ++i) { const float pz = __builtin_amdgcn_exp2f(sacc[kt][i] - mx); sacc[kt][i] = pz; l += pz; } }
    l += __shfl_xor(l, 16); l += __shfl_xor(l, 32);
    f32x4 o[4];
#pragma unroll
    for (int dt = 0; dt < 4; ++dt) o[dt] = (f32x4){0.f, 0.f, 0.f, 0.f};
    const LAS unsigned char* vb = lds + hh * VHEAD + (kstart + 4 * fq + ((lane & 15) >> 2)) * VPITCH + 8 * (lane & 3);
#pragma unroll
    for (int ks = 0; ks < 8; ++ks) {
        u32x4 pw; pw.x = pkbf(sacc[2 * ks][0], sacc[2 * ks][1]); pw.y = pkbf(sacc[2 * ks][2], sacc[2 * ks][3]); pw.z = pkbf(sacc[2 * ks + 1][0], sacc[2 * ks + 1][1]); pw.w = pkbf(sacc[2 * ks + 1][2], sacc[2 * ks + 1][3]);
        const bf16x8v pf = __builtin_bit_cast(bf16x8v, pw);
#pragma unroll
        for (int dt = 0; dt < 4; ++dt) {
            const s16x4v lo = __builtin_amdgcn_ds_read_tr16_b64_v4i16((LAS s16x4v*)(vb + ks * 64 * VPITCH + 32 * dt));
            const s16x4v hi = __builtin_amdgcn_ds_read_tr16_b64_v4i16((LAS s16x4v*)(vb + (ks * 64 + 16) * VPITCH + 32 * dt));
            const bf16x8v vf = __builtin_shufflevector(lo, hi, 0, 1, 2, 3, 4, 5, 6, 7);
            o[dt] = MFMA16(vf, pf, o[dt]); } }
    const float inv = 1.f / l; float ssq = 0.f;
#pragma unroll
    for (int dt = 0; dt < 4; ++dt) { o[dt] = o[dt] * inv; ssq += (o[dt][0] * o[dt][0] + o[dt][1] * o[dt][1]) + (o[dt][2] * o[dt][2] + o[dt][3] * o[dt][3]); }
    ssq += __shfl_xor(ssq, 16); ssq += __shfl_xor(ssq, 32);
    if (fq == 0) atomicAdd(SSQA + qtok, ssq);
#pragma unroll
    for (int dt = 0; dt < 4; ++dt) { const f32x4 gv = *(const f32x4*)(gattn + h * 64 + 16 * dt + 4 * fq); const f32x4 ov = o[dt] * gv;
        u32x2 w; w.x = pkbf(ov[0], ov[1]); w.y = pkbf(ov[2], ov[3]); *(u32x2*)(MIX + (size_t)qtok * 1024 + h * 64 + 16 * dt + 4 * fq) = w; }
}

typedef float f32x16 __attribute__((ext_vector_type(16)));
#define MFMA32(a, b, c) __builtin_amdgcn_mfma_f32_32x32x16_bf16((a), (b), (c), 0, 0, 0)
constexpr float LOG2E = 1.4426950408889634f;
constexpr int TPITCH = 272;
__device__ __forceinline__ void conv_item(int it, const bf16* RAW, const float* DTraw, const float* cw, const float* cb, const float* dt_bias, const float* a_log,
                                          bf16* XT, bf16* BT, bf16* BTOK, bf16* CTOK, float* CUM, float* DTA, float* WST, LAS unsigned char* lds, int tid, int wave, int lane) {
    const int ck = it >> 3, sl = it & 7, m0 = ck * 128; int s0, T; seq_of_row(m0, s0, T); const int tl0 = m0 - s0;
    const int cg = tid & 15, tg = tid >> 4, c0 = 128 * sl + 8 * cg;
    float x[8][8];
#pragma unroll
    for (int i = 0; i < 8; ++i) { const int tt = tl0 + 4 * tg - 2 + i; u32x4 v = {0u, 0u, 0u, 0u};
        if (tt >= 0 && tt < T) v = *(const u32x4*)(RAW + (size_t)(s0 + tt) * 1024 + c0);
        x[i][0] = bf_lo(v.x); x[i][1] = bf_hi(v.x); x[i][2] = bf_lo(v.y); x[i][3] = bf_hi(v.y); x[i][4] = bf_lo(v.z); x[i][5] = bf_hi(v.z); x[i][6] = bf_lo(v.w); x[i][7] = bf_hi(v.w); }
    float o[4][8];
    { const f32x4 b0 = *(const f32x4*)(cb + c0), b1 = *(const f32x4*)(cb + c0 + 4);
#pragma unroll
      for (int tk = 0; tk < 4; ++tk) { o[tk][0] = b0[0]; o[tk][1] = b0[1]; o[tk][2] = b0[2]; o[tk][3] = b0[3]; o[tk][4] = b1[0]; o[tk][5] = b1[1]; o[tk][6] = b1[2]; o[tk][7] = b1[3]; }
#pragma unroll
      for (int j = 0; j < 5; ++j) { const f32x4 w0 = *(const f32x4*)(cw + j * 1024 + c0), w1 = *(const f32x4*)(cw + j * 1024 + c0 + 4);
#pragma unroll
          for (int tk = 0; tk < 4; ++tk) { o[tk][0] += x[tk + j][0] * w0[0]; o[tk][1] += x[tk + j][1] * w0[1]; o[tk][2] += x[tk + j][2] * w0[2]; o[tk][3] += x[tk + j][3] * w0[3];
              o[tk][4] += x[tk + j][4] * w1[0]; o[tk][5] += x[tk + j][5] * w1[1]; o[tk][6] += x[tk + j][6] * w1[2]; o[tk][7] += x[tk + j][7] * w1[3]; } }
#pragma unroll
      for (int tk = 0; tk < 4; ++tk)
#pragma unroll
          for (int e = 0; e < 8; ++e) o[tk][e] = silu_f(o[tk][e]); }
    __syncthreads();
    if (sl >= 4) { bf16* dst = (sl < 6 ? BTOK : CTOK) + (size_t)(m0 + 4 * tg) * 256 + 128 * (sl & 1) + 8 * cg;
#pragma unroll
        for (int tk = 0; tk < 4; ++tk) { u32x4 w; w.x = pkbf(o[tk][0], o[tk][1]); w.y = pkbf(o[tk][2], o[tk][3]); w.z = pkbf(o[tk][4], o[tk][5]); w.w = pkbf(o[tk][6], o[tk][7]); *(u32x4*)(dst + (size_t)tk * 256) = w; } }
    if (sl < 6) {
#pragma unroll
        for (int e = 0; e < 8; ++e) { u32x2 w; w.x = pkbf(o[0][e], o[1][e]); w.y = pkbf(o[2][e], o[3][e]); *(LAS u32x2*)(lds + (8 * cg + e) * TPITCH + 8 * tg) = w; }
        __syncthreads();
        bf16* dbase = sl < 4 ? XT + ((size_t)ck * 16 + 4 * sl) * 4096 : BT + ((size_t)ck * 8 + 4 * (sl - 4)) * 4096;
#pragma unroll
        for (int i = 0; i < 4; ++i) { const int r_ = tid & 31, pc = (tid >> 5) & 15;
            *(u32x4*)(dbase + (size_t)i * 4096 + (pc * 32 + r_) * 8) = *(const LAS u32x4*)(lds + (32 * i + r_) * TPITCH + 16 * pc); }
    }
    if (sl == 0) {
#pragma unroll
        for (int q = 0; q < 2; ++q) { const int sr = 2 * wave + q, dir = sr >> 3;
            const float a = -expf(a_log[sr]) * LOG2E, bias = dt_bias[sr];
            const float dt0 = softplus_f(DTraw[(size_t)(m0 + 2 * lane) * 16 + sr] + bias), dt1 = softplus_f(DTraw[(size_t)(m0 + 2 * lane + 1) * 16 + sr] + bias);
            const float v0 = dt0 * a, v1 = dt1 * a; float inc = v0 + v1;
#pragma unroll
            for (int ofs = 1; ofs < 64; ofs <<= 1) { const float t = __shfl_up(inc, ofs); if (lane >= ofs) inc += t; }
            const float excl = inc - (v0 + v1), total = __shfl(inc, 63);
            float c0_, c1_;
            if (dir == 0) { c0_ = excl + v0; c1_ = inc; } else { c0_ = total - excl; c1_ = total - excl - v0; }
            const float tot = total;
            const size_t off = ((size_t)ck * 16 + sr) * 128 + 2 * lane;
            *(pg8::f32x2e*)(CUM + off) = (pg8::f32x2e){c0_, c1_}; *(pg8::f32x2e*)(DTA + off) = (pg8::f32x2e){dt0, dt1};
            ((unsigned*)WST)[off >> 1] = pkbf(__builtin_amdgcn_exp2f(tot - c0_) * dt0, __builtin_amdgcn_exp2f(tot - c1_) * dt1); }
    }
}
struct S12Ops { bf16x8v bf[8]; u32x4 xr[8]; u32x4 w[8]; };
__device__ __forceinline__ void s12_load(S12Ops& o, int ck, int g, int h, int sr, int pt, int nt, int r, int hh, const bf16* XT, const bf16* BT, const bf16* WSTb) {
    const bf16* bp = BT + ((size_t)ck * 8 + 4 * g + nt) * 4096 + (hh * 32 + r) * 8;
    const bf16* xp = XT + ((size_t)ck * 16 + 2 * h + pt) * 4096 + (hh * 32 + r) * 8;
    const bf16* wp = WSTb + ((size_t)ck * 16 + sr) * 128 + 8 * hh;
#pragma unroll
    for (int kk = 0; kk < 8; ++kk) { o.bf[kk] = *(const bf16x8v*)(bp + kk * 512); o.xr[kk] = *(const u32x4*)(xp + kk * 512); o.w[kk] = *(const u32x4*)(wp + 16 * kk); }
}
__device__ __forceinline__ void s12_unit(int u, const bf16* XT, const bf16* BT, const float* CUM, const bf16* WSTb, bf16* PREV, int wave, int lane) {
    int b, h, dir, c0, nc;
    if (u < 64) { b = u >> 4; h = (u & 15) >> 1; dir = u & 1; c0 = 512 + b * 32; nc = 32; } else { const int v = u - 64; b = v >> 4; h = (v & 15) >> 1; dir = v & 1; c0 = b * 16; nc = 16; }
    const int g = h >> 2, sr = dir * 8 + h, pt = wave >> 2, nt = wave & 3, r = lane & 31, hh = lane >> 5;
    f32x16 prev;
#pragma unroll
    for (int i = 0; i < 16; ++i) prev[i] = 0.f;
    S12Ops cur; s12_load(cur, dir == 0 ? c0 : c0 + nc - 1, g, h, sr, pt, nt, r, hh, XT, BT, WSTb);
    for (int ci = 0; ci < nc; ++ci) { const int ck = dir == 0 ? c0 + ci : c0 + nc - 1 - ci;
        S12Ops nxt; { const int cin = ci + 1 < nc ? ci + 1 : ci; s12_load(nxt, dir == 0 ? c0 + cin : c0 + nc - 1 - cin, g, h, sr, pt, nt, r, hh, XT, BT, WSTb); }
        const float cd = __builtin_amdgcn_exp2f(CUM[((size_t)ck * 16 + sr) * 128 + (dir == 0 ? 127 : 0)]);
        bf16* pp = PREV + (((size_t)ck * 8 + h) * 2 + dir) * 8192 + pt * 4096 + r * 8 + 4 * hh;
#pragma unroll
        for (int q = 0; q < 4; ++q) { u32x2 w; w.x = pkbf(prev[4 * q], prev[4 * q + 1]); w.y = pkbf(prev[4 * q + 2], prev[4 * q + 3]);
            *(u32x2*)(pp + ((2 * nt + (q >> 1)) * 2 + (q & 1)) * 256) = w; }
        f32x16 st;
#pragma unroll
        for (int i = 0; i < 16; ++i) st[i] = 0.f;
#pragma unroll
        for (int kk = 0; kk < 8; ++kk) { const u32x4 xr = cur.xr[kk], wv = cur.w[kk];
            u32x4 xw; xw.x = pkbf(bf_lo(xr.x) * bf_lo(wv.x), bf_hi(xr.x) * bf_hi(wv.x)); xw.y = pkbf(bf_lo(xr.y) * bf_lo(wv.y), bf_hi(xr.y) * bf_hi(wv.y));
            xw.z = pkbf(bf_lo(xr.z) * bf_lo(wv.z), bf_hi(xr.z) * bf_hi(wv.z)); xw.w = pkbf(bf_lo(xr.w) * bf_lo(wv.w), bf_hi(xr.w) * bf_hi(wv.w));
            st = MFMA32(cur.bf[kk], __builtin_bit_cast(bf16x8v, xw), st); }
        prev = prev * cd + st;
        cur = nxt;
    }
}
constexpr int S3_BM = 0, S3_CM = 34816, S3_XT = 69632, S3_CUM = 139264, S3_DT = 143360;
__device__ __forceinline__ void s3_unit(int u, const bf16* XT, const bf16* BTOK, const bf16* CTOK, const float* CUM, const float* DTA, const bf16* PREV, const bf16* Zb, const float* d_skip, const float* gssm,
                                        bf16* MIX, float* SSQS, LAS unsigned char* lds, int tid, int wave, int lane_) {
    int lane = lane_; asm volatile("" : "+v"(lane));
    const int ck = u >> 1, g = u & 1, m0 = ck * 128;
    __syncthreads();
    { asm volatile("" : "+v"(tid));
      u32x4 vb[4], vc[4], vx[8];
#pragma unroll
      for (int i = 0; i < 4; ++i) { const int id = i * 512 + tid, row = id >> 4, pc = id & 15; vb[i] = *(const u32x4*)(BTOK + (size_t)(m0 + row) * 256 + 128 * g + 8 * pc); vc[i] = *(const u32x4*)(CTOK + (size_t)(m0 + row) * 256 + 128 * g + 8 * pc); }
#pragma unroll
      for (int i = 0; i < 8; ++i) { const int r_ = tid & 31, pc = (tid >> 5) & 15; vx[i] = *(const u32x4*)(XT + ((size_t)ck * 16 + 8 * g + i) * 4096 + (pc * 32 + r_) * 8); }
      const int a4 = tid & 255, hl_ = a4 >> 6, dr_ = (a4 >> 5) & 1, e4 = a4 & 31;
      const f32x4 vs = *(const f32x4*)((tid < 256 ? CUM : DTA) + ((size_t)ck * 16 + dr_ * 8 + 4 * g + hl_) * 128 + 4 * e4);
#pragma unroll
      for (int i = 0; i < 4; ++i) { const int id = i * 512 + tid, row = id >> 4, pc = id & 15; *(LAS u32x4*)(lds + S3_BM + row * TPITCH + 16 * pc) = vb[i]; *(LAS u32x4*)(lds + S3_CM + row * TPITCH + 16 * pc) = vc[i]; }
#pragma unroll
      for (int i = 0; i < 8; ++i) { const int r_ = tid & 31, pc = (tid >> 5) & 15; *(LAS u32x4*)(lds + S3_XT + (32 * i + r_) * TPITCH + 16 * pc) = vx[i]; }
      *(LAS f32x4*)(lds + (tid < 256 ? S3_CUM : S3_DT) + ((hl_ * 2 + dr_) * 128 + 4 * e4) * 4) = vs; }
    __syncthreads();
    const int hl = wave >> 1, half = wave & 1, h = 4 * g + hl, r = lane & 31, hh = lane >> 5;
    const float dskip = d_skip[h];
    const LAS float* cumf = (const LAS float*)(lds + S3_CUM) + (hl * 2) * 128; const LAS float* cumb = cumf + 128;
    const LAS float* dtf = (const LAS float*)(lds + S3_DT) + (hl * 2) * 128; const LAS float* dtb = dtf + 128;
    for (int lbi = 0; lbi < 2; ++lbi) { const int lb = 2 * half + lbi, l = 32 * lb + r;
        const float Af_l = cumf[l], Sb_l = cumb[l];
        bf16x8v cf[8];
#pragma unroll
        for (int kk = 0; kk < 8; ++kk) cf[kk] = *(const LAS bf16x8v*)(lds + S3_CM + l * TPITCH + 32 * kk + 16 * hh);
        f32x16 yacc[2];
#pragma unroll
        for (int pb = 0; pb < 2; ++pb)
#pragma unroll
            for (int i = 0; i < 16; ++i) yacc[pb][i] = 0.f;
#pragma unroll
        for (int sb = 0; sb < 4; ++sb) {
            f32x16 cbt;
#pragma unroll
            for (int i = 0; i < 16; ++i) cbt[i] = 0.f;
#pragma unroll
            for (int kk = 0; kk < 8; ++kk) { const bf16x8v bmf = *(const LAS bf16x8v*)(lds + S3_BM + (32 * sb + r) * TPITCH + 32 * kk + 16 * hh); cbt = MFMA32(bmf, cf[kk], cbt); }
#pragma unroll
            for (int q = 0; q < 4; ++q) { const int sbase = 32 * sb + 8 * q + 4 * hh;
                const f32x4 af = *(const LAS f32x4*)(cumf + sbase), sbv = *(const LAS f32x4*)(cumb + sbase), df = *(const LAS f32x4*)(dtf + sbase), db = *(const LAS f32x4*)(dtb + sbase);
#pragma unroll
                for (int e = 0; e < 4; ++e) { const int sidx = sbase + e;
                    const float fw = sidx <= l ? __builtin_amdgcn_exp2f(Af_l - af[e]) * df[e] : 0.f;
                    const float bw = sidx >= l ? __builtin_amdgcn_exp2f(Sb_l - sbv[e]) * db[e] : 0.f;
                    cbt[4 * q + e] = cbt[4 * q + e] * (fw + bw) + (sidx == l ? dskip : 0.f); } }
#pragma unroll
            for (int ks = 0; ks < 2; ++ks) {
                u32x4 gw_; gw_.x = pkbf(cbt[8 * ks], cbt[8 * ks + 1]); gw_.y = pkbf(cbt[8 * ks + 2], cbt[8 * ks + 3]); gw_.z = pkbf(cbt[8 * ks + 4], cbt[8 * ks + 5]); gw_.w = pkbf(cbt[8 * ks + 6], cbt[8 * ks + 7]);
                const bf16x8v gf = __builtin_bit_cast(bf16x8v, gw_);
#pragma unroll
                for (int pb = 0; pb < 2; ++pb) { const LAS unsigned char* xa = lds + S3_XT + (64 * hl + 32 * pb + r) * TPITCH + 2 * (32 * sb + 16 * ks + 4 * hh);
                    const s16x4v lo = *(const LAS s16x4v*)xa, hi = *(const LAS s16x4v*)(xa + 16);
                    yacc[pb] = MFMA32(__builtin_shufflevector(lo, hi, 0, 1, 2, 3, 4, 5, 6, 7), gf, yacc[pb]); } }
        }
#pragma unroll
        for (int dir = 0; dir < 2; ++dir) { const float el = __builtin_amdgcn_exp2f(dir == 0 ? Af_l : Sb_l);
#pragma unroll
            for (int pb = 0; pb < 2; ++pb) { f32x16 ua;
#pragma unroll
                for (int i = 0; i < 16; ++i) ua[i] = 0.f;
                const bf16* pp = PREV + (((size_t)ck * 8 + h) * 2 + dir) * 8192 + pb * 4096 + (hh * 32 + r) * 8;
#pragma unroll
                for (int kk = 0; kk < 8; ++kk) { const bf16x8v pf = *(const bf16x8v*)(pp + kk * 512); ua = MFMA32(pf, cf[kk], ua); }
                yacc[pb] = yacc[pb] + ua * el; } }
        const size_t mrow = (size_t)(m0 + l); float ssq = 0.f;
#pragma unroll
        for (int pb = 0; pb < 2; ++pb)
#pragma unroll
            for (int q = 0; q < 4; ++q) { const int pc = h * 64 + 32 * pb + 8 * q + 4 * hh; const u32x2 zv = *(const u32x2*)(Zb + mrow * 512 + pc); const f32x4 gv = *(const f32x4*)(gssm + pc);
                const float v0 = yacc[pb][4 * q] * silu_f(bf_lo(zv.x)), v1 = yacc[pb][4 * q + 1] * silu_f(bf_hi(zv.x)), v2 = yacc[pb][4 * q + 2] * silu_f(bf_lo(zv.y)), v3 = yacc[pb][4 * q + 3] * silu_f(bf_hi(zv.y));
                ssq += (v0 * v0 + v1 * v1) + (v2 * v2 + v3 * v3);
                u32x2 w; w.x = pkbf(v0 * gv[0], v1 * gv[1]); w.y = pkbf(v2 * gv[2], v3 * gv[3]); *(u32x2*)(MIX + mrow * 1024 + 512 + pc) = w; }
        ssq += __shfl_xor(ssq, 32);
        if (hh == 0) atomicAdd(SSQS + mrow, ssq);
    }
}

__device__ __forceinline__ void gate_norm_row(int m, int lane, const float* Y, const bf16* Z, const float* g, bf16* MIX) {
    const f32x4 y0 = *(const f32x4*)(Y + (size_t)m * 512 + 8 * lane), y1 = *(const f32x4*)(Y + (size_t)m * 512 + 8 * lane + 4);
    const u32x4 zv = *(const u32x4*)(Z + (size_t)m * 512 + 8 * lane);
    float v[8] = {y0[0] * silu_f(bf_lo(zv.x)), y0[1] * silu_f(bf_hi(zv.x)), y0[2] * silu_f(bf_lo(zv.y)), y0[3] * silu_f(bf_hi(zv.y)),
                  y1[0] * silu_f(bf_lo(zv.z)), y1[1] * silu_f(bf_hi(zv.z)), y1[2] * silu_f(bf_lo(zv.w)), y1[3] * silu_f(bf_hi(zv.w))};
    float ss = 0.f;
#pragma unroll
    for (int e = 0; e < 8; ++e) ss += v[e] * v[e];
    const float scl = 1.f / sqrtf(wave_sum(ss) * (1.f / 512.f) + RMS_EPS);
    const f32x4 g0 = *(const f32x4*)(g + 8 * lane), g1 = *(const f32x4*)(g + 8 * lane + 4);
    u32x4 w; w.x = pkbf(v[0] * scl * g0[0], v[1] * scl * g0[1]); w.y = pkbf(v[2] * scl * g0[2], v[3] * scl * g0[3]);
    w.z = pkbf(v[4] * scl * g1[0], v[5] * scl * g1[1]); w.w = pkbf(v[6] * scl * g1[2], v[7] * scl * g1[3]);
    *(u32x4*)(MIX + (size_t)m * 1024 + 512 + 8 * lane) = w;
}

#define FRESH_IDS() int tid = threadIdx.x; asm volatile("" : "+v"(tid)); int G = gridDim.x, bx = blockIdx.x; asm volatile("" : "+s"(G), "+s"(bx)); \
    const int lane = tid & 63, wave = __builtin_amdgcn_readfirstlane(tid >> 6), gw = bx * NWAVES + wave, NGW = G * NWAVES; (void)gw; (void)lane; (void)NGW; \
    unsigned char* ws = KWS(); float* out = KOUT(); (void)out; \
    bf16* XB = (bf16*)(ws + WS_XB); bf16* Hb = (bf16*)(ws + WS_H); bf16* QKV = (bf16*)(ws + WS_QKV); bf16* Zb = (bf16*)(ws + WS_Z); bf16* RAW = (bf16*)(ws + WS_RAW); \
    float* Yb = (float*)(ws + WS_Y); float* DTb = (float*)(ws + WS_DT); (void)XB; (void)Hb; (void)QKV; (void)Zb; (void)RAW; (void)Yb; (void)DTb
template <int l> __device__ __forceinline__ void layer_body(LAS unsigned char* lds) {
    cg::grid_group grid = cg::this_grid();
        { FRESH_IDS(); pg8::Gemm g{XB, (const bf16*)(ws + WS_W + (size_t)l * W_LAYER + OW_GU1), M, NGU, D}; pg8::StaticOrder S; S.init(M, NGU, (int)gridDim.x, (int)blockIdx.x); pg8::EpiSwiGLU E{Hb, FF};
          pg8::gemm_phase<pg8::EpiSwiGLU, pg8::StaticOrder, true, true>(lds, g, S, E); }
        grid.sync();
        { FRESH_IDS(); pg8::Gemm g{Hb, (const bf16*)(ws + WS_W + (size_t)l * W_LAYER + OW_D1), M, D, FF}; pg8::StaticOrder S; S.init(M, D, (int)gridDim.x, (int)blockIdx.x);
          pg8::EpiResidBf E{XB, 0.5f};
          pg8::gemm_phase<pg8::EpiResidBf, pg8::StaticOrder, true, true>(lds, g, S, E); }
        grid.sync();
        { FRESH_IDS(); const float* g_ = KIN(5) + l * D; const float* b_ = KIN(6) + l * D;
          for (int m = gw; m < M; m += NGW) ln_row_bf(XB + (size_t)m * D, nullptr, g_, b_, lane);
          const f32x4 z4 = {0.f, 0.f, 0.f, 0.f};
          f32x4* sz = (f32x4*)(ws + WS_SSQ); for (int i = bx * NT + tid; i < 2 * M / 4; i += G * NT) sz[i] = z4; }
        grid.sync();
        { FRESH_IDS(); pg8::Gemm g{XB, (const bf16*)(ws + WS_W + (size_t)l * W_LAYER + OW_IN), M, NIN, D}; pg8::StaticOrder S; S.init(M, NIN, (int)gridDim.x, (int)blockIdx.x); pg8::EpiProj E{QKV, Zb, RAW, DTb};
          pg8::gemm_phase<pg8::EpiProj, pg8::StaticOrder, true, true>(lds, g, S, E); }
        grid.sync();
#ifndef MIXREP
#define MIXREP 1
#endif
        for (int rep = 0; rep < MIXREP; ++rep) {
        if (rep > 0) { { FRESH_IDS(); const f32x4 z4 = {0.f, 0.f, 0.f, 0.f}; f32x4* sz = (f32x4*)(ws + WS_SSQ); for (int i = bx * NT + tid; i < 2 * M / 4; i += G * NT) sz[i] = z4; } grid.sync(); }
        { FRESH_IDS();
          for (int it = bx; it < 640 * 8; it += G)
              conv_item(it, RAW, DTb, KIN(8) + (size_t)l * 5 * 1024, KIN(9) + l * 1024, KIN(10) + l * 16, KIN(11) + l * 16, (bf16*)(ws + WS_XT), (bf16*)(ws + WS_BT), (bf16*)(ws + WS_BTOK), (bf16*)(ws + WS_CTOK),
                        (float*)(ws + WS_CUM), (float*)(ws + WS_DTA), (float*)(ws + WS_WST), lds, tid, wave, lane);
          { const int per = (5120 + G - 1) / G; const int u0 = bx * per, u1 = min(u0 + per, 5120);
            for (int u = u0; u < u1; ++u) attn_fast_unit(u, QKV, (const float*)(ws + WS_TB) + (size_t)l * 8 * 4 * 15 * 512, KIN(14) + l * 512, (bf16*)out, (float*)(ws + WS_SSQ), lds, tid, wave, lane); } }
        grid.sync();
        { FRESH_IDS();
          for (int i = 0; i < 3; ++i) { int u = bx + i * G; if (G == 256 && i == 2) u = (bx >= 64 && bx < 128) ? 512 + bx - 64 : 576; if (u >= 576) break;
              s12_unit(u, (const bf16*)(ws + WS_XT), (const bf16*)(ws + WS_BT), (const float*)(ws + WS_CUM), (const bf16*)(ws + WS_WST), (bf16*)(ws + WS_PREV), wave, lane); } }
        grid.sync();
        { FRESH_IDS();
          for (int u = bx; u < 1280; u += G)
              s3_unit(u, (const bf16*)(ws + WS_XT), (const bf16*)(ws + WS_BTOK), (const bf16*)(ws + WS_CTOK), (const float*)(ws + WS_CUM), (const float*)(ws + WS_DTA), (const bf16*)(ws + WS_PREV), Zb,
                      KIN(12) + l * 8, KIN(13) + l * 512, (bf16*)out, (float*)(ws + WS_SSQ) + M, lds, tid, wave, lane); }
        grid.sync();
        }
        { FRESH_IDS(); const float* ssq = (const float*)(ws + WS_SSQ);
          for (int m = gw; m < M; m += NGW) { const float sa = 1.f / sqrtf(ssq[m] * (1.f / 512.f) + RMS_EPS), ss = 1.f / sqrtf(ssq[M + m] * (1.f / 512.f) + RMS_EPS);
              u32x4* rowp = (u32x4*)((bf16*)out + (size_t)m * 1024) + lane;
#pragma unroll
              for (int hf = 0; hf < 2; ++hf) { const float f = hf ? ss : sa; u32x4 v = rowp[64 * hf];
                  v.x = pkbf(bf_lo(v.x) * f, bf_hi(v.x) * f); v.y = pkbf(bf_lo(v.y) * f, bf_hi(v.y) * f); v.z = pkbf(bf_lo(v.z) * f, bf_hi(v.z) * f); v.w = pkbf(bf_lo(v.w) * f, bf_hi(v.w) * f); rowp[64 * hf] = v; } } }
        grid.sync();
        { FRESH_IDS(); pg8::Gemm g{(const bf16*)out, (const bf16*)(ws + WS_W + (size_t)l * W_LAYER + OW_OUT), M, D, D}; pg8::StaticOrder S; S.init(M, D, (int)gridDim.x, (int)blockIdx.x); pg8::EpiResidBf E{XB, 1.0f};
          pg8::gemm_phase<pg8::EpiResidBf, pg8::StaticOrder, true, true>(lds, g, S, E); }
        grid.sync();
        { FRESH_IDS(); const float* g_ = KIN(17) + l * D; const float* b_ = KIN(18) + l * D;
          for (int m = gw; m < M; m += NGW) ln_row_bf(XB + (size_t)m * D, nullptr, g_, b_, lane); }
        grid.sync();
        { FRESH_IDS(); pg8::Gemm g{XB, (const bf16*)(ws + WS_W + (size_t)l * W_LAYER + OW_GU2), M, NGU, D}; pg8::StaticOrder S; S.init(M, NGU, (int)gridDim.x, (int)blockIdx.x); pg8::EpiSwiGLU E{Hb, FF};
          pg8::gemm_phase<pg8::EpiSwiGLU, pg8::StaticOrder, true, true>(lds, g, S, E); }
        grid.sync();
        { FRESH_IDS(); pg8::Gemm g{Hb, (const bf16*)(ws + WS_W + (size_t)l * W_LAYER + OW_D2), M, D, FF}; pg8::StaticOrder S; S.init(M, D, (int)gridDim.x, (int)blockIdx.x); pg8::EpiResidBf E{XB, 0.5f};
          pg8::gemm_phase<pg8::EpiResidBf, pg8::StaticOrder, true, true>(lds, g, S, E); }
        grid.sync();
        { FRESH_IDS(); const float* g_ = KIN(22) + l * D; const float* b_ = KIN(23) + l * D;
          for (int m = gw; m < M; m += NGW) ln_row_bf(XB + (size_t)m * D, l == 1 ? out + (size_t)m * D : nullptr, g_, b_, lane); }
        if (l == 0) grid.sync();
}

__global__ void __launch_bounds__(NT, 2) fwd_mega(Params P) {
    extern __shared__ __attribute__((aligned(16))) unsigned char lds_raw[];
    LAS unsigned char* lds = (LAS unsigned char*)lds_raw;
    cg::grid_group grid = cg::this_grid();
    { FRESH_IDS(); LAS float* scr = (LAS float*)(lds + wave * 16384);
      for (int it = gw; it < 2 * IT_LAYER; it += NGW) prologue_item(ws, it, scr, lane);
      { float* TBw = (float*)(ws + WS_TB);
        for (int i = bx * NT + tid; i < 2 * 8 * 4 * 15 * 512; i += G * NT) { const int kc = i & 31, q = (i >> 5) & 15; int t = i >> 9; const int ro = t % 15; t /= 15; const int j = t & 3; t >>= 2; const int h = t & 7, l = t >> 3;
            const int kstart = j == 0 ? 0 : (j == 1 ? 8 : (j == 2 ? 24 : 32)), qcol = 16 * j + q, kcol = kstart + kc, cst = min(max(qcol - 8, 0), 48);
            const bool valid = kcol >= cst && kcol < cst + 16;
            TBw[i] = valid ? 1.4426950408889634f * KIN(15)[((l * 8 + h) * 15 + ro) * 31 + (kcol - qcol + 15)] : -INFINITY; } }
      for (int m = gw; m < M; m += NGW) { const float* src = m < MPROMPT ? KIN(0) + (size_t)m * D : KIN(1) + (size_t)(m - MPROMPT) * D; row_to_bf16(src, XB + (size_t)m * D, lane); } }
    grid.sync();

    layer_body<0>(lds);
    layer_body<1>(lds);
}

extern "C" void kernel_launch(void* const* d_in, const int* in_sizes, int n_in, void* d_out, int out_size, void* d_ws, size_t ws_size, hipStream_t stream) {
    static int grid_blocks = 0;
    if (grid_blocks == 0) {
        if (n_in != 24 || out_size != M * D || ws_size < WS_END) { fprintf(stderr, "kernel_launch: unexpected shapes (n_in %d out %d ws %zu)\n", n_in, out_size, ws_size); grid_blocks = -1; return; }
        int dev = 0, cus = 0, per_cu = 0;
        (void)hipGetDevice(&dev); (void)hipDeviceGetAttribute(&cus, hipDeviceAttributeMultiprocessorCount, dev);
        if (hipFuncSetAttribute((const void*)fwd_mega, hipFuncAttributeMaxDynamicSharedMemorySize, LDS_BYTES) != hipSuccess) { fprintf(stderr, "kernel_launch: hipFuncSetAttribute failed\n"); grid_blocks = -1; return; }
        if (hipOccupancyMaxActiveBlocksPerMultiprocessor(&per_cu, (const void*)fwd_mega, NT, LDS_BYTES) != hipSuccess || per_cu < 1) { fprintf(stderr, "kernel_launch: occupancy query gave %d\n", per_cu); per_cu = 1; }
        (void)hipGetLastError();
        grid_blocks = cus * per_cu;
    }
    if (grid_blocks < 0) return;
    Params p{};
    for (int i = 0; i < 24; ++i) p.in[i] = (const float*)d_in[i];
    p.out = (float*)d_out; p.ws = (unsigned char*)d_ws;
    void* args[] = {&p};
    hipError_t e = hipLaunchCooperativeKernel((const void*)fwd_mega, dim3(grid_blocks), dim3(NT), args, LDS_BYTES, stream);
    if (e != hipSuccess) fprintf(stderr, "cooperative launch failed: %s (grid %d)\n", hipGetErrorString(e), grid_blocks);
}
```

```cpp
#include <hip/hip_runtime.h>
#include <hip/hip_cooperative_groups.h>
#include <cstdio>
#include <cstdint>
namespace cg = cooperative_groups;
namespace pg8 {
#define PG8_LAS __attribute__((address_space(3)))
typedef unsigned short bf16_t;
typedef short bf16x8 __attribute__((ext_vector_type(8)));
typedef float f32x4 __attribute__((ext_vector_type(4)));
typedef unsigned u32x4 __attribute__((ext_vector_type(4)));
constexpr int BM = 256, BK = 64, HALF = 128, HTB = HALF * BK * 2  , STAGE_BYTES = 8 * HTB, NXCD = 8, WGM = 8;

__host__ __device__ __forceinline__ int lds_byte(int r, int c) { const int st = (r >> 4) * 2 + (c >> 5), rr = r & 15, cc = c & 31, ob = rr * 64 + cc * 2; return st * 1024 + (ob ^ (((ob >> 9) & 1) << 5)); }
__host__ __device__ __forceinline__ void stage_rc(int b, int& R, int& C) { const int st = b / 1024, sb = b % 1024, swz = sb ^ (((sb >> 9) & 1) << 5); R = (st >> 1) * 16 + swz / 64; C = (st & 1) * 32 + (swz % 64) / 2; }
__host__ __device__ __forceinline__ int perm32(int rho) { const int n = rho >> 4, i = rho & 15; return 8 * (i >> 2) + 4 * n + (i & 3); }

struct Unit { int pm, pn; };
struct Gemm { const bf16_t* A; const bf16_t* Bt; int M, N, K; };

struct StaticOrder {
    int nM, nN, nwg, G, c;
    __host__ __device__ void init(int M, int N, int G_, int c_) { nM = M / BM; nN = N / BM; nwg = nM * nN; G = G_; c = c_; }
    __host__ __device__ bool next(int i, Unit& u) const {
        const long L = (long)i * G + c; if (L >= nwg) return false;
        int wgid = (int)L; { const int q = nwg / NXCD, r = nwg % NXCD, xcd = wgid % NXCD, off = wgid / NXCD; wgid = (xcd < r ? xcd * (q + 1) : r * (q + 1) + (xcd - r) * q) + off; }
        const int nig = WGM * nN, gid = wgid / nig, fm = gid * WGM, gsz = (nM - fm) < WGM ? (nM - fm) : WGM;
        u.pm = fm + ((wgid % nig) % gsz); u.pn = (wgid % nig) / gsz; return true;
    }
    __device__ __forceinline__ void a_ready(const Unit&) const {}
    __device__ __forceinline__ void done(const Unit&) const {}
};

typedef float f32x2e __attribute__((ext_vector_type(2)));
typedef __bf16 bf16x2e __attribute__((ext_vector_type(2)));
__device__ __forceinline__ unsigned pkbf(float a, float b) { f32x2e v = {a, b}; bf16x2e r = __builtin_convertvector(v, bf16x2e); return __builtin_bit_cast(unsigned, r); }
__device__ __forceinline__ float silu_f(float g) { return g * __builtin_amdgcn_rcpf(1.f + __builtin_amdgcn_exp2f(-1.4426950408889634f * g)); }
constexpr float ALPHA_F = 1.4142135623730951f;
constexpr int MPROMPT = 65536;

struct EpiSwiGLU {
    static constexpr bool PERM = true, AFTER_DRAIN = false, MID = false;
    bf16_t* H; int ldh;
    __device__ __forceinline__ void operator()(const f32x4 (&acc)[2][2][4][2], const Unit& u, int wr, int wc, int fr, int fq) const {
        const int row0 = u.pm * BM + wr * 64 + fr, col0 = u.pn * HALF + wc * 32 + 8 * fq;
#pragma unroll
        for (int ai = 0; ai < 2; ++ai)
#pragma unroll
            for (int m = 0; m < 4; ++m) {
                bf16_t* p = H + (size_t)(row0 + ai * HALF + m * 16) * ldh + col0;
                const f32x4 g0 = acc[ai][0][m][0], g1 = acc[ai][0][m][1], u0 = acc[ai][1][m][0], u1 = acc[ai][1][m][1];
                u32x4 w;
                w.x = pkbf(silu_f(g0[0]) * u0[0], silu_f(g0[1]) * u0[1]); w.y = pkbf(silu_f(g0[2]) * u0[2], silu_f(g0[3]) * u0[3]);
                w.z = pkbf(silu_f(g1[0]) * u1[0], silu_f(g1[1]) * u1[1]); w.w = pkbf(silu_f(g1[2]) * u1[2], silu_f(g1[3]) * u1[3]);
                *(u32x4*)p = w;
            }
    }
};
struct EpiResid {
    static constexpr bool PERM = false, AFTER_DRAIN = false, MID = false;
    const float* r0; const float* r1; float* out; float scale;
    __device__ __forceinline__ void operator()(const f32x4 (&acc)[2][2][4][2], const Unit& u, int wr, int wc, int fr, int fq) const {
        const float* rbase = (u.pm * BM < MPROMPT) ? r0 : r1;
#pragma unroll
        for (int ai = 0; ai < 2; ++ai)
#pragma unroll
            for (int m = 0; m < 4; ++m) {
                const size_t roff = (size_t)(u.pm * BM + ai * HALF + wr * 64 + m * 16 + fr) * 1024;
#pragma unroll
                for (int bj = 0; bj < 2; ++bj)
#pragma unroll
                    for (int n = 0; n < 2; ++n) {
                        const int c = u.pn * BM + bj * HALF + wc * 32 + n * 16 + 4 * fq;
                        const f32x4 b = *(const f32x4*)(rbase + roff + c);
                        *(f32x4*)(out + roff + c) = b * ALPHA_F + acc[ai][bj][m][n] * scale;
                    }
            }
    }
};
struct EpiResidBf {
    static constexpr bool PERM = true, AFTER_DRAIN = false, MID = false;
    bf16_t* X; float scale;
    __device__ __forceinline__ void operator()(const f32x4 (&acc)[2][2][4][2], const Unit& u, int wr, int wc, int fr, int fq) const {
        const int row0 = u.pm * BM + wr * 64 + fr, col0 = u.pn * BM + wc * 32 + 8 * fq;
#pragma unroll
        for (int ai = 0; ai < 2; ++ai)
#pragma unroll
            for (int m = 0; m < 4; ++m) { bf16_t* rowp = X + (size_t)(row0 + ai * HALF + m * 16) * 1024 + col0;
#pragma unroll
                for (int bj = 0; bj < 2; ++bj) { const u32x4 xv = *(const u32x4*)(rowp + bj * HALF); const f32x4 a0 = acc[ai][bj][m][0] * scale, a1 = acc[ai][bj][m][1] * scale;
                    u32x4 w;
                    w.x = pkbf(__uint_as_float(xv.x << 16) * ALPHA_F + a0[0], __uint_as_float(xv.x & 0xffff0000u) * ALPHA_F + a0[1]);
                    w.y = pkbf(__uint_as_float(xv.y << 16) * ALPHA_F + a0[2], __uint_as_float(xv.y & 0xffff0000u) * ALPHA_F + a0[3]);
                    w.z = pkbf(__uint_as_float(xv.z << 16) * ALPHA_F + a1[0], __uint_as_float(xv.z & 0xffff0000u) * ALPHA_F + a1[1]);
                    w.w = pkbf(__uint_as_float(xv.w << 16) * ALPHA_F + a1[2], __uint_as_float(xv.w & 0xffff0000u) * ALPHA_F + a1[3]);
                    *(u32x4*)(rowp + bj * HALF) = w; } }
    }
};
struct EpiResidMix {
    static constexpr bool PERM = false, AFTER_DRAIN = false, MID = true;
    float* out; const float* ssq;
    __device__ __forceinline__ void mid(f32x4 (&acc)[2][2][4][2], const Unit& u, int wr, int wc, int fr, int fq) const {
#pragma unroll
        for (int ai = 0; ai < 2; ++ai)
#pragma unroll
            for (int m = 0; m < 4; ++m) { const int r = u.pm * BM + ai * HALF + wr * 64 + m * 16 + fr;
                const float f = sqrtf((ssq[81920 + r] * (1.f / 512.f) + 1e-6f) / (ssq[r] * (1.f / 512.f) + 1e-6f));
#pragma unroll
                for (int bj = 0; bj < 2; ++bj)
#pragma unroll
                    for (int n = 0; n < 2; ++n) acc[ai][bj][m][n] = acc[ai][bj][m][n] * f; }
    }
    __device__ __forceinline__ void operator()(const f32x4 (&acc)[2][2][4][2], const Unit& u, int wr, int wc, int fr, int fq) const {
#pragma unroll
        for (int ai = 0; ai < 2; ++ai)
#pragma unroll
            for (int m = 0; m < 4; ++m) { const int r = u.pm * BM + ai * HALF + wr * 64 + m * 16 + fr; const size_t roff = (size_t)r * 1024;
                const float f = 1.f / sqrtf(ssq[81920 + r] * (1.f / 512.f) + 1e-6f);
#pragma unroll
                for (int bj = 0; bj < 2; ++bj)
#pragma unroll
                    for (int n = 0; n < 2; ++n) { const int c = u.pn * BM + bj * HALF + wc * 32 + n * 16 + 4 * fq;
                        const f32x4 b = *(const f32x4*)(out + roff + c);
                        *(f32x4*)(out + roff + c) = b * ALPHA_F + acc[ai][bj][m][n] * f; } }
    }
};
struct EpiProj {
    static constexpr bool PERM = true, AFTER_DRAIN = false, MID = false;
    bf16_t* QKV; bf16_t* Z; bf16_t* XBC; float* DT;
    __device__ __forceinline__ void operator()(const f32x4 (&acc)[2][2][4][2], const Unit& u, int wr, int wc, int fr, int fq) const {
        const int row0 = u.pm * BM + wr * 64 + fr, pn = u.pn;
        if (pn == 12) {
            if (wc == 0 && fq < 2) {
#pragma unroll
                for (int ai = 0; ai < 2; ++ai)
#pragma unroll
                    for (int m = 0; m < 4; ++m) { float* p = DT + (size_t)(row0 + ai * HALF + m * 16) * 16 + 8 * fq;
                        *(f32x4*)p = acc[ai][0][m][0]; *(f32x4*)(p + 4) = acc[ai][0][m][1]; }
            }
            return;
        }
        bf16_t* base; int ldc, colt; float sc = 1.f;
        if (pn < 6) { base = QKV; ldc = 1536; colt = pn * 256; if (pn < 2) sc = 0.125f * 1.4426950408889634f; }
        else if (pn < 8) { base = Z; ldc = 512; colt = (pn - 6) * 256; }
        else { base = XBC; ldc = 1024; colt = (pn - 8) * 256; }
        const int col0 = colt + wc * 32 + 8 * fq;
#pragma unroll
        for (int ai = 0; ai < 2; ++ai)
#pragma unroll
            for (int m = 0; m < 4; ++m) { bf16_t* rowp = base + (size_t)(row0 + ai * HALF + m * 16) * ldc + col0;
#pragma unroll
                for (int bj = 0; bj < 2; ++bj) { const f32x4 v0 = acc[ai][bj][m][0] * sc, v1 = acc[ai][bj][m][1] * sc;
                    u32x4 w; w.x = pkbf(v0[0], v0[1]); w.y = pkbf(v0[2], v0[3]); w.z = pkbf(v1[0], v1[1]); w.w = pkbf(v1[2], v1[3]);
                    *(u32x4*)(rowp + bj * HALF) = w; } }
    }
};

template <class Epi, class Sched, bool ALIGN_EPI = false, bool SP2 = false>
__device__ __forceinline__ void gemm_phase(PG8_LAS unsigned char* lds, const Gemm g, const Sched& S, const Epi& E) {
    int tid_ = threadIdx.x; asm volatile("" : "+v"(tid_));
    const int tid = tid_, wid = __builtin_amdgcn_readfirstlane(tid >> 6), lane = tid & 63, wr = wid >> 2, wc = wid & 3, fr = lane & 15, fq = lane >> 4;
    const int K = g.K, nt = K / BK;
    unsigned voffA[2], voffB[2];
#pragma unroll
    for (int i = 0; i < 2; ++i) { int R, C; stage_rc(tid * 16 + i * 8192, R, C); const int Rb = Epi::PERM ? ((R & ~31) + perm32(R & 31)) : R;
        voffA[i] = (unsigned)(R * K + C) * 2u; voffB[i] = (unsigned)(Rb * K + C) * 2u; }
    const size_t kstep = (size_t)(BK * 2);
    const size_t hstep = (size_t)HALF * K * 2;
    const size_t tstep = 2 * hstep;
    const unsigned ldsw = (unsigned)wid * 1024u;
    const int aoff = lds_byte(wr * 64 + fr, fq * 8), boff = lds_byte(wc * 32 + fr, fq * 8);
#define PG8_SA(b, h) (((b) * 2 + (h)) * HTB)
#define PG8_SB(b, h) ((4 + (b) * 2 + (h)) * HTB)
#define PG8_STAGE(bufoff, gbase, voff) do { _Pragma("unroll") for (int _i = 0; _i < 2; ++_i) \
        __builtin_amdgcn_global_load_lds((const unsigned*)((const char*)(gbase) + (voff)[_i]), (PG8_LAS unsigned*)(lds + (bufoff) + ldsw + _i * 8192), 16, 0, 0); } while (0)
#define PG8_LDA(dst, b, h) do { _Pragma("unroll") for (int m = 0; m < 4; ++m) _Pragma("unroll") for (int k = 0; k < 2; ++k) dst[m][k] = *(const PG8_LAS bf16x8*)(lds + PG8_SA(b, h) + aoff + m * 2048 + k * 1024); } while (0)
#define PG8_LDB(dst, b, h) do { _Pragma("unroll") for (int n = 0; n < 2; ++n) _Pragma("unroll") for (int k = 0; k < 2; ++k) dst[n][k] = *(const PG8_LAS bf16x8*)(lds + PG8_SB(b, h) + boff + n * 2048 + k * 1024); } while (0)
#define PG8_MMA(ai, bj, At, Bt) do { __builtin_amdgcn_s_setprio(1); _Pragma("unroll") for (int m = 0; m < 4; ++m) _Pragma("unroll") for (int n = 0; n < 2; ++n) _Pragma("unroll") for (int k = 0; k < 2; ++k) \
        acc[ai][bj][m][n] = __builtin_amdgcn_mfma_f32_16x16x32_bf16(Bt[n][k], At[m][k], acc[ai][bj][m][n], 0, 0, 0); __builtin_amdgcn_s_setprio(0); } while (0)
#define PG8_WAIT_V(n) asm volatile("s_waitcnt vmcnt(" #n ")" ::: "memory")
#define PG8_WAIT_L(n) asm volatile("s_waitcnt lgkmcnt(" #n ")" ::: "memory")
#define PG8_BAR __builtin_amdgcn_s_barrier()
#define PG8_SCHED __builtin_amdgcn_sched_barrier(0)
    Unit cur, nxt; int ui = 0;
    if (!S.next(0, cur)) return;
    f32x4 acc[2][2][4][2];
#pragma unroll
    for (int a = 0; a < 2; ++a)
#pragma unroll
        for (int b = 0; b < 2; ++b)
#pragma unroll
            for (int m = 0; m < 4; ++m)
#pragma unroll
                for (int n = 0; n < 2; ++n) acc[a][b][m][n] = (f32x4){0.f, 0.f, 0.f, 0.f};
    bf16x8 At[4][2], B0[2][2], B1[2][2];
    const char* cA = (const char*)g.A + (size_t)cur.pm * tstep; const char* cB = (const char*)g.Bt + (size_t)cur.pn * tstep;
    S.a_ready(cur);
    if constexpr (SP2) {
        PG8_STAGE(PG8_SB(0, 0), cB, voffB); PG8_STAGE(PG8_SB(0, 1), cB + hstep, voffB); PG8_STAGE(PG8_SA(0, 0), cA, voffA); PG8_STAGE(PG8_SA(0, 1), cA + hstep, voffA);
        if (wr == 1) PG8_BAR;
        PG8_WAIT_V(2); PG8_BAR;
        PG8_STAGE(PG8_SB(1, 0), cB + kstep, voffB); PG8_STAGE(PG8_SA(1, 0), cA + kstep, voffA); PG8_STAGE(PG8_SB(1, 1), cB + hstep + kstep, voffB);
        PG8_WAIT_V(6); PG8_BAR;
    } else {
        PG8_STAGE(PG8_SB(0, 0), cB, voffB); PG8_STAGE(PG8_SA(0, 0), cA, voffA); PG8_STAGE(PG8_SB(0, 1), cB + hstep, voffB); PG8_STAGE(PG8_SA(0, 1), cA + hstep, voffA);
        if (wr == 1) PG8_BAR;
        PG8_WAIT_V(4); PG8_BAR;
        PG8_STAGE(PG8_SB(1, 0), cB + kstep, voffB); PG8_STAGE(PG8_SA(1, 0), cA + kstep, voffA); PG8_STAGE(PG8_SB(1, 1), cB + hstep + kstep, voffB);
        PG8_WAIT_V(6); PG8_BAR;
    }
    for (;;) {
        const bool has_next = S.next(ui + 1, nxt);
        const char* nA = has_next ? (const char*)g.A + (size_t)nxt.pm * tstep : cA; const char* nB = has_next ? (const char*)g.Bt + (size_t)nxt.pn * tstep : cB;
        for (int t = 0; t < nt; t += 2) {
            if constexpr (Epi::MID) { if (t == (nt >> 1)) E.mid(acc, cur, wr, wc, fr, fq); }
            const bool last = (t == nt - 2);
            const char* a1 = cA + (size_t)(t + 1) * kstep;
            const char* a2 = last ? nA : cA + (size_t)(t + 2) * kstep; const char* b2 = last ? nB : cB + (size_t)(t + 2) * kstep;
            const char* a3 = a2 + kstep; const char* b3 = b2 + kstep;
            if (last && has_next) S.a_ready(nxt);
            if constexpr (SP2) {
            PG8_LDB(B0, 0, 0); PG8_LDB(B1, 0, 1); PG8_SCHED; PG8_LDA(At, 0, 0); PG8_STAGE(PG8_SA(1, 1), a1 + hstep, voffA);
            PG8_WAIT_V(8); PG8_WAIT_L(0); PG8_BAR; PG8_MMA(0, 0, At, B0); PG8_MMA(0, 1, At, B1); PG8_BAR; PG8_SCHED;
            PG8_LDA(At, 0, 1); PG8_STAGE(PG8_SB(0, 0), b2, voffB); PG8_STAGE(PG8_SB(0, 1), b2 + hstep, voffB); PG8_STAGE(PG8_SA(0, 0), a2, voffA);
            PG8_WAIT_V(8); PG8_WAIT_L(0); PG8_BAR; PG8_MMA(1, 0, At, B0); PG8_MMA(1, 1, At, B1); PG8_BAR; PG8_SCHED;
            PG8_LDB(B0, 1, 0); PG8_LDB(B1, 1, 1); PG8_SCHED; PG8_LDA(At, 1, 0); PG8_STAGE(PG8_SA(0, 1), a2 + hstep, voffA);
            PG8_WAIT_V(8); PG8_WAIT_L(0); PG8_BAR; PG8_MMA(0, 0, At, B0); PG8_MMA(0, 1, At, B1); PG8_BAR; PG8_SCHED;
            PG8_LDA(At, 1, 1); PG8_STAGE(PG8_SB(1, 0), b3, voffB); PG8_STAGE(PG8_SB(1, 1), b3 + hstep, voffB); PG8_STAGE(PG8_SA(1, 0), a3, voffA);
            PG8_WAIT_V(8); PG8_WAIT_L(0); PG8_BAR; PG8_MMA(1, 0, At, B0); PG8_MMA(1, 1, At, B1); PG8_BAR; PG8_SCHED;
            } else {
            PG8_LDB(B0, 0, 0); PG8_SCHED; PG8_LDA(At, 0, 0); PG8_STAGE(PG8_SA(1, 1), a1 + hstep, voffA);
            PG8_WAIT_L(8); PG8_BAR; PG8_WAIT_L(0); PG8_MMA(0, 0, At, B0); PG8_BAR; PG8_SCHED;
            PG8_LDB(B1, 0, 1); PG8_STAGE(PG8_SB(0, 0), b2, voffB);
            PG8_BAR; PG8_WAIT_L(0); PG8_MMA(0, 1, At, B1); PG8_BAR;
            PG8_LDA(At, 0, 1); PG8_STAGE(PG8_SA(0, 0), a2, voffA);
            PG8_BAR; PG8_WAIT_L(0); PG8_MMA(1, 0, At, B0); PG8_BAR; PG8_SCHED;
            PG8_STAGE(PG8_SB(0, 1), b2 + hstep, voffB);
            PG8_WAIT_V(6); PG8_BAR; PG8_MMA(1, 1, At, B1); PG8_BAR;
            PG8_LDB(B0, 1, 0); PG8_SCHED; PG8_LDA(At, 1, 0); PG8_STAGE(PG8_SA(0, 1), a2 + hstep, voffA);
            PG8_WAIT_L(8); PG8_BAR; PG8_WAIT_L(0); PG8_MMA(0, 0, At, B0); PG8_BAR; PG8_SCHED;
            PG8_LDB(B1, 1, 1); PG8_STAGE(PG8_SB(1, 0), b3, voffB);
            PG8_BAR; PG8_WAIT_L(0); PG8_MMA(0, 1, At, B1); PG8_BAR;
            PG8_LDA(At, 1, 1); PG8_STAGE(PG8_SA(1, 0), a3, voffA);
            PG8_BAR; PG8_WAIT_L(0); PG8_MMA(1, 0, At, B0); PG8_BAR; PG8_SCHED;
            PG8_STAGE(PG8_SB(1, 1), b3 + hstep, voffB);
            PG8_WAIT_V(6); PG8_BAR; PG8_MMA(1, 1, At, B1); PG8_BAR;
            }
        }
        if constexpr (ALIGN_EPI) { if (wr == 0) PG8_BAR; }
        if constexpr (!Epi::AFTER_DRAIN) { E(acc, cur, wr, wc, fr, fq); S.done(cur); }
        if (!has_next) break;
#pragma unroll
        for (int a = 0; a < 2; ++a)
#pragma unroll
            for (int b = 0; b < 2; ++b)
#pragma unroll
                for (int m = 0; m < 4; ++m)
#pragma unroll
                    for (int n = 0; n < 2; ++n) acc[a][b][m][n] = (f32x4){0.f, 0.f, 0.f, 0.f};
        cur = nxt; cA = nA; cB = nB; ++ui;
        if constexpr (ALIGN_EPI) { if (wr == 1) PG8_BAR; }
    }
    PG8_WAIT_V(0);
    if constexpr (!ALIGN_EPI) { if (wr == 0) PG8_BAR; }
    PG8_BAR;
    if constexpr (Epi::AFTER_DRAIN) { E.fused(acc, cur, wr, wc, fr, fq, lds, wid, lane); S.done(cur); }
#undef PG8_SA
#undef PG8_SB
#undef PG8_STAGE
#undef PG8_LDA
#undef PG8_LDB
#undef PG8_MMA
#undef PG8_WAIT_V
#undef PG8_WAIT_L
#undef PG8_BAR
#undef PG8_SCHED
}
}

#define LAS __attribute__((address_space(3)))
typedef unsigned short bf16;
using pg8::f32x4; using pg8::u32x4; using pg8::pkbf; using pg8::silu_f; using pg8::MPROMPT;
typedef unsigned u32x2 __attribute__((ext_vector_type(2)));
constexpr int NWAVES = 8, NT = 512;
constexpr int M = 81920, D = 1024, FF = 2816, NGU = 5632, NIN = 3328, NPROJ = 3088;
constexpr float LN_EPS = 1e-5f, RMS_EPS = 1e-6f;
constexpr size_t MiB = 1u << 20;
constexpr size_t WS_W = 1 * MiB, W_LAYER = 42 * MiB;
constexpr size_t OW_GU1 = 0, OW_D1 = 11534336, OW_IN = 17301504, OW_OUT = 24117248, OW_GU2 = 26214400, OW_D2 = 37748736;
constexpr size_t WS_XB = 85 * MiB, WS_R = 245 * MiB, WS_QKV = WS_R, WS_Z = WS_R + 240 * MiB, WS_RAW = WS_R + 320 * MiB, WS_H = WS_R;
constexpr size_t WS_Y = 725 * MiB;
constexpr size_t WS_XT = 725 * MiB, WS_BT = 805 * MiB, WS_BTOK = 845 * MiB, WS_CTOK = 885 * MiB;
constexpr size_t WS_CUM = 925 * MiB, WS_DTA = 930 * MiB, WS_WST = 935 * MiB;
constexpr size_t WS_DT = 940 * MiB, WS_SSQ = 945 * MiB, WS_TB = 946 * MiB, WS_END = 948 * MiB;
constexpr size_t WS_PREV = WS_RAW;
constexpr int LDS_BYTES = 155648;

#define LDS_WAIT() asm volatile("s_waitcnt lgkmcnt(0)" ::: "memory")
__device__ __forceinline__ float bf_lo(unsigned u) { return __uint_as_float(u << 16); }
__device__ __forceinline__ float bf_hi(unsigned u) { return __uint_as_float(u & 0xffff0000u); }
__device__ __forceinline__ float bf2f(bf16 v) { return __uint_as_float(((unsigned)v) << 16); }
__device__ __forceinline__ bf16 f2bf(float f) { return (bf16)(pkbf(f, 0.f) & 0xffffu); }
__device__ __forceinline__ float wave_sum(float v) {
#pragma unroll
    for (int o = 1; o < 64; o <<= 1) v += __shfl_xor(v, o);
    return v;
}
__device__ __forceinline__ float wave_max(float v) {
#pragma unroll
    for (int o = 1; o < 64; o <<= 1) v = fmaxf(v, __shfl_xor(v, o));
    return v;
}

struct Params { const float* in[24]; float* out; unsigned char* ws; };
__device__ __forceinline__ unsigned long long karg_u64(int i) { int j = i; asm volatile("" : "+s"(j)); const __attribute__((address_space(4))) unsigned long long* ka = (const __attribute__((address_space(4))) unsigned long long*)__builtin_amdgcn_kernarg_segment_ptr(); return ka[j]; }
#define KIN(i) ((const float*)karg_u64(i))
#define KOUT() ((float*)karg_u64(24))
#define KWS() ((unsigned char*)karg_u64(25))

__device__ __forceinline__ void tr_item(const float* W, int ldw, int ncols, bf16* WT, int Kdst, int k0, int n0, int drow, LAS float* scr, int lane) {
    int n = n0 + (lane & 31); n = n < ncols ? n : ncols - 1;
#pragma unroll 8
    for (int i = 0; i < 32; ++i) { const int kk = 2 * i + (lane >> 5); scr[kk * 33 + (lane & 31)] = W[(size_t)(k0 + kk) * ldw + n]; }
    LDS_WAIT(); asm volatile("" ::: "memory");
    const int c = lane & 7;
#pragma unroll
    for (int j = 0; j < 4; ++j) { const int nn = (lane >> 3) + 8 * j; const LAS float* s = scr + (8 * c) * 33 + nn;
        u32x4 o; o.x = pkbf(s[0 * 33], s[1 * 33]); o.y = pkbf(s[2 * 33], s[3 * 33]); o.z = pkbf(s[4 * 33], s[5 * 33]); o.w = pkbf(s[6 * 33], s[7 * 33]);
        *(u32x4*)(WT + (size_t)(drow + nn) * Kdst + k0 + 8 * c) = o; }
    LDS_WAIT(); asm volatile("" ::: "memory");
}
constexpr int IT_GU = 16 * 88, IT_D = 44 * 32, IT_IN = 16 * 97, IT_OUT = 16 * 32, IT_LAYER = 6 * IT_GU + IT_IN + IT_OUT;
__device__ __forceinline__ void prologue_item(unsigned char* wsb, int it, LAS float* scr, int lane) {
    const int l = it / IT_LAYER; int r = it % IT_LAYER;
    unsigned char* wl = wsb + WS_W + (size_t)l * W_LAYER;
    if (r < 2 * IT_GU) { const int up = r >= IT_GU; r -= up * IT_GU; const int kb = r / 88, nb = r % 88, n0 = 32 * nb;
        tr_item(KIN(up ? 3 : 2) + (size_t)l * D * FF, FF, FF, (bf16*)(wl + OW_GU1), D, 64 * kb, n0, 256 * (n0 >> 7) + (n0 & 127) + 128 * up, scr, lane); return; }
    r -= 2 * IT_GU;
    if (r < IT_D) { const int kb = r / 32, nb = r % 32; tr_item(KIN(4) + (size_t)l * FF * D, D, D, (bf16*)(wl + OW_D1), FF, 64 * kb, 32 * nb, 32 * nb, scr, lane); return; }
    r -= IT_D;
    if (r < IT_IN) { const int kb = r / 97, nb = r % 97; tr_item(KIN(7) + (size_t)l * D * NPROJ, NPROJ, NPROJ, (bf16*)(wl + OW_IN), D, 64 * kb, 32 * nb, 32 * nb, scr, lane); return; }
    r -= IT_IN;
    if (r < IT_OUT) { const int kb = r / 32, nb = r % 32; tr_item(KIN(16) + (size_t)l * D * D, D, D, (bf16*)(wl + OW_OUT), D, 64 * kb, 32 * nb, 32 * nb, scr, lane); return; }
    r -= IT_OUT;
    if (r < 2 * IT_GU) { const int up = r >= IT_GU; r -= up * IT_GU; const int kb = r / 88, nb = r % 88, n0 = 32 * nb;
        tr_item(KIN(up ? 20 : 19) + (size_t)l * D * FF, FF, FF, (bf16*)(wl + OW_GU2), D, 64 * kb, n0, 256 * (n0 >> 7) + (n0 & 127) + 128 * up, scr, lane); return; }
    r -= 2 * IT_GU;
    { const int kb = r / 32, nb = r % 32; tr_item(KIN(21) + (size_t)l * FF * D, D, D, (bf16*)(wl + OW_D2), FF, 64 * kb, 32 * nb, 32 * nb, scr, lane); }
}
__device__ __forceinline__ void row_to_bf16(const float* xrow, bf16* orow, int lane) {
    const f32x4* xr = (const f32x4*)xrow + lane; u32x2* o8 = (u32x2*)orow + lane;
#pragma unroll
    for (int j = 0; j < 4; ++j) { const f32x4 v = xr[64 * j]; u32x2 w; w.x = pkbf(v[0], v[1]); w.y = pkbf(v[2], v[3]); o8[64 * j] = w; }
}
__device__ __forceinline__ void ln_row(float* xrow, bf16* orow, const float* g, const float* b, int lane) {
    f32x4* xr = (f32x4*)xrow + lane; f32x4 v[4]; float s = 0.f;
#pragma unroll
    for (int j = 0; j < 4; ++j) { v[j] = xr[64 * j]; s += (v[j][0] + v[j][1]) + (v[j][2] + v[j][3]); }
    const float mean = wave_sum(s) * (1.f / D); float s2 = 0.f;
#pragma unroll
    for (int j = 0; j < 4; ++j) { v[j] = v[j] - mean; s2 += (v[j][0] * v[j][0] + v[j][1] * v[j][1]) + (v[j][2] * v[j][2] + v[j][3] * v[j][3]); }
    const float rstd = 1.f / sqrtf(wave_sum(s2) * (1.f / D) + LN_EPS);
    u32x2* o8 = (u32x2*)orow + lane;
#pragma unroll
    for (int j = 0; j < 4; ++j) { const f32x4 gv = ((const f32x4*)g)[lane + 64 * j], bv = ((const f32x4*)b)[lane + 64 * j];
        const f32x4 o = v[j] * rstd * gv + bv; xr[64 * j] = o; u32x2 w; w.x = pkbf(o[0], o[1]); w.y = pkbf(o[2], o[3]); o8[64 * j] = w; }
}

__device__ __forceinline__ void ln_row_bf(bf16* xrow, float* fout, const float* g, const float* b, int lane) {
    u32x4* xr = (u32x4*)xrow + lane; float v[16]; float s = 0.f;
#pragma unroll
    for (int j = 0; j < 2; ++j) { const u32x4 t = xr[64 * j]; v[8 * j] = bf_lo(t.x); v[8 * j + 1] = bf_hi(t.x); v[8 * j + 2] = bf_lo(t.y); v[8 * j + 3] = bf_hi(t.y); v[8 * j + 4] = bf_lo(t.z); v[8 * j + 5] = bf_hi(t.z); v[8 * j + 6] = bf_lo(t.w); v[8 * j + 7] = bf_hi(t.w); }
#pragma unroll
    for (int e = 0; e < 16; ++e) s += v[e];
    const float mean = wave_sum(s) * (1.f / D); float s2 = 0.f;
#pragma unroll
    for (int e = 0; e < 16; ++e) { v[e] -= mean; s2 += v[e] * v[e]; }
    const float rstd = 1.f / sqrtf(wave_sum(s2) * (1.f / D) + LN_EPS);
#pragma unroll
    for (int j = 0; j < 2; ++j) { const int c = 512 * j + 8 * lane; const f32x4 g0 = *(const f32x4*)(g + c), g1 = *(const f32x4*)(g + c + 4), b0 = *(const f32x4*)(b + c), b1 = *(const f32x4*)(b + c + 4);
        const f32x4 o0 = {v[8 * j] * rstd * g0[0] + b0[0], v[8 * j + 1] * rstd * g0[1] + b0[1], v[8 * j + 2] * rstd * g0[2] + b0[2], v[8 * j + 3] * rstd * g0[3] + b0[3]};
        const f32x4 o1 = {v[8 * j + 4] * rstd * g1[0] + b1[0], v[8 * j + 5] * rstd * g1[1] + b1[1], v[8 * j + 6] * rstd * g1[2] + b1[2], v[8 * j + 7] * rstd * g1[3] + b1[3]};
        if (fout) { *(f32x4*)(fout + c) = o0; *(f32x4*)(fout + c + 4) = o1; }
        else { u32x4 w; w.x = pkbf(o0[0], o0[1]); w.y = pkbf(o0[2], o0[3]); w.z = pkbf(o1[0], o1[1]); w.w = pkbf(o1[2], o1[3]); xr[64 * j] = w; } }
}

__device__ __forceinline__ void seq_of_row(int m, int& s0, int& T) { if (m < MPROMPT) { s0 = m & ~2047; T = 2048; } else { s0 = MPROMPT + ((m - MPROMPT) & ~4095); T = 4096; } }
__device__ __forceinline__ void conv8(const bf16* raw, int m, int tl, int T, int c0, const float* cw, const float* cb, float (&o)[8]) {
    const f32x4 b0 = *(const f32x4*)(cb + c0), b1 = *(const f32x4*)(cb + c0 + 4);
    float a[8] = {b0[0], b0[1], b0[2], b0[3], b1[0], b1[1], b1[2], b1[3]};
#pragma unroll
    for (int j = 0; j < 5; ++j) { const int tt = tl + j - 2;
        if (tt >= 0 && tt < T) { const u32x4 v = *(const u32x4*)(raw + (size_t)(m + j - 2) * 1024 + c0);
            const f32x4 w0 = *(const f32x4*)(cw + j * 1024 + c0), w1 = *(const f32x4*)(cw + j * 1024 + c0 + 4);
            a[0] += bf_lo(v.x) * w0[0]; a[1] += bf_hi(v.x) * w0[1]; a[2] += bf_lo(v.y) * w0[2]; a[3] += bf_hi(v.y) * w0[3];
            a[4] += bf_lo(v.z) * w1[0]; a[5] += bf_hi(v.z) * w1[1]; a[6] += bf_lo(v.w) * w1[2]; a[7] += bf_hi(v.w) * w1[3]; } }
#pragma unroll
    for (int e = 0; e < 8; ++e) o[e] = silu_f(a[e]);
}
__device__ __forceinline__ float softplus_f(float x) { return x > 20.f ? x : log1pf(expf(x)); }

constexpr int SCAN_DIR_F = 10368;
__device__ __forceinline__ void scan_naive_unit(int b, int h, const bf16* raw, const float* DT, float* Y, const float* cw, const float* cb, const float* dt_bias, const float* a_log, const float* d_skip, LAS float* L, int tid, int wave, int lane) {
    int s0, T; if (b < 32) { s0 = b * 2048; T = 2048; } else { s0 = MPROMPT + (b - 32) * 4096; T = 4096; }
    const int g = h >> 2, dir = wave >> 2, pb = wave & 3, p = pb * 16 + (lane & 15), nq = lane >> 4;
    const float a = -expf(a_log[dir * 8 + h]), dskip = d_skip[h], dtb = dt_bias[dir * 8 + h];
    float s[32];
#pragma unroll
    for (int k = 0; k < 32; ++k) s[k] = 0.f;
    LAS float* Lw = L + dir * SCAN_DIR_F;
    const int nblk = T >> 5;
    for (int blk = 0; blk < nblk; ++blk) {
        __syncthreads();
        const int tbase = dir == 0 ? 32 * blk : T - 32 * (blk + 1);
        { const int r_ = tid & 255, tok = r_ >> 3, part = r_ & 7, tl = tbase + tok, m = s0 + tl; float o[8];
          conv8(raw, m, tl, T, 512 + 128 * g + 16 * part, cw, cb, o);
#pragma unroll
          for (int e = 0; e < 8; ++e) Lw[tok * 128 + 16 * part + e] = o[e];
          conv8(raw, m, tl, T, 512 + 128 * g + 16 * part + 8, cw, cb, o);
#pragma unroll
          for (int e = 0; e < 8; ++e) Lw[tok * 128 + 16 * part + 8 + e] = o[e];
          conv8(raw, m, tl, T, 768 + 128 * g + 16 * part, cw, cb, o);
#pragma unroll
          for (int e = 0; e < 8; ++e) Lw[4096 + tok * 128 + 16 * part + e] = o[e];
          conv8(raw, m, tl, T, 768 + 128 * g + 16 * part + 8, cw, cb, o);
#pragma unroll
          for (int e = 0; e < 8; ++e) Lw[4096 + tok * 128 + 16 * part + 8 + e] = o[e];
          conv8(raw, m, tl, T, h * 64 + 8 * part, cw, cb, o);
#pragma unroll
          for (int e = 0; e < 8; ++e) Lw[8192 + tok * 64 + 8 * part + e] = o[e];
          if (part == 0) { const float dtv = softplus_f(DT[(size_t)m * 16 + dir * 8 + h] + dtb); Lw[10240 + tok] = dtv; Lw[10272 + tok] = expf(dtv * a); }
        }
        __syncthreads();
        for (int i = 0; i < 32; ++i) {
            const int ti = dir == 0 ? i : 31 - i;
            const float d = Lw[10272 + ti], dtv = Lw[10240 + ti], xv = Lw[8192 + ti * 64 + p], xdt = xv * dtv;
            float y = 0.f;
#pragma unroll
            for (int k4 = 0; k4 < 8; ++k4) { const f32x4 bv = *(const LAS f32x4*)(Lw + ti * 128 + 32 * nq + 4 * k4), cv = *(const LAS f32x4*)(Lw + 4096 + ti * 128 + 32 * nq + 4 * k4);
#pragma unroll
                for (int e = 0; e < 4; ++e) { s[4 * k4 + e] = s[4 * k4 + e] * d + xdt * bv[e]; y += s[4 * k4 + e] * cv[e]; } }
            y += __shfl_xor(y, 16); y += __shfl_xor(y, 32);
            if (nq == 0) atomicAdd(Y + (size_t)(s0 + tbase + ti) * 512 + h * 64 + p, y + (dir == 0 ? dskip * xv : 0.f));
        }
    }
}

__device__ __forceinline__ void attn_naive_unit(int m, int wave, int lane, const bf16* QKV, const float* rpb, const float* gattn, bf16* MIX, LAS float* Ps, volatile LAS float* exch, int parity) {
    const int h = wave; int s0, T; seq_of_row(m, s0, T);
    const int tl = m - s0, r = tl >> 6, qc = tl & 63, rows = T >> 6;
    const int cstart = min(max(qc - 8, 0), 48), rs = min(max(r - 4, 0), rows - 8);
    float q[64];
    { const bf16* qp = QKV + (size_t)m * 1536 + h * 64;
#pragma unroll
      for (int i = 0; i < 8; ++i) { const u32x4 v = *(const u32x4*)(qp + 8 * i); q[8 * i] = bf_lo(v.x); q[8 * i + 1] = bf_hi(v.x); q[8 * i + 2] = bf_lo(v.y); q[8 * i + 3] = bf_hi(v.y);
          q[8 * i + 4] = bf_lo(v.z); q[8 * i + 5] = bf_hi(v.z); q[8 * i + 6] = bf_lo(v.w); q[8 * i + 7] = bf_hi(v.w); } }
    float sc[2];
#pragma unroll
    for (int k2 = 0; k2 < 2; ++k2) { const int kk = lane + 64 * k2, kri = kk >> 4, kci = kk & 15; const int kt = s0 + (rs + kri) * 64 + cstart + kci;
        const bf16* kp = QKV + (size_t)kt * 1536 + 512 + h * 64; float d = 0.f;
#pragma unroll
        for (int i = 0; i < 8; ++i) { const u32x4 v = *(const u32x4*)(kp + 8 * i);
            d += q[8 * i] * bf_lo(v.x) + q[8 * i + 1] * bf_hi(v.x) + q[8 * i + 2] * bf_lo(v.y) + q[8 * i + 3] * bf_hi(v.y) + q[8 * i + 4] * bf_lo(v.z) + q[8 * i + 5] * bf_hi(v.z) + q[8 * i + 6] * bf_lo(v.w) + q[8 * i + 7] * bf_hi(v.w); }
        sc[k2] = d + rpb[h * 465 + (rs + kri - r + 7) * 31 + (cstart + kci - qc + 15)]; }
    const float mx = wave_max(fmaxf(sc[0], sc[1]));
    const float p0 = __expf(sc[0] - mx), p1 = __expf(sc[1] - mx);
    const float inv = 1.f / wave_sum(p0 + p1);
    Ps[lane] = p0 * inv; Ps[lane + 64] = p1 * inv;
    LDS_WAIT(); asm volatile("" ::: "memory");
    float o = 0.f; const bf16* vbase = QKV + 1024 + h * 64 + lane;
#pragma unroll 4
    for (int kk = 0; kk < 128; kk += 4) { const f32x4 pv = *(const LAS f32x4*)(Ps + kk); const int kt = s0 + (rs + (kk >> 4)) * 64 + cstart + (kk & 15);
#pragma unroll
        for (int e = 0; e < 4; ++e) o += pv[e] * bf2f(vbase[(size_t)(kt + e) * 1536]); }
    const float ssq = wave_sum(o * o);
    if (lane == 0) exch[parity * 8 + h] = ssq;
    __syncthreads();
    float tot = 0.f;
#pragma unroll
    for (int i = 0; i < 8; ++i) tot += exch[parity * 8 + i];
    const float scl = 1.f / sqrtf(tot * (1.f / 512.f) + RMS_EPS);
    MIX[(size_t)m * 1024 + h * 64 + lane] = f2bf(o * scl * gattn[h * 64 + lane]);
}


typedef short bf16x8v __attribute__((ext_vector_type(8)));
typedef short s16x4v __attribute__((ext_vector_type(4)));
#define MFMA16(a, b, c) __builtin_amdgcn_mfma_f32_16x16x32_bf16((a), (b), (c), 0, 0, 0)
constexpr int VPITCH = 144, VHEAD = 512 * VPITCH;
__device__ __forceinline__ void attn_fast_unit(int u, const bf16* QKV, const float* TB  , const float* gattn, bf16* MIX, float* SSQA, LAS unsigned char* lds, int tid, int wave, int lane) {
    const int hp = u / 1280, gr = u % 1280;
    int s0, rows, r;
    if (gr < 1024) { s0 = (gr >> 5) * 2048; r = gr & 31; rows = 32; } else { const int g2 = gr - 1024; s0 = MPROMPT + (g2 >> 6) * 4096; r = g2 & 63; rows = 64; }
    const int rs = min(max(r - 4, 0), rows - 8);
    __syncthreads();
    { u32x4 v[16];
#pragma unroll
      for (int i = 0; i < 16; ++i) { const int id = i * 512 + tid, c = id & 7, key = (id >> 3) & 511, hh = id >> 12;
          v[i] = *(const u32x4*)(QKV + (size_t)(s0 + rs * 64 + key) * 1536 + 1024 + (2 * hp + hh) * 64 + 8 * c); }
#pragma unroll
      for (int i = 0; i < 16; ++i) { const int id = i * 512 + tid, c = id & 7, key = (id >> 3) & 511, hh = id >> 12;
          *(LAS u32x4*)(lds + hh * VHEAD + key * VPITCH + 16 * c) = v[i]; } }
    __syncthreads();
    const int hh = wave >> 2, j = wave & 3, h = 2 * hp + hh, fr = lane & 15, fq = lane >> 4;
    const int kstart = j == 0 ? 0 : (j == 1 ? 8 : (j == 2 ? 24 : 32));
    const int qtok = s0 + r * 64 + 16 * j + fr;
    const bf16x8v q0 = *(const bf16x8v*)(QKV + (size_t)qtok * 1536 + h * 64 + 8 * fq), q1 = *(const bf16x8v*)(QKV + (size_t)qtok * 1536 + h * 64 + 32 + 8 * fq);
    f32x4 sacc[16];
    const float* tb = TB + (size_t)((h * 4 + j) * 15 + (rs - r + 7)) * 512 + fr * 32 + 4 * fq;
#pragma unroll
    for (int kt = 0; kt < 16; ++kt) { const int kri = kt >> 1; const size_t ktok = (size_t)(s0 + (rs + kri) * 64 + kstart + 16 * (kt & 1) + fr);
        const bf16x8v k0 = *(const bf16x8v*)(QKV + ktok * 1536 + 512 + h * 64 + 8 * fq), k1 = *(const bf16x8v*)(QKV + ktok * 1536 + 512 + h * 64 + 32 + 8 * fq);
        f32x4 a = {0.f, 0.f, 0.f, 0.f}; a = MFMA16(k0, q0, a); a = MFMA16(k1, q1, a);
        sacc[kt] = a + *(const f32x4*)(tb + kri * 512 + 16 * (kt & 1)); }
    float mx = -INFINITY;
#pragma unroll
    for (int kt = 0; kt < 16; ++kt) mx = fmaxf(mx, fmaxf(fmaxf(sacc[kt][0], sacc[kt][1]), fmaxf(sacc[kt][2], sacc[kt][3])));
    mx = fmaxf(mx, __shfl_xor(mx, 16)); mx = fmaxf(mx, __shfl_xor(mx, 32));
    float l = 0.f;
#pragma unroll
    for (int kt = 0; kt < 16; ++kt) {
#pragma unroll
        for (int i = 0; i < 4; ++i) { const float pz = __builtin_amdgcn_exp2f(sacc[kt][i] - mx); sacc[kt][i] = pz; l += pz; } }
    l += __shfl_xor(l, 16); l += __shfl_xor(l, 32);
    f32x4 o[4];
#pragma unroll
    for (int dt = 0; dt < 4; ++dt) o[dt] = (f32x4){0.f, 0.f, 0.f, 0.f};
    const LAS unsigned char* vb = lds + hh * VHEAD + (kstart + 4 * fq + ((lane & 15) >> 2)) * VPITCH + 8 * (lane & 3);
#pragma unroll
    for (int ks = 0; ks < 8; ++ks) {
        u32x4 pw; pw.x = pkbf(sacc[2 * ks][0], sacc[2 * ks][1]); pw.y = pkbf(sacc[2 * ks][2], sacc[2 * ks][3]); pw.z = pkbf(sacc[2 * ks + 1][0], sacc[2 * ks + 1][1]); pw.w = pkbf(sacc[2 * ks + 1][2], sacc[2 * ks + 1][3]);
        const bf16x8v pf = __builtin_bit_cast(bf16x8v, pw);
#pragma unroll
        for (int dt = 0; dt < 4; ++dt) {
            const s16x4v lo = __builtin_amdgcn_ds_read_tr16_b64_v4i16((LAS s16x4v*)(vb + ks * 64 * VPITCH + 32 * dt));
            const s16x4v hi = __builtin_amdgcn_ds_read_tr16_b64_v4i16((LAS s16x4v*)(vb + (ks * 64 + 16) * VPITCH + 32 * dt));
            const bf16x8v vf = __builtin_shufflevector(lo, hi, 0, 1, 2, 3, 4, 5, 6, 7);
            o[dt] = MFMA16(vf, pf, o[dt]); } }
    const float inv = 1.f / l; float ssq = 0.f;
#pragma unroll
    for (int dt = 0; dt < 4; ++dt) { o[dt] = o[dt] * inv; ssq += (o[dt][0] * o[dt][0] + o[dt][1] * o[dt][1]) + (o[dt][2] * o[dt][2] + o[dt][3] * o[dt][3]); }
    ssq += __shfl_xor(ssq, 16); ssq += __shfl_xor(ssq, 32);
    if (fq == 0) atomicAdd(SSQA + qtok, ssq);
#pragma unroll
    for (int dt = 0; dt < 4; ++dt) { const f32x4 gv = *(const f32x4*)(gattn + h * 64 + 16 * dt + 4 * fq); const f32x4 ov = o[dt] * gv;
        u32x2 w; w.x = pkbf(ov[0], ov[1]); w.y = pkbf(ov[2], ov[3]); *(u32x2*)(MIX + (size_t)qtok * 1024 + h * 64 + 16 * dt + 4 * fq) = w; }
}

typedef float f32x16 __attribute__((ext_vector_type(16)));
#define MFMA32(a, b, c) __builtin_amdgcn_mfma_f32_32x32x16_bf16((a), (b), (c), 0, 0, 0)
constexpr float LOG2E = 1.4426950408889634f;
constexpr int TPITCH = 272;
__device__ __forceinline__ void conv_item(int it, const bf16* RAW, const float* DTraw, const float* cw, const float* cb, const float* dt_bias, const float* a_log,
                                          bf16* XT, bf16* BT, bf16* BTOK, bf16* CTOK, float* CUM, float* DTA, float* WST, LAS unsigned char* lds, int tid, int wave, int lane) {
    const int ck = it >> 3, sl = it & 7, m0 = ck * 128; int s0, T; seq_of_row(m0, s0, T); const int tl0 = m0 - s0;
    const int cg = tid & 15, tg = tid >> 4, c0 = 128 * sl + 8 * cg;
    float x[8][8];
#pragma unroll
    for (int i = 0; i < 8; ++i) { const int tt = tl0 + 4 * tg - 2 + i; u32x4 v = {0u, 0u, 0u, 0u};
        if (tt >= 0 && tt < T) v = *(const u32x4*)(RAW + (size_t)(s0 + tt) * 1024 + c0);
        x[i][0] = bf_lo(v.x); x[i][1] = bf_hi(v.x); x[i][2] = bf_lo(v.y); x[i][3] = bf_hi(v.y); x[i][4] = bf_lo(v.z); x[i][5] = bf_hi(v.z); x[i][6] = bf_lo(v.w); x[i][7] = bf_hi(v.w); }
    float o[4][8];
    { const f32x4 b0 = *(const f32x4*)(cb + c0), b1 = *(const f32x4*)(cb + c0 + 4);
#pragma unroll
      for (int tk = 0; tk < 4; ++tk) { o[tk][0] = b0[0]; o[tk][1] = b0[1]; o[tk][2] = b0[2]; o[tk][3] = b0[3]; o[tk][4] = b1[0]; o[tk][5] = b1[1]; o[tk][6] = b1[2]; o[tk][7] = b1[3]; }
#pragma unroll
      for (int j = 0; j < 5; ++j) { const f32x4 w0 = *(const f32x4*)(cw + j * 1024 + c0), w1 = *(const f32x4*)(cw + j * 1024 + c0 + 4);
#pragma unroll
          for (int tk = 0; tk < 4; ++tk) { o[tk][0] += x[tk + j][0] * w0[0]; o[tk][1] += x[tk + j][1] * w0[1]; o[tk][2] += x[tk + j][2] * w0[2]; o[tk][3] += x[tk + j][3] * w0[3];
              o[tk][4] += x[tk + j][4] * w1[0]; o[tk][5] += x[tk + j][5] * w1[1]; o[tk][6] += x[tk + j][6] * w1[2]; o[tk][7] += x[tk + j][7] * w1[3]; } }
#pragma unroll
      for (int tk = 0; tk < 4; ++tk)
#pragma unroll
          for (int e = 0; e < 8; ++e) o[tk][e] = silu_f(o[tk][e]); }
    __syncthreads();
    if (sl >= 4) { bf16* dst = (sl < 6 ? BTOK : CTOK) + (size_t)(m0 + 4 * tg) * 256 + 128 * (sl & 1) + 8 * cg;
#pragma unroll
        for (int tk = 0; tk < 4; ++tk) { u32x4 w; w.x = pkbf(o[tk][0], o[tk][1]); w.y = pkbf(o[tk][2], o[tk][3]); w.z = pkbf(o[tk][4], o[tk][5]); w.w = pkbf(o[tk][6], o[tk][7]); *(u32x4*)(dst + (size_t)tk * 256) = w; } }
    if (sl < 6) {
#pragma unroll
        for (int e = 0; e < 8; ++e) { u32x2 w; w.x = pkbf(o[0][e], o[1][e]); w.y = pkbf(o[2][e], o[3][e]); *(LAS u32x2*)(lds + (8 * cg + e) * TPITCH + 8 * tg) = w; }
        __syncthreads();
        bf16* dbase = sl < 4 ? XT + ((size_t)ck * 16 + 4 * sl) * 4096 : BT + ((size_t)ck * 8 + 4 * (sl - 4)) * 4096;
#pragma unroll
        for (int i = 0; i < 4; ++i) { const int r_ = tid & 31, pc = (tid >> 5) & 15;
            *(u32x4*)(dbase + (size_t)i * 4096 + (pc * 32 + r_) * 8) = *(const LAS u32x4*)(lds + (32 * i + r_) * TPITCH + 16 * pc); }
    }
    if (sl == 0) {
#pragma unroll
        for (int q = 0; q < 2; ++q) { const int sr = 2 * wave + q, dir = sr >> 3;
            const float a = -expf(a_log[sr]) * LOG2E, bias = dt_bias[sr];
            const float dt0 = softplus_f(DTraw[(size_t)(m0 + 2 * lane) * 16 + sr] + bias), dt1 = softplus_f(DTraw[(size_t)(m0 + 2 * lane + 1) * 16 + sr] + bias);
            const float v0 = dt0 * a, v1 = dt1 * a; float inc = v0 + v1;
#pragma unroll
            for (int ofs = 1; ofs < 64; ofs <<= 1) { const float t = __shfl_up(inc, ofs); if (lane >= ofs) inc += t; }
            const float excl = inc - (v0 + v1), total = __shfl(inc, 63);
            float c0_, c1_;
            if (dir == 0) { c0_ = excl + v0; c1_ = inc; } else { c0_ = total - excl; c1_ = total - excl - v0; }
            const float tot = total;
            const size_t off = ((size_t)ck * 16 + sr) * 128 + 2 * lane;
            *(pg8::f32x2e*)(CUM + off) = (pg8::f32x2e){c0_, c1_}; *(pg8::f32x2e*)(DTA + off) = (pg8::f32x2e){dt0, dt1};
            ((unsigned*)WST)[off >> 1] = pkbf(__builtin_amdgcn_exp2f(tot - c0_) * dt0, __builtin_amdgcn_exp2f(tot - c1_) * dt1); }
    }
}
struct S12Ops { bf16x8v bf[8]; u32x4 xr[8]; u32x4 w[8]; };
__device__ __forceinline__ void s12_load(S12Ops& o, int ck, int g, int h, int sr, int pt, int nt, int r, int hh, const bf16* XT, const bf16* BT, const bf16* WSTb) {
    const bf16* bp = BT + ((size_t)ck * 8 + 4 * g + nt) * 4096 + (hh * 32 + r) * 8;
    const bf16* xp = XT + ((size_t)ck * 16 + 2 * h + pt) * 4096 + (hh * 32 + r) * 8;
    const bf16* wp = WSTb + ((size_t)ck * 16 + sr) * 128 + 8 * hh;
#pragma unroll
    for (int kk = 0; kk < 8; ++kk) { o.bf[kk] = *(const bf16x8v*)(bp + kk * 512); o.xr[kk] = *(const u32x4*)(xp + kk * 512); o.w[kk] = *(const u32x4*)(wp + 16 * kk); }
}
__device__ __forceinline__ void s12_unit(int u, const bf16* XT, const bf16* BT, const float* CUM, const bf16* WSTb, bf16* PREV, int wave, int lane) {
    int b, h, dir, c0, nc;
    if (u < 64) { b = u >> 4; h = (u & 15) >> 1; dir = u & 1; c0 = 512 + b * 32; nc = 32; } else { const int v = u - 64; b = v >> 4; h = (v & 15) >> 1; dir = v & 1; c0 = b * 16; nc = 16; }
    const int g = h >> 2, sr = dir * 8 + h, pt = wave >> 2, nt = wave & 3, r = lane & 31, hh = lane >> 5;
    f32x16 prev;
#pragma unroll
    for (int i = 0; i < 16; ++i) prev[i] = 0.f;
    S12Ops cur; s12_load(cur, dir == 0 ? c0 : c0 + nc - 1, g, h, sr, pt, nt, r, hh, XT, BT, WSTb);
    for (int ci = 0; ci < nc; ++ci) { const int ck = dir == 0 ? c0 + ci : c0 + nc - 1 - ci;
        S12Ops nxt; { const int cin = ci + 1 < nc ? ci + 1 : ci; s12_load(nxt, dir == 0 ? c0 + cin : c0 + nc - 1 - cin, g, h, sr, pt, nt, r, hh, XT, BT, WSTb); }
        const float cd = __builtin_amdgcn_exp2f(CUM[((size_t)ck * 16 + sr) * 128 + (dir == 0 ? 127 : 0)]);
        bf16* pp = PREV + (((size_t)ck * 8 + h) * 2 + dir) * 8192 + pt * 4096 + r * 8 + 4 * hh;
#pragma unroll
        for (int q = 0; q < 4; ++q) { u32x2 w; w.x = pkbf(prev[4 * q], prev[4 * q + 1]); w.y = pkbf(prev[4 * q + 2], prev[4 * q + 3]);
            *(u32x2*)(pp + ((2 * nt + (q >> 1)) * 2 + (q & 1)) * 256) = w; }
        f32x16 st;
#pragma unroll
        for (int i = 0; i < 16; ++i) st[i] = 0.f;
#pragma unroll
        for (int kk = 0; kk < 8; ++kk) { const u32x4 xr = cur.xr[kk], wv = cur.w[kk];
            u32x4 xw; xw.x = pkbf(bf_lo(xr.x) * bf_lo(wv.x), bf_hi(xr.x) * bf_hi(wv.x)); xw.y = pkbf(bf_lo(xr.y) * bf_lo(wv.y), bf_hi(xr.y) * bf_hi(wv.y));
            xw.z = pkbf(bf_lo(xr.z) * bf_lo(wv.z), bf_hi(xr.z) * bf_hi(wv.z)); xw.w = pkbf(bf_lo(xr.w) * bf_lo(wv.w), bf_hi(xr.w) * bf_hi(wv.w));
            st = MFMA32(cur.bf[kk], __builtin_bit_cast(bf16x8v, xw), st); }
        prev = prev * cd + st;
        cur = nxt;
    }
}
constexpr int S3_BM = 0, S3_CM = 34816, S3_XT = 69632, S3_CUM = 139264, S3_DT = 143360;
__device__ __forceinline__ void s3_unit(int u, const bf16* XT, const bf16* BTOK, const bf16* CTOK, const float* CUM, const float* DTA, const bf16* PREV, const bf16* Zb, const float* d_skip, const float* gssm,
                                        bf16* MIX, float* SSQS, LAS unsigned char* lds, int tid, int wave, int lane_) {
    int lane = lane_; asm volatile("" : "+v"(lane));
    const int ck = u >> 1, g = u & 1, m0 = ck * 128;
    __syncthreads();
    { asm volatile("" : "+v"(tid));
      u32x4 vb[4], vc[4], vx[8];
#pragma unroll
      for (int i = 0; i < 4; ++i) { const int id = i * 512 + tid, row = id >> 4, pc = id & 15; vb[i] = *(const u32x4*)(BTOK + (size_t)(m0 + row) * 256 + 128 * g + 8 * pc); vc[i] = *(const u32x4*)(CTOK + (size_t)(m0 + row) * 256 + 128 * g + 8 * pc); }
#pragma unroll
      for (int i = 0; i < 8; ++i) { const int r_ = tid & 31, pc = (tid >> 5) & 15; vx[i] = *(const u32x4*)(XT + ((size_t)ck * 16 + 8 * g + i) * 4096 + (pc * 32 + r_) * 8); }
      const int a4 = tid & 255, hl_ = a4 >> 6, dr_ = (a4 >> 5) & 1, e4 = a4 & 31;
      const f32x4 vs = *(const f32x4*)((tid < 256 ? CUM : DTA) + ((size_t)ck * 16 + dr_ * 8 + 4 * g + hl_) * 128 + 4 * e4);
#pragma unroll
      for (int i = 0; i < 4; ++i) { const int id = i * 512 + tid, row = id >> 4, pc = id & 15; *(LAS u32x4*)(lds + S3_BM + row * TPITCH + 16 * pc) = vb[i]; *(LAS u32x4*)(lds + S3_CM + row * TPITCH + 16 * pc) = vc[i]; }
#pragma unroll
      for (int i = 0; i < 8; ++i) { const int r_ = tid & 31, pc = (tid >> 5) & 15; *(LAS u32x4*)(lds + S3_XT + (32 * i + r_) * TPITCH + 16 * pc) = vx[i]; }
      *(LAS f32x4*)(lds + (tid < 256 ? S3_CUM : S3_DT) + ((hl_ * 2 + dr_) * 128 + 4 * e4) * 4) = vs; }
    __syncthreads();
    const int hl = wave >> 1, half = wave & 1, h = 4 * g + hl, r = lane & 31, hh = lane >> 5;
    const float dskip = d_skip[h];
    const LAS float* cumf = (const LAS float*)(lds + S3_CUM) + (hl * 2) * 128; const LAS float* cumb = cumf + 128;
    const LAS float* dtf = (const LAS float*)(lds + S3_DT) + (hl * 2) * 128; const LAS float* dtb = dtf + 128;
    for (int lbi = 0; lbi < 2; ++lbi) { const int lb = 2 * half + lbi, l = 32 * lb + r;
        const float Af_l = cumf[l], Sb_l = cumb[l];
        bf16x8v cf[8];
#pragma unroll
        for (int kk = 0; kk < 8; ++kk) cf[kk] = *(const LAS bf16x8v*)(lds + S3_CM + l * TPITCH + 32 * kk + 16 * hh);
        f32x16 yacc[2];
#pragma unroll
        for (int pb = 0; pb < 2; ++pb)
#pragma unroll
            for (int i = 0; i < 16; ++i) yacc[pb][i] = 0.f;
#pragma unroll
        for (int sb = 0; sb < 4; ++sb) {
            f32x16 cbt;
#pragma unroll
            for (int i = 0; i < 16; ++i) cbt[i] = 0.f;
#pragma unroll
            for (int kk = 0; kk < 8; ++kk) { const bf16x8v bmf = *(const LAS bf16x8v*)(lds + S3_BM + (32 * sb + r) * TPITCH + 32 * kk + 16 * hh); cbt = MFMA32(bmf, cf[kk], cbt); }
#pragma unroll
            for (int q = 0; q < 4; ++q) { const int sbase = 32 * sb + 8 * q + 4 * hh;
                const f32x4 af = *(const LAS f32x4*)(cumf + sbase), sbv = *(const LAS f32x4*)(cumb + sbase), df = *(const LAS f32x4*)(dtf + sbase), db = *(const LAS f32x4*)(dtb + sbase);
#pragma unroll
                for (int e = 0; e < 4; ++e) { const int sidx = sbase + e;
                    const float fw = sidx <= l ? __builtin_amdgcn_exp2f(Af_l - af[e]) * df[e] : 0.f;
                    const float bw = sidx >= l ? __builtin_amdgcn_exp2f(Sb_l - sbv[e]) * db[e] : 0.f;
                    cbt[4 * q + e] = cbt[4 * q + e] * (fw + bw) + (sidx == l ? dskip : 0.f); } }
#pragma unroll
            for (int ks = 0; ks < 2; ++ks) {
                u32x4 gw_; gw_.x = pkbf(cbt[8 * ks], cbt[8 * ks + 1]); gw_.y = pkbf(cbt[8 * ks + 2], cbt[8 * ks + 3]); gw_.z = pkbf(cbt[8 * ks + 4], cbt[8 * ks + 5]); gw_.w = pkbf(cbt[8 * ks + 6], cbt[8 * ks + 7]);
                const bf16x8v gf = __builtin_bit_cast(bf16x8v, gw_);
#pragma unroll
                for (int pb = 0; pb < 2; ++pb) { const LAS unsigned char* xa = lds + S3_XT + (64 * hl + 32 * pb + r) * TPITCH + 2 * (32 * sb + 16 * ks + 4 * hh);
                    const s16x4v lo = *(const LAS s16x4v*)xa, hi = *(const LAS s16x4v*)(xa + 16);
                    yacc[pb] = MFMA32(__builtin_shufflevector(lo, hi, 0, 1, 2, 3, 4, 5, 6, 7), gf, yacc[pb]); } }
        }
#pragma unroll
        for (int dir = 0; dir < 2; ++dir) { const float el = __builtin_amdgcn_exp2f(dir == 0 ? Af_l : Sb_l);
#pragma unroll
            for (int pb = 0; pb < 2; ++pb) { f32x16 ua;
#pragma unroll
                for (int i = 0; i < 16; ++i) ua[i] = 0.f;
                const bf16* pp = PREV + (((size_t)ck * 8 + h) * 2 + dir) * 8192 + pb * 4096 + (hh * 32 + r) * 8;
#pragma unroll
                for (int kk = 0; kk < 8; ++kk) { const bf16x8v pf = *(const bf16x8v*)(pp + kk * 512); ua = MFMA32(pf, cf[kk], ua); }
                yacc[pb] = yacc[pb] + ua * el; } }
        const size_t mrow = (size_t)(m0 + l); float ssq = 0.f;
#pragma unroll
        for (int pb = 0; pb < 2; ++pb)
#pragma unroll
            for (int q = 0; q < 4; ++q) { const int pc = h * 64 + 32 * pb + 8 * q + 4 * hh; const u32x2 zv = *(const u32x2*)(Zb + mrow * 512 + pc); const f32x4 gv = *(const f32x4*)(gssm + pc);
                const float v0 = yacc[pb][4 * q] * silu_f(bf_lo(zv.x)), v1 = yacc[pb][4 * q + 1] * silu_f(bf_hi(zv.x)), v2 = yacc[pb][4 * q + 2] * silu_f(bf_lo(zv.y)), v3 = yacc[pb][4 * q + 3] * silu_f(bf_hi(zv.y));
                ssq += (v0 * v0 + v1 * v1) + (v2 * v2 + v3 * v3);
                u32x2 w; w.x = pkbf(v0 * gv[0], v1 * gv[1]); w.y = pkbf(v2 * gv[2], v3 * gv[3]); *(u32x2*)(MIX + mrow * 1024 + 512 + pc) = w; }
        ssq += __shfl_xor(ssq, 32);
        if (hh == 0) atomicAdd(SSQS + mrow, ssq);
    }
}

__device__ __forceinline__ void gate_norm_row(int m, int lane, const float* Y, const bf16* Z, const float* g, bf16* MIX) {
    const f32x4 y0 = *(const f32x4*)(Y + (size_t)m * 512 + 8 * lane), y1 = *(const f32x4*)(Y + (size_t)m * 512 + 8 * lane + 4);
    const u32x4 zv = *(const u32x4*)(Z + (size_t)m * 512 + 8 * lane);
    float v[8] = {y0[0] * silu_f(bf_lo(zv.x)), y0[1] * silu_f(bf_hi(zv.x)), y0[2] * silu_f(bf_lo(zv.y)), y0[3] * silu_f(bf_hi(zv.y)),
                  y1[0] * silu_f(bf_lo(zv.z)), y1[1] * silu_f(bf_hi(zv.z)), y1[2] * silu_f(bf_lo(zv.w)), y1[3] * silu_f(bf_hi(zv.w))};
    float ss = 0.f;
#pragma unroll
    for (int e = 0; e < 8; ++e) ss += v[e] * v[e];
    const float scl = 1.f / sqrtf(wave_sum(ss) * (1.f / 512.f) + RMS_EPS);
    const f32x4 g0 = *(const f32x4*)(g + 8 * lane), g1 = *(const f32x4*)(g + 8 * lane + 4);
    u32x4 w; w.x = pkbf(v[0] * scl * g0[0], v[1] * scl * g0[1]); w.y = pkbf(v[2] * scl * g0[2], v[3] * scl * g0[3]);
    w.z = pkbf(v[4] * scl * g1[0], v[5] * scl * g1[1]); w.w = pkbf(v[6] * scl * g1[2], v[7] * scl * g1[3]);
    *(u32x4*)(MIX + (size_t)m * 1024 + 512 + 8 * lane) = w;
}

#define XB_TMO      128
#define XB_XCNT(j)  (256  + 64 * (j))
#define XB_XSUB(j)  (1280 + 64 * (j))
#define XB_XGEN(j)  (2304 + 64 * (j))
#define XB_TOP      3328
#define XB_TOPGEN   3392
#define XCD_BAR_WORDS 3456
#define XB_SPIN_CAP (1u << 18)

__device__ __forceinline__ unsigned xb_ld(unsigned* p)              { return __hip_atomic_load(p, __ATOMIC_RELAXED, __HIP_MEMORY_SCOPE_AGENT); }
__device__ __forceinline__ unsigned xb_add(unsigned* p, unsigned v) { return __hip_atomic_fetch_add(p, v, __ATOMIC_RELAXED, __HIP_MEMORY_SCOPE_AGENT); }
__device__ __forceinline__ unsigned xb_xcc_id() { return (unsigned)__builtin_amdgcn_s_getreg((3 << 11) | 20) & 0xFu; }
#define XB_SPIN(cond, bar) do { unsigned _sp = 0; while (cond) { __builtin_amdgcn_s_sleep(1); \
    if ((++_sp & 255u) == 0u) { if (xb_ld(&(bar)[XB_TMO])) break; if (_sp > XB_SPIN_CAP) { atomicAdd(&(bar)[XB_TMO], 1u); break; } } } } while (0)

struct XcdBarrier {
    unsigned* bar; unsigned x;
    volatile LAS unsigned* st;
};

__device__ __forceinline__ XcdBarrier xcd_barrier_post(unsigned* bar, volatile LAS unsigned* st) {
    XcdBarrier b; b.bar = bar; b.x = xb_xcc_id(); b.st = st;
    if (threadIdx.x == 0) (void)xb_add(&bar[XB_XCNT(b.x)], 1u);
    return b;
}
__device__ __forceinline__ void xcd_barrier_complete(unsigned* bar, unsigned x, unsigned& nloc, unsigned& nx) {
    const unsigned G = gridDim.x * gridDim.y * gridDim.z;
    unsigned sum, cnt, mine, sp = 0u;
    for (;;) {
        sum = 0u; cnt = 0u; mine = 0u;
#pragma unroll
        for (unsigned j = 0; j < 16; ++j) { const unsigned c = xb_ld(&bar[XB_XCNT(j)]); sum += c; cnt += (c > 0u) ? 1u : 0u; mine = (j == x) ? c : mine; }
        if (sum == G) break;
        __builtin_amdgcn_s_sleep(1);
        if ((++sp & 255u) == 0u) { if (xb_ld(&bar[XB_TMO])) break; if (sp > XB_SPIN_CAP) { atomicAdd(&bar[XB_TMO], 1u); break; } }
    }
    nloc = mine > 0u ? mine : 1u; nx = cnt > 0u ? cnt : 1u;
}

__device__ __forceinline__ void xcd_barrier(const XcdBarrier& b) {
    asm volatile("s_waitcnt vmcnt(0)" ::: "memory");
    __syncthreads();
    if (threadIdx.x == 0) {
        unsigned* bar = b.bar;
        __builtin_amdgcn_s_waitcnt(0);
        unsigned nloc = b.st[0], nx = b.st[1];
        if (nloc == 0u) { xcd_barrier_complete(bar, b.x, nloc, nx); b.st[0] = nloc; b.st[1] = nx; }
        const unsigned old = xb_add(&bar[XB_XSUB(b.x)], 1u);
        const unsigned gen = old / nloc;
        if (old + 1u == (gen + 1u) * nloc) {
            __builtin_amdgcn_fence(__ATOMIC_RELEASE, "agent");
            asm volatile("s_waitcnt vmcnt(0)" ::: "memory");
            const unsigned og = xb_add(&bar[XB_TOP], 1u);
            const unsigned tg = og / nx;
            if (og + 1u == (tg + 1u) * nx) xb_add(&bar[XB_TOPGEN], 1u);
            else XB_SPIN(xb_ld(&bar[XB_TOPGEN]) == tg, bar);
            __builtin_amdgcn_fence(__ATOMIC_ACQUIRE, "agent");
            xb_add(&bar[XB_XGEN(b.x)], 1u);
            asm volatile("s_waitcnt vmcnt(0)" ::: "memory");
        } else {
            XB_SPIN(xb_ld(&bar[XB_XGEN(b.x)]) == gen, bar);
            __builtin_amdgcn_fence(__ATOMIC_ACQUIRE, "agent");
            asm volatile("s_waitcnt vmcnt(0)" ::: "memory");
        }
    }
    __syncthreads();
}

#define FRESH_IDS() int tid = threadIdx.x; asm volatile("" : "+v"(tid)); int G = gridDim.x, bx = blockIdx.x; asm volatile("" : "+s"(G), "+s"(bx)); \
    const int lane = tid & 63, wave = __builtin_amdgcn_readfirstlane(tid >> 6), gw = bx * NWAVES + wave, NGW = G * NWAVES; (void)gw; (void)lane; (void)NGW; \
    unsigned char* ws = KWS(); float* out = KOUT(); (void)out; \
    bf16* XB = (bf16*)(ws + WS_XB); bf16* Hb = (bf16*)(ws + WS_H); bf16* QKV = (bf16*)(ws + WS_QKV); bf16* Zb = (bf16*)(ws + WS_Z); bf16* RAW = (bf16*)(ws + WS_RAW); \
    float* Yb = (float*)(ws + WS_Y); float* DTb = (float*)(ws + WS_DT); (void)XB; (void)Hb; (void)QKV; (void)Zb; (void)RAW; (void)Yb; (void)DTb
template <int l> __device__ __forceinline__ void layer_body(LAS unsigned char* lds, const XcdBarrier& xb) {
        { FRESH_IDS(); pg8::Gemm g{XB, (const bf16*)(ws + WS_W + (size_t)l * W_LAYER + OW_GU1), M, NGU, D}; pg8::StaticOrder S; S.init(M, NGU, (int)gridDim.x, (int)blockIdx.x); pg8::EpiSwiGLU E{Hb, FF};
          pg8::gemm_phase<pg8::EpiSwiGLU, pg8::StaticOrder, true, true>(lds, g, S, E); }
        xcd_barrier(xb);
        { FRESH_IDS(); pg8::Gemm g{Hb, (const bf16*)(ws + WS_W + (size_t)l * W_LAYER + OW_D1), M, D, FF}; pg8::StaticOrder S; S.init(M, D, (int)gridDim.x, (int)blockIdx.x);
          pg8::EpiResidBf E{XB, 0.5f};
          pg8::gemm_phase<pg8::EpiResidBf, pg8::StaticOrder, true, true>(lds, g, S, E); }
        xcd_barrier(xb);
        { FRESH_IDS(); const float* g_ = KIN(5) + l * D; const float* b_ = KIN(6) + l * D;
          for (int m = gw; m < M; m += NGW) ln_row_bf(XB + (size_t)m * D, nullptr, g_, b_, lane);
          const f32x4 z4 = {0.f, 0.f, 0.f, 0.f};
          f32x4* sz = (f32x4*)(ws + WS_SSQ); for (int i = bx * NT + tid; i < 2 * M / 4; i += G * NT) sz[i] = z4; }
        xcd_barrier(xb);
        { FRESH_IDS(); pg8::Gemm g{XB, (const bf16*)(ws + WS_W + (size_t)l * W_LAYER + OW_IN), M, NIN, D}; pg8::StaticOrder S; S.init(M, NIN, (int)gridDim.x, (int)blockIdx.x); pg8::EpiProj E{QKV, Zb, RAW, DTb};
          pg8::gemm_phase<pg8::EpiProj, pg8::StaticOrder, true, true>(lds, g, S, E); }
        xcd_barrier(xb);
#ifndef MIXREP
#define MIXREP 1
#endif
        for (int rep = 0; rep < MIXREP; ++rep) {
        if (rep > 0) { { FRESH_IDS(); const f32x4 z4 = {0.f, 0.f, 0.f, 0.f}; f32x4* sz = (f32x4*)(ws + WS_SSQ); for (int i = bx * NT + tid; i < 2 * M / 4; i += G * NT) sz[i] = z4; } xcd_barrier(xb); }
        { FRESH_IDS();
          for (int it = bx; it < 640 * 8; it += G)
              conv_item(it, RAW, DTb, KIN(8) + (size_t)l * 5 * 1024, KIN(9) + l * 1024, KIN(10) + l * 16, KIN(11) + l * 16, (bf16*)(ws + WS_XT), (bf16*)(ws + WS_BT), (bf16*)(ws + WS_BTOK), (bf16*)(ws + WS_CTOK),
                        (float*)(ws + WS_CUM), (float*)(ws + WS_DTA), (float*)(ws + WS_WST), lds, tid, wave, lane);
          { const int per = (5120 + G - 1) / G; const int u0 = bx * per, u1 = min(u0 + per, 5120);
            for (int u = u0; u < u1; ++u) attn_fast_unit(u, QKV, (const float*)(ws + WS_TB) + (size_t)l * 8 * 4 * 15 * 512, KIN(14) + l * 512, (bf16*)out, (float*)(ws + WS_SSQ), lds, tid, wave, lane); } }
        xcd_barrier(xb);
        { FRESH_IDS();
          for (int i = 0; i < 3; ++i) { int u = bx + i * G; if (G == 256 && i == 2) u = (bx >= 64 && bx < 128) ? 512 + bx - 64 : 576; if (u >= 576) break;
              s12_unit(u, (const bf16*)(ws + WS_XT), (const bf16*)(ws + WS_BT), (const float*)(ws + WS_CUM), (const bf16*)(ws + WS_WST), (bf16*)(ws + WS_PREV), wave, lane); } }
        xcd_barrier(xb);
        { FRESH_IDS();
          for (int u = bx; u < 1280; u += G)
              s3_unit(u, (const bf16*)(ws + WS_XT), (const bf16*)(ws + WS_BTOK), (const bf16*)(ws + WS_CTOK), (const float*)(ws + WS_CUM), (const float*)(ws + WS_DTA), (const bf16*)(ws + WS_PREV), Zb,
                      KIN(12) + l * 8, KIN(13) + l * 512, (bf16*)out, (float*)(ws + WS_SSQ) + M, lds, tid, wave, lane); }
        xcd_barrier(xb);
        }
        { FRESH_IDS(); const float* ssq = (const float*)(ws + WS_SSQ);
          for (int m = gw; m < M; m += NGW) { const float sa = 1.f / sqrtf(ssq[m] * (1.f / 512.f) + RMS_EPS), ss = 1.f / sqrtf(ssq[M + m] * (1.f / 512.f) + RMS_EPS);
              u32x4* rowp = (u32x4*)((bf16*)out + (size_t)m * 1024) + lane;
#pragma unroll
              for (int hf = 0; hf < 2; ++hf) { const float f = hf ? ss : sa; u32x4 v = rowp[64 * hf];
                  v.x = pkbf(bf_lo(v.x) * f, bf_hi(v.x) * f); v.y = pkbf(bf_lo(v.y) * f, bf_hi(v.y) * f); v.z = pkbf(bf_lo(v.z) * f, bf_hi(v.z) * f); v.w = pkbf(bf_lo(v.w) * f, bf_hi(v.w) * f); rowp[64 * hf] = v; } } }
        xcd_barrier(xb);
        { FRESH_IDS(); pg8::Gemm g{(const bf16*)out, (const bf16*)(ws + WS_W + (size_t)l * W_LAYER + OW_OUT), M, D, D}; pg8::StaticOrder S; S.init(M, D, (int)gridDim.x, (int)blockIdx.x); pg8::EpiResidBf E{XB, 1.0f};
          pg8::gemm_phase<pg8::EpiResidBf, pg8::StaticOrder, true, true>(lds, g, S, E); }
        xcd_barrier(xb);
        { FRESH_IDS(); const float* g_ = KIN(17) + l * D; const float* b_ = KIN(18) + l * D;
          for (int m = gw; m < M; m += NGW) ln_row_bf(XB + (size_t)m * D, nullptr, g_, b_, lane); }
        xcd_barrier(xb);
        { FRESH_IDS(); pg8::Gemm g{XB, (const bf16*)(ws + WS_W + (size_t)l * W_LAYER + OW_GU2), M, NGU, D}; pg8::StaticOrder S; S.init(M, NGU, (int)gridDim.x, (int)blockIdx.x); pg8::EpiSwiGLU E{Hb, FF};
          pg8::gemm_phase<pg8::EpiSwiGLU, pg8::StaticOrder, true, true>(lds, g, S, E); }
        xcd_barrier(xb);
        { FRESH_IDS(); pg8::Gemm g{Hb, (const bf16*)(ws + WS_W + (size_t)l * W_LAYER + OW_D2), M, D, FF}; pg8::StaticOrder S; S.init(M, D, (int)gridDim.x, (int)blockIdx.x); pg8::EpiResidBf E{XB, 0.5f};
          pg8::gemm_phase<pg8::EpiResidBf, pg8::StaticOrder, true, true>(lds, g, S, E); }
        xcd_barrier(xb);
        { FRESH_IDS(); const float* g_ = KIN(22) + l * D; const float* b_ = KIN(23) + l * D;
          for (int m = gw; m < M; m += NGW) ln_row_bf(XB + (size_t)m * D, l == 1 ? out + (size_t)m * D : nullptr, g_, b_, lane); }
        if (l == 0) xcd_barrier(xb);
}

__global__ void __launch_bounds__(NT, 2) fwd_mega(Params P) {
    extern __shared__ __attribute__((aligned(16))) unsigned char lds_raw[];
    LAS unsigned char* lds = (LAS unsigned char*)lds_raw;
    cg::grid_group grid = cg::this_grid();
    volatile LAS unsigned* bst = (volatile LAS unsigned*)(lds + LDS_BYTES - 64);
    if (threadIdx.x < 2) bst[threadIdx.x] = 0u;
    __syncthreads();
    const XcdBarrier xb = xcd_barrier_post((unsigned*)KWS(), bst);
    { FRESH_IDS(); LAS float* scr = (LAS float*)(lds + wave * 16384);
      for (int it = gw; it < 2 * IT_LAYER; it += NGW) prologue_item(ws, it, scr, lane);
      { float* TBw = (float*)(ws + WS_TB);
        for (int i = bx * NT + tid; i < 2 * 8 * 4 * 15 * 512; i += G * NT) { const int kc = i & 31, q = (i >> 5) & 15; int t = i >> 9; const int ro = t % 15; t /= 15; const int j = t & 3; t >>= 2; const int h = t & 7, l = t >> 3;
            const int kstart = j == 0 ? 0 : (j == 1 ? 8 : (j == 2 ? 24 : 32)), qcol = 16 * j + q, kcol = kstart + kc, cst = min(max(qcol - 8, 0), 48);
            const bool valid = kcol >= cst && kcol < cst + 16;
            TBw[i] = valid ? 1.4426950408889634f * KIN(15)[((l * 8 + h) * 15 + ro) * 31 + (kcol - qcol + 15)] : -INFINITY; } }
      for (int m = gw; m < M; m += NGW) { const float* src = m < MPROMPT ? KIN(0) + (size_t)m * D : KIN(1) + (size_t)(m - MPROMPT) * D; row_to_bf16(src, XB + (size_t)m * D, lane); } }
    grid.sync();

    layer_body<0>(lds, xb);
    layer_body<1>(lds, xb);
}

extern "C" void kernel_launch(void* const* d_in, const int* in_sizes, int n_in, void* d_out, int out_size, void* d_ws, size_t ws_size, hipStream_t stream) {
    static int grid_blocks = 0;
    if (grid_blocks == 0) {
        if (n_in != 24 || out_size != M * D || ws_size < WS_END) { fprintf(stderr, "kernel_launch: unexpected shapes (n_in %d out %d ws %zu)\n", n_in, out_size, ws_size); grid_blocks = -1; return; }
        int dev = 0, cus = 0, per_cu = 0;
        (void)hipGetDevice(&dev); (void)hipDeviceGetAttribute(&cus, hipDeviceAttributeMultiprocessorCount, dev);
        if (hipFuncSetAttribute((const void*)fwd_mega, hipFuncAttributeMaxDynamicSharedMemorySize, LDS_BYTES) != hipSuccess) { fprintf(stderr, "kernel_launch: hipFuncSetAttribute failed\n"); grid_blocks = -1; return; }
        if (hipOccupancyMaxActiveBlocksPerMultiprocessor(&per_cu, (const void*)fwd_mega, NT, LDS_BYTES) != hipSuccess || per_cu < 1) { fprintf(stderr, "kernel_launch: occupancy query gave %d\n", per_cu); per_cu = 1; }
        (void)hipGetLastError();
        grid_blocks = cus * per_cu;
    }
    if (grid_blocks < 0) return;
    if (hipMemsetAsync(d_ws, 0, 65536, stream) != hipSuccess) { fprintf(stderr, "kernel_launch: memset of the barrier words failed\n"); return; }
    Params p{};
    for (int i = 0; i < 24; ++i) p.in[i] = (const float*)d_in[i];
    p.out = (float*)d_out; p.ws = (unsigned char*)d_ws;
    void* args[] = {&p};
    hipError_t e = hipLaunchCooperativeKernel((const void*)fwd_mega, dim3(grid_blocks), dim3(NT), args, LDS_BYTES, stream);
    if (e != hipSuccess) fprintf(stderr, "cooperative launch failed: %s (grid %d)\n", hipGetErrorString(e), grid_blocks);
}
```

```cpp
#include <hip/hip_runtime.h>
#include <hip/hip_cooperative_groups.h>
#include <cstdio>
#include <cstdint>
namespace cg = cooperative_groups;
namespace pg8 {
#define PG8_LAS __attribute__((address_space(3)))
typedef unsigned short bf16_t;
typedef short bf16x8 __attribute__((ext_vector_type(8)));
typedef float f32x4 __attribute__((ext_vector_type(4)));
typedef unsigned u32x4 __attribute__((ext_vector_type(4)));
constexpr int BM = 256, BK = 64, HALF = 128, HTB = HALF * BK * 2  , STAGE_BYTES = 8 * HTB, NXCD = 8, WGM = 8;

__host__ __device__ __forceinline__ int lds_byte(int r, int c) { const int st = (r >> 4) * 2 + (c >> 5), rr = r & 15, cc = c & 31, ob = rr * 64 + cc * 2; return st * 1024 + (ob ^ (((ob >> 9) & 1) << 5)); }
__host__ __device__ __forceinline__ void stage_rc(int b, int& R, int& C) { const int st = b / 1024, sb = b % 1024, swz = sb ^ (((sb >> 9) & 1) << 5); R = (st >> 1) * 16 + swz / 64; C = (st & 1) * 32 + (swz % 64) / 2; }
__host__ __device__ __forceinline__ int perm32(int rho) { const int n = rho >> 4, i = rho & 15; return 8 * (i >> 2) + 4 * n + (i & 3); }

struct Unit { int pm, pn; };
struct Gemm { const bf16_t* A; const bf16_t* Bt; int M, N, K; };

struct StaticOrder {
    int nM, nN, nwg, G, c;
    __host__ __device__ void init(int M, int N, int G_, int c_) { nM = M / BM; nN = N / BM; nwg = nM * nN; G = G_; c = c_; }
    __host__ __device__ bool next(int i, Unit& u) const {
        const long L = (long)i * G + c; if (L >= nwg) return false;
        int wgid = (int)L; { const int q = nwg / NXCD, r = nwg % NXCD, xcd = wgid % NXCD, off = wgid / NXCD; wgid = (xcd < r ? xcd * (q + 1) : r * (q + 1) + (xcd - r) * q) + off; }
        const int nig = WGM * nN, gid = wgid / nig, fm = gid * WGM, gsz = (nM - fm) < WGM ? (nM - fm) : WGM;
        u.pm = fm + ((wgid % nig) % gsz); u.pn = (wgid % nig) / gsz; return true;
    }
    __device__ __forceinline__ void a_ready(const Unit&) const {}
    __device__ __forceinline__ void done(const Unit&) const {}
};

typedef float f32x2e __attribute__((ext_vector_type(2)));
typedef __bf16 bf16x2e __attribute__((ext_vector_type(2)));
__device__ __forceinline__ unsigned pkbf(float a, float b) { f32x2e v = {a, b}; bf16x2e r = __builtin_convertvector(v, bf16x2e); return __builtin_bit_cast(unsigned, r); }
__device__ __forceinline__ float silu_f(float g) { return g * __builtin_amdgcn_rcpf(1.f + __builtin_amdgcn_exp2f(-1.4426950408889634f * g)); }
constexpr float ALPHA_F = 1.4142135623730951f;
constexpr int MPROMPT = 65536;

struct EpiSwiGLU {
    static constexpr bool PERM = true, AFTER_DRAIN = false, MID = false;
    bf16_t* H; int ldh;
    __device__ __forceinline__ void operator()(const f32x4 (&acc)[2][2][4][2], const Unit& u, int wr, int wc, int fr, int fq) const {
        const int row0 = u.pm * BM + wr * 64 + fr, col0 = u.pn * HALF + wc * 32 + 8 * fq;
#pragma unroll
        for (int ai = 0; ai < 2; ++ai)
#pragma unroll
            for (int m = 0; m < 4; ++m) {
                bf16_t* p = H + (size_t)(row0 + ai * HALF + m * 16) * ldh + col0;
                const f32x4 g0 = acc[ai][0][m][0], g1 = acc[ai][0][m][1], u0 = acc[ai][1][m][0], u1 = acc[ai][1][m][1];
                u32x4 w;
                w.x = pkbf(silu_f(g0[0]) * u0[0], silu_f(g0[1]) * u0[1]); w.y = pkbf(silu_f(g0[2]) * u0[2], silu_f(g0[3]) * u0[3]);
                w.z = pkbf(silu_f(g1[0]) * u1[0], silu_f(g1[1]) * u1[1]); w.w = pkbf(silu_f(g1[2]) * u1[2], silu_f(g1[3]) * u1[3]);
                *(u32x4*)p = w;
            }
    }
};
struct EpiResid {
    static constexpr bool PERM = false, AFTER_DRAIN = false, MID = false;
    const float* r0; const float* r1; float* out; float scale;
    __device__ __forceinline__ void operator()(const f32x4 (&acc)[2][2][4][2], const Unit& u, int wr, int wc, int fr, int fq) const {
        const float* rbase = (u.pm * BM < MPROMPT) ? r0 : r1;
#pragma unroll
        for (int ai = 0; ai < 2; ++ai)
#pragma unroll
            for (int m = 0; m < 4; ++m) {
                const size_t roff = (size_t)(u.pm * BM + ai * HALF + wr * 64 + m * 16 + fr) * 1024;
#pragma unroll
                for (int bj = 0; bj < 2; ++bj)
#pragma unroll
                    for (int n = 0; n < 2; ++n) {
                        const int c = u.pn * BM + bj * HALF + wc * 32 + n * 16 + 4 * fq;
                        const f32x4 b = *(const f32x4*)(rbase + roff + c);
                        *(f32x4*)(out + roff + c) = b * ALPHA_F + acc[ai][bj][m][n] * scale;
                    }
            }
    }
};
struct EpiResidBf {
    static constexpr bool PERM = true, AFTER_DRAIN = false, MID = false;
    bf16_t* X; float scale;
    __device__ __forceinline__ void operator()(const f32x4 (&acc)[2][2][4][2], const Unit& u, int wr, int wc, int fr, int fq) const {
        const int row0 = u.pm * BM + wr * 64 + fr, col0 = u.pn * BM + wc * 32 + 8 * fq;
#pragma unroll
        for (int ai = 0; ai < 2; ++ai)
#pragma unroll
            for (int m = 0; m < 4; ++m) { bf16_t* rowp = X + (size_t)(row0 + ai * HALF + m * 16) * 1024 + col0;
#pragma unroll
                for (int bj = 0; bj < 2; ++bj) { const u32x4 xv = *(const u32x4*)(rowp + bj * HALF); const f32x4 a0 = acc[ai][bj][m][0] * scale, a1 = acc[ai][bj][m][1] * scale;
                    u32x4 w;
                    w.x = pkbf(__uint_as_float(xv.x << 16) * ALPHA_F + a0[0], __uint_as_float(xv.x & 0xffff0000u) * ALPHA_F + a0[1]);
                    w.y = pkbf(__uint_as_float(xv.y << 16) * ALPHA_F + a0[2], __uint_as_float(xv.y & 0xffff0000u) * ALPHA_F + a0[3]);
                    w.z = pkbf(__uint_as_float(xv.z << 16) * ALPHA_F + a1[0], __uint_as_float(xv.z & 0xffff0000u) * ALPHA_F + a1[1]);
                    w.w = pkbf(__uint_as_float(xv.w << 16) * ALPHA_F + a1[2], __uint_as_float(xv.w & 0xffff0000u) * ALPHA_F + a1[3]);
                    *(u32x4*)(rowp + bj * HALF) = w; } }
    }
};
struct EpiResidMix {
    static constexpr bool PERM = false, AFTER_DRAIN = false, MID = true;
    float* out; const float* ssq;
    __device__ __forceinline__ void mid(f32x4 (&acc)[2][2][4][2], const Unit& u, int wr, int wc, int fr, int fq) const {
#pragma unroll
        for (int ai = 0; ai < 2; ++ai)
#pragma unroll
            for (int m = 0; m < 4; ++m) { const int r = u.pm * BM + ai * HALF + wr * 64 + m * 16 + fr;
                const float f = sqrtf((ssq[81920 + r] * (1.f / 512.f) + 1e-6f) / (ssq[r] * (1.f / 512.f) + 1e-6f));
#pragma unroll
                for (int bj = 0; bj < 2; ++bj)
#pragma unroll
                    for (int n = 0; n < 2; ++n) acc[ai][bj][m][n] = acc[ai][bj][m][n] * f; }
    }
    __device__ __forceinline__ void operator()(const f32x4 (&acc)[2][2][4][2], const Unit& u, int wr, int wc, int fr, int fq) const {
#pragma unroll
        for (int ai = 0; ai < 2; ++ai)
#pragma unroll
            for (int m = 0; m < 4; ++m) { const int r = u.pm * BM + ai * HALF + wr * 64 + m * 16 + fr; const size_t roff = (size_t)r * 1024;
                const float f = 1.f / sqrtf(ssq[81920 + r] * (1.f / 512.f) + 1e-6f);
#pragma unroll
                for (int bj = 0; bj < 2; ++bj)
#pragma unroll
                    for (int n = 0; n < 2; ++n) { const int c = u.pn * BM + bj * HALF + wc * 32 + n * 16 + 4 * fq;
                        const f32x4 b = *(const f32x4*)(out + roff + c);
                        *(f32x4*)(out + roff + c) = b * ALPHA_F + acc[ai][bj][m][n] * f; } }
    }
};
struct EpiProj {
    static constexpr bool PERM = true, AFTER_DRAIN = false, MID = false;
    bf16_t* QKV; bf16_t* Z; bf16_t* XBC; float* DT;
    __device__ __forceinline__ void operator()(const f32x4 (&acc)[2][2][4][2], const Unit& u, int wr, int wc, int fr, int fq) const {
        const int row0 = u.pm * BM + wr * 64 + fr, pn = u.pn;
        if (pn == 12) {
            if (wc == 0 && fq < 2) {
#pragma unroll
                for (int ai = 0; ai < 2; ++ai)
#pragma unroll
                    for (int m = 0; m < 4; ++m) { float* p = DT + (size_t)(row0 + ai * HALF + m * 16) * 16 + 8 * fq;
                        *(f32x4*)p = acc[ai][0][m][0]; *(f32x4*)(p + 4) = acc[ai][0][m][1]; }
            }
            return;
        }
        bf16_t* base; int ldc, colt; float sc = 1.f;
        if (pn < 6) { base = QKV; ldc = 1536; colt = pn * 256; if (pn < 2) sc = 0.125f * 1.4426950408889634f; }
        else if (pn < 8) { base = Z; ldc = 512; colt = (pn - 6) * 256; }
        else { base = XBC; ldc = 1024; colt = (pn - 8) * 256; }
        const int col0 = colt + wc * 32 + 8 * fq;
#pragma unroll
        for (int ai = 0; ai < 2; ++ai)
#pragma unroll
            for (int m = 0; m < 4; ++m) { bf16_t* rowp = base + (size_t)(row0 + ai * HALF + m * 16) * ldc + col0;
#pragma unroll
                for (int bj = 0; bj < 2; ++bj) { const f32x4 v0 = acc[ai][bj][m][0] * sc, v1 = acc[ai][bj][m][1] * sc;
                    u32x4 w; w.x = pkbf(v0[0], v0[1]); w.y = pkbf(v0[2], v0[3]); w.z = pkbf(v1[0], v1[1]); w.w = pkbf(v1[2], v1[3]);
                    *(u32x4*)(rowp + bj * HALF) = w; } }
    }
};

template <class Epi, class Sched, bool ALIGN_EPI = false, bool SP2 = false>
__device__ __forceinline__ void gemm_phase(PG8_LAS unsigned char* lds, const Gemm g, const Sched& S, const Epi& E) {
    int tid_ = threadIdx.x; asm volatile("" : "+v"(tid_));
    const int tid = tid_, wid = __builtin_amdgcn_readfirstlane(tid >> 6), lane = tid & 63, wr = wid >> 2, wc = wid & 3, fr = lane & 15, fq = lane >> 4;
    const int K = g.K, nt = K / BK;
    unsigned voffA[2], voffB[2];
#pragma unroll
    for (int i = 0; i < 2; ++i) { int R, C; stage_rc(tid * 16 + i * 8192, R, C); const int Rb = Epi::PERM ? ((R & ~31) + perm32(R & 31)) : R;
        voffA[i] = (unsigned)(R * K + C) * 2u; voffB[i] = (unsigned)(Rb * K + C) * 2u; }
    const size_t kstep = (size_t)(BK * 2);
    const size_t hstep = (size_t)HALF * K * 2;
    const size_t tstep = 2 * hstep;
    const unsigned ldsw = (unsigned)wid * 1024u;
    const int aoff = lds_byte(wr * 64 + fr, fq * 8), boff = lds_byte(wc * 32 + fr, fq * 8);
#define PG8_SA(b, h) (((b) * 2 + (h)) * HTB)
#define PG8_SB(b, h) ((4 + (b) * 2 + (h)) * HTB)
#define PG8_STAGE(bufoff, gbase, voff) do { _Pragma("unroll") for (int _i = 0; _i < 2; ++_i) \
        __builtin_amdgcn_global_load_lds((const unsigned*)((const char*)(gbase) + (voff)[_i]), (PG8_LAS unsigned*)(lds + (bufoff) + ldsw + _i * 8192), 16, 0, 0); } while (0)
#define PG8_LDA(dst, b, h) do { _Pragma("unroll") for (int m = 0; m < 4; ++m) _Pragma("unroll") for (int k = 0; k < 2; ++k) dst[m][k] = *(const PG8_LAS bf16x8*)(lds + PG8_SA(b, h) + aoff + m * 2048 + k * 1024); } while (0)
#define PG8_LDB(dst, b, h) do { _Pragma("unroll") for (int n = 0; n < 2; ++n) _Pragma("unroll") for (int k = 0; k < 2; ++k) dst[n][k] = *(const PG8_LAS bf16x8*)(lds + PG8_SB(b, h) + boff + n * 2048 + k * 1024); } while (0)
#define PG8_MMA(ai, bj, At, Bt) do { __builtin_amdgcn_s_setprio(1); _Pragma("unroll") for (int m = 0; m < 4; ++m) _Pragma("unroll") for (int n = 0; n < 2; ++n) _Pragma("unroll") for (int k = 0; k < 2; ++k) \
        acc[ai][bj][m][n] = __builtin_amdgcn_mfma_f32_16x16x32_bf16(Bt[n][k], At[m][k], acc[ai][bj][m][n], 0, 0, 0); __builtin_amdgcn_s_setprio(0); } while (0)
#define PG8_WAIT_V(n) asm volatile("s_waitcnt vmcnt(" #n ")" ::: "memory")
#define PG8_WAIT_L(n) asm volatile("s_waitcnt lgkmcnt(" #n ")" ::: "memory")
#define PG8_BAR __builtin_amdgcn_s_barrier()
#define PG8_SCHED __builtin_amdgcn_sched_barrier(0)
    Unit cur, nxt; int ui = 0;
    if (!S.next(0, cur)) return;
    f32x4 acc[2][2][4][2];
#pragma unroll
    for (int a = 0; a < 2; ++a)
#pragma unroll
        for (int b = 0; b < 2; ++b)
#pragma unroll
            for (int m = 0; m < 4; ++m)
#pragma unroll
                for (int n = 0; n < 2; ++n) acc[a][b][m][n] = (f32x4){0.f, 0.f, 0.f, 0.f};
    bf16x8 At[4][2], B0[2][2], B1[2][2];
    const char* cA = (const char*)g.A + (size_t)cur.pm * tstep; const char* cB = (const char*)g.Bt + (size_t)cur.pn * tstep;
    S.a_ready(cur);
    if constexpr (SP2) {
        PG8_STAGE(PG8_SB(0, 0), cB, voffB); PG8_STAGE(PG8_SB(0, 1), cB + hstep, voffB); PG8_STAGE(PG8_SA(0, 0), cA, voffA); PG8_STAGE(PG8_SA(0, 1), cA + hstep, voffA);
        if (wr == 1) PG8_BAR;
        PG8_WAIT_V(2); PG8_BAR;
        PG8_STAGE(PG8_SB(1, 0), cB + kstep, voffB); PG8_STAGE(PG8_SA(1, 0), cA + kstep, voffA); PG8_STAGE(PG8_SB(1, 1), cB + hstep + kstep, voffB);
        PG8_WAIT_V(6); PG8_BAR;
    } else {
        PG8_STAGE(PG8_SB(0, 0), cB, voffB); PG8_STAGE(PG8_SA(0, 0), cA, voffA); PG8_STAGE(PG8_SB(0, 1), cB + hstep, voffB); PG8_STAGE(PG8_SA(0, 1), cA + hstep, voffA);
        if (wr == 1) PG8_BAR;
        PG8_WAIT_V(4); PG8_BAR;
        PG8_STAGE(PG8_SB(1, 0), cB + kstep, voffB); PG8_STAGE(PG8_SA(1, 0), cA + kstep, voffA); PG8_STAGE(PG8_SB(1, 1), cB + hstep + kstep, voffB);
        PG8_WAIT_V(6); PG8_BAR;
    }
    for (;;) {
        const bool has_next = S.next(ui + 1, nxt);
        const char* nA = has_next ? (const char*)g.A + (size_t)nxt.pm * tstep : cA; const char* nB = has_next ? (const char*)g.Bt + (size_t)nxt.pn * tstep : cB;
        for (int t = 0; t < nt; t += 2) {
            if constexpr (Epi::MID) { if (t == (nt >> 1)) E.mid(acc, cur, wr, wc, fr, fq); }
            const bool last = (t == nt - 2);
            const char* a1 = cA + (size_t)(t + 1) * kstep;
            const char* a2 = last ? nA : cA + (size_t)(t + 2) * kstep; const char* b2 = last ? nB : cB + (size_t)(t + 2) * kstep;
            const char* a3 = a2 + kstep; const char* b3 = b2 + kstep;
            if (last && has_next) S.a_ready(nxt);
            if constexpr (SP2) {
            PG8_LDB(B0, 0, 0); PG8_LDB(B1, 0, 1); PG8_SCHED; PG8_LDA(At, 0, 0); PG8_STAGE(PG8_SA(1, 1), a1 + hstep, voffA);
            PG8_WAIT_V(8); PG8_WAIT_L(0); PG8_BAR; PG8_MMA(0, 0, At, B0); PG8_MMA(0, 1, At, B1); PG8_BAR; PG8_SCHED;
            PG8_LDA(At, 0, 1); PG8_STAGE(PG8_SB(0, 0), b2, voffB); PG8_STAGE(PG8_SB(0, 1), b2 + hstep, voffB); PG8_STAGE(PG8_SA(0, 0), a2, voffA);
            PG8_WAIT_V(8); PG8_WAIT_L(0); PG8_BAR; PG8_MMA(1, 0, At, B0); PG8_MMA(1, 1, At, B1); PG8_BAR; PG8_SCHED;
            PG8_LDB(B0, 1, 0); PG8_LDB(B1, 1, 1); PG8_SCHED; PG8_LDA(At, 1, 0); PG8_STAGE(PG8_SA(0, 1), a2 + hstep, voffA);
            PG8_WAIT_V(8); PG8_WAIT_L(0); PG8_BAR; PG8_MMA(0, 0, At, B0); PG8_MMA(0, 1, At, B1); PG8_BAR; PG8_SCHED;
            PG8_LDA(At, 1, 1); PG8_STAGE(PG8_SB(1, 0), b3, voffB); PG8_STAGE(PG8_SB(1, 1), b3 + hstep, voffB); PG8_STAGE(PG8_SA(1, 0), a3, voffA);
            PG8_WAIT_V(8); PG8_WAIT_L(0); PG8_BAR; PG8_MMA(1, 0, At, B0); PG8_MMA(1, 1, At, B1); PG8_BAR; PG8_SCHED;
            } else {
            PG8_LDB(B0, 0, 0); PG8_SCHED; PG8_LDA(At, 0, 0); PG8_STAGE(PG8_SA(1, 1), a1 + hstep, voffA);
            PG8_WAIT_L(8); PG8_BAR; PG8_WAIT_L(0); PG8_MMA(0, 0, At, B0); PG8_BAR; PG8_SCHED;
            PG8_LDB(B1, 0, 1); PG8_STAGE(PG8_SB(0, 0), b2, voffB);
            PG8_BAR; PG8_WAIT_L(0); PG8_MMA(0, 1, At, B1); PG8_BAR;
            PG8_LDA(At, 0, 1); PG8_STAGE(PG8_SA(0, 0), a2, voffA);
            PG8_BAR; PG8_WAIT_L(0); PG8_MMA(1, 0, At, B0); PG8_BAR; PG8_SCHED;
            PG8_STAGE(PG8_SB(0, 1), b2 + hstep, voffB);
            PG8_WAIT_V(6); PG8_BAR; PG8_MMA(1, 1, At, B1); PG8_BAR;
            PG8_LDB(B0, 1, 0); PG8_SCHED; PG8_LDA(At, 1, 0); PG8_STAGE(PG8_SA(0, 1), a2 + hstep, voffA);
            PG8_WAIT_L(8); PG8_BAR; PG8_WAIT_L(0); PG8_MMA(0, 0, At, B0); PG8_BAR; PG8_SCHED;
            PG8_LDB(B1, 1, 1); PG8_STAGE(PG8_SB(1, 0), b3, voffB);
            PG8_BAR; PG8_WAIT_L(0); PG8_MMA(0, 1, At, B1); PG8_BAR;
            PG8_LDA(At, 1, 1); PG8_STAGE(PG8_SA(1, 0), a3, voffA);
            PG8_BAR; PG8_WAIT_L(0); PG8_MMA(1, 0, At, B0); PG8_BAR; PG8_SCHED;
            PG8_STAGE(PG8_SB(1, 1), b3 + hstep, voffB);
            PG8_WAIT_V(6); PG8_BAR; PG8_MMA(1, 1, At, B1); PG8_BAR;
            }
        }
        if constexpr (ALIGN_EPI) { if (wr == 0) PG8_BAR; }
        if constexpr (!Epi::AFTER_DRAIN) { E(acc, cur, wr, wc, fr, fq); S.done(cur); }
        if (!has_next) break;
#pragma unroll
        for (int a = 0; a < 2; ++a)
#pragma unroll
            for (int b = 0; b < 2; ++b)
#pragma unroll
                for (int m = 0; m < 4; ++m)
#pragma unroll
                    for (int n = 0; n < 2; ++n) acc[a][b][m][n] = (f32x4){0.f, 0.f, 0.f, 0.f};
        cur = nxt; cA = nA; cB = nB; ++ui;
        if constexpr (ALIGN_EPI) { if (wr == 1) PG8_BAR; }
    }
    PG8_WAIT_V(0);
    if constexpr (!ALIGN_EPI) { if (wr == 0) PG8_BAR; }
    PG8_BAR;
    if constexpr (Epi::AFTER_DRAIN) { E.fused(acc, cur, wr, wc, fr, fq, lds, wid, lane); S.done(cur); }
#undef PG8_SA
#undef PG8_SB
#undef PG8_STAGE
#undef PG8_LDA
#undef PG8_LDB
#undef PG8_MMA
#undef PG8_WAIT_V
#undef PG8_WAIT_L
#undef PG8_BAR
#undef PG8_SCHED
}
}

#define LAS __attribute__((address_space(3)))
typedef unsigned short bf16;
using pg8::f32x4; using pg8::u32x4; using pg8::pkbf; using pg8::silu_f; using pg8::MPROMPT;
typedef unsigned u32x2 __attribute__((ext_vector_type(2)));
constexpr int NWAVES = 8, NT = 512;
constexpr int M = 81920, D = 1024, FF = 2816, NGU = 5632, NIN = 3328, NPROJ = 3088;
constexpr float LN_EPS = 1e-5f, RMS_EPS = 1e-6f;
constexpr size_t MiB = 1u << 20;
constexpr size_t WS_W = 1 * MiB, W_LAYER = 42 * MiB;
constexpr size_t OW_GU1 = 0, OW_D1 = 11534336, OW_IN = 17301504, OW_OUT = 24117248, OW_GU2 = 26214400, OW_D2 = 37748736;
constexpr size_t WS_XB = 85 * MiB, WS_R = 245 * MiB, WS_QKV = WS_R, WS_Z = WS_R + 240 * MiB, WS_RAW = WS_R + 320 * MiB, WS_H = WS_R;
constexpr size_t WS_Y = 725 * MiB;
constexpr size_t WS_XT = 725 * MiB, WS_BT = 805 * MiB, WS_BTOK = 845 * MiB, WS_CTOK = 885 * MiB;
constexpr size_t WS_CUM = 925 * MiB, WS_DTA = 930 * MiB, WS_WST = 935 * MiB;
constexpr size_t WS_DT = 940 * MiB, WS_SSQ = 945 * MiB, WS_TB = 946 * MiB, WS_END = 948 * MiB;
constexpr size_t WS_PREV = WS_RAW;
constexpr int LDS_BYTES = 155648;

#define LDS_WAIT() asm volatile("s_waitcnt lgkmcnt(0)" ::: "memory")
__device__ __forceinline__ float bf_lo(unsigned u) { return __uint_as_float(u << 16); }
__device__ __forceinline__ float bf_hi(unsigned u) { return __uint_as_float(u & 0xffff0000u); }
__device__ __forceinline__ float bf2f(bf16 v) { return __uint_as_float(((unsigned)v) << 16); }
__device__ __forceinline__ bf16 f2bf(float f) { return (bf16)(pkbf(f, 0.f) & 0xffffu); }
__device__ __forceinline__ float wave_sum(float v) {
#pragma unroll
    for (int o = 1; o < 64; o <<= 1) v += __shfl_xor(v, o);
    return v;
}
__device__ __forceinline__ float wave_max(float v) {
#pragma unroll
    for (int o = 1; o < 64; o <<= 1) v = fmaxf(v, __shfl_xor(v, o));
    return v;
}

struct Params { const float* in[24]; float* out; unsigned char* ws; };
__device__ __forceinline__ unsigned long long karg_u64(int i) { int j = i; asm volatile("" : "+s"(j)); const __attribute__((address_space(4))) unsigned long long* ka = (const __attribute__((address_space(4))) unsigned long long*)__builtin_amdgcn_kernarg_segment_ptr(); return ka[j]; }
#define KIN(i) ((const float*)karg_u64(i))
#define KOUT() ((float*)karg_u64(24))
#define KWS() ((unsigned char*)karg_u64(25))

__device__ __forceinline__ void tr_item(const float* W, int ldw, int ncols, bf16* WT, int Kdst, int k0, int n0, int drow, LAS float* scr, int lane) {
    int n = n0 + (lane & 31); n = n < ncols ? n : ncols - 1;
#pragma unroll 8
    for (int i = 0; i < 32; ++i) { const int kk = 2 * i + (lane >> 5); scr[kk * 33 + (lane & 31)] = W[(size_t)(k0 + kk) * ldw + n]; }
    LDS_WAIT(); asm volatile("" ::: "memory");
    const int c = lane & 7;
#pragma unroll
    for (int j = 0; j < 4; ++j) { const int nn = (lane >> 3) + 8 * j; const LAS float* s = scr + (8 * c) * 33 + nn;
        u32x4 o; o.x = pkbf(s[0 * 33], s[1 * 33]); o.y = pkbf(s[2 * 33], s[3 * 33]); o.z = pkbf(s[4 * 33], s[5 * 33]); o.w = pkbf(s[6 * 33], s[7 * 33]);
        *(u32x4*)(WT + (size_t)(drow + nn) * Kdst + k0 + 8 * c) = o; }
    LDS_WAIT(); asm volatile("" ::: "memory");
}
constexpr int IT_GU = 16 * 88, IT_D = 44 * 32, IT_IN = 16 * 97, IT_OUT = 16 * 32, IT_LAYER = 6 * IT_GU + IT_IN + IT_OUT;
__device__ __forceinline__ void prologue_item(unsigned char* wsb, int it, LAS float* scr, int lane) {
    const int l = it / IT_LAYER; int r = it % IT_LAYER;
    unsigned char* wl = wsb + WS_W + (size_t)l * W_LAYER;
    if (r < 2 * IT_GU) { const int up = r >= IT_GU; r -= up * IT_GU; const int kb = r / 88, nb = r % 88, n0 = 32 * nb;
        tr_item(KIN(up ? 3 : 2) + (size_t)l * D * FF, FF, FF, (bf16*)(wl + OW_GU1), D, 64 * kb, n0, 256 * (n0 >> 7) + (n0 & 127) + 128 * up, scr, lane); return; }
    r -= 2 * IT_GU;
    if (r < IT_D) { const int kb = r / 32, nb = r % 32; tr_item(KIN(4) + (size_t)l * FF * D, D, D, (bf16*)(wl + OW_D1), FF, 64 * kb, 32 * nb, 32 * nb, scr, lane); return; }
    r -= IT_D;
    if (r < IT_IN) { const int kb = r / 97, nb = r % 97; tr_item(KIN(7) + (size_t)l * D * NPROJ, NPROJ, NPROJ, (bf16*)(wl + OW_IN), D, 64 * kb, 32 * nb, 32 * nb, scr, lane); return; }
    r -= IT_IN;
    if (r < IT_OUT) { const int kb = r / 32, nb = r % 32; tr_item(KIN(16) + (size_t)l * D * D, D, D, (bf16*)(wl + OW_OUT), D, 64 * kb, 32 * nb, 32 * nb, scr, lane); return; }
    r -= IT_OUT;
    if (r < 2 * IT_GU) { const int up = r >= IT_GU; r -= up * IT_GU; const int kb = r / 88, nb = r % 88, n0 = 32 * nb;
        tr_item(KIN(up ? 20 : 19) + (size_t)l * D * FF, FF, FF, (bf16*)(wl + OW_GU2), D, 64 * kb, n0, 256 * (n0 >> 7) + (n0 & 127) + 128 * up, scr, lane); return; }
    r -= 2 * IT_GU;
    { const int kb = r / 32, nb = r % 32; tr_item(KIN(21) + (size_t)l * FF * D, D, D, (bf16*)(wl + OW_D2), FF, 64 * kb, 32 * nb, 32 * nb, scr, lane); }
}
__device__ __forceinline__ void row_to_bf16(const float* xrow, bf16* orow, int lane) {
    const f32x4* xr = (const f32x4*)xrow + lane; u32x2* o8 = (u32x2*)orow + lane;
#pragma unroll
    for (int j = 0; j < 4; ++j) { const f32x4 v = xr[64 * j]; u32x2 w; w.x = pkbf(v[0], v[1]); w.y = pkbf(v[2], v[3]); o8[64 * j] = w; }
}
__device__ __forceinline__ void ln_row(float* xrow, bf16* orow, const float* g, const float* b, int lane) {
    f32x4* xr = (f32x4*)xrow + lane; f32x4 v[4]; float s = 0.f;
#pragma unroll
    for (int j = 0; j < 4; ++j) { v[j] = xr[64 * j]; s += (v[j][0] + v[j][1]) + (v[j][2] + v[j][3]); }
    const float mean = wave_sum(s) * (1.f / D); float s2 = 0.f;
#pragma unroll
    for (int j = 0; j < 4; ++j) { v[j] = v[j] - mean; s2 += (v[j][0] * v[j][0] + v[j][1] * v[j][1]) + (v[j][2] * v[j][2] + v[j][3] * v[j][3]); }
    const float rstd = 1.f / sqrtf(wave_sum(s2) * (1.f / D) + LN_EPS);
    u32x2* o8 = (u32x2*)orow + lane;
#pragma unroll
    for (int j = 0; j < 4; ++j) { const f32x4 gv = ((const f32x4*)g)[lane + 64 * j], bv = ((const f32x4*)b)[lane + 64 * j];
        const f32x4 o = v[j] * rstd * gv + bv; xr[64 * j] = o; u32x2 w; w.x = pkbf(o[0], o[1]); w.y = pkbf(o[2], o[3]); o8[64 * j] = w; }
}

__device__ __forceinline__ void ln_row_bf(bf16* xrow, float* fout, const float* g, const float* b, int lane) {
    u32x4* xr = (u32x4*)xrow + lane; float v[16]; float s = 0.f;
#pragma unroll
    for (int j = 0; j < 2; ++j) { const u32x4 t = xr[64 * j]; v[8 * j] = bf_lo(t.x); v[8 * j + 1] = bf_hi(t.x); v[8 * j + 2] = bf_lo(t.y); v[8 * j + 3] = bf_hi(t.y); v[8 * j + 4] = bf_lo(t.z); v[8 * j + 5] = bf_hi(t.z); v[8 * j + 6] = bf_lo(t.w); v[8 * j + 7] = bf_hi(t.w); }
#pragma unroll
    for (int e = 0; e < 16; ++e) s += v[e];
    const float mean = wave_sum(s) * (1.f / D); float s2 = 0.f;
#pragma unroll
    for (int e = 0; e < 16; ++e) { v[e] -= mean; s2 += v[e] * v[e]; }
    const float rstd = 1.f / sqrtf(wave_sum(s2) * (1.f / D) + LN_EPS);
#pragma unroll
    for (int j = 0; j < 2; ++j) { const int c = 512 * j + 8 * lane; const f32x4 g0 = *(const f32x4*)(g + c), g1 = *(const f32x4*)(g + c + 4), b0 = *(const f32x4*)(b + c), b1 = *(const f32x4*)(b + c + 4);
        const f32x4 o0 = {v[8 * j] * rstd * g0[0] + b0[0], v[8 * j + 1] * rstd * g0[1] + b0[1], v[8 * j + 2] * rstd * g0[2] + b0[2], v[8 * j + 3] * rstd * g0[3] + b0[3]};
        const f32x4 o1 = {v[8 * j + 4] * rstd * g1[0] + b1[0], v[8 * j + 5] * rstd * g1[1] + b1[1], v[8 * j + 6] * rstd * g1[2] + b1[2], v[8 * j + 7] * rstd * g1[3] + b1[3]};
        if (fout) { *(f32x4*)(fout + c) = o0; *(f32x4*)(fout + c + 4) = o1; }
        else { u32x4 w; w.x = pkbf(o0[0], o0[1]); w.y = pkbf(o0[2], o0[3]); w.z = pkbf(o1[0], o1[1]); w.w = pkbf(o1[2], o1[3]); xr[64 * j] = w; } }
}

__device__ __forceinline__ void seq_of_row(int m, int& s0, int& T) { if (m < MPROMPT) { s0 = m & ~2047; T = 2048; } else { s0 = MPROMPT + ((m - MPROMPT) & ~4095); T = 4096; } }
__device__ __forceinline__ void conv8(const bf16* raw, int m, int tl, int T, int c0, const float* cw, const float* cb, float (&o)[8]) {
    const f32x4 b0 = *(const f32x4*)(cb + c0), b1 = *(const f32x4*)(cb + c0 + 4);
    float a[8] = {b0[0], b0[1], b0[2], b0[3], b1[0], b1[1], b1[2], b1[3]};
#pragma unroll
    for (int j = 0; j < 5; ++j) { const int tt = tl + j - 2;
        if (tt >= 0 && tt < T) { const u32x4 v = *(const u32x4*)(raw + (size_t)(m + j - 2) * 1024 + c0);
            const f32x4 w0 = *(const f32x4*)(cw + j * 1024 + c0), w1 = *(const f32x4*)(cw + j * 1024 + c0 + 4);
            a[0] += bf_lo(v.x) * w0[0]; a[1] += bf_hi(v.x) * w0[1]; a[2] += bf_lo(v.y) * w0[2]; a[3] += bf_hi(v.y) * w0[3];
            a[4] += bf_lo(v.z) * w1[0]; a[5] += bf_hi(v.z) * w1[1]; a[6] += bf_lo(v.w) * w1[2]; a[7] += bf_hi(v.w) * w1[3]; } }
#pragma unroll
    for (int e = 0; e < 8; ++e) o[e] = silu_f(a[e]);
}
__device__ __forceinline__ float softplus_f(float x) { return x > 20.f ? x : log1pf(expf(x)); }

constexpr int SCAN_DIR_F = 10368;
__device__ __forceinline__ void scan_naive_unit(int b, int h, const bf16* raw, const float* DT, float* Y, const float* cw, const float* cb, const float* dt_bias, const float* a_log, const float* d_skip, LAS float* L, int tid, int wave, int lane) {
    int s0, T; if (b < 32) { s0 = b * 2048; T = 2048; } else { s0 = MPROMPT + (b - 32) * 4096; T = 4096; }
    const int g = h >> 2, dir = wave >> 2, pb = wave & 3, p = pb * 16 + (lane & 15), nq = lane >> 4;
    const float a = -expf(a_log[dir * 8 + h]), dskip = d_skip[h], dtb = dt_bias[dir * 8 + h];
    float s[32];
#pragma unroll
    for (int k = 0; k < 32; ++k) s[k] = 0.f;
    LAS float* Lw = L + dir * SCAN_DIR_F;
    const int nblk = T >> 5;
    for (int blk = 0; blk < nblk; ++blk) {
        __syncthreads();
        const int tbase = dir == 0 ? 32 * blk : T - 32 * (blk + 1);
        { const int r_ = tid & 255, tok = r_ >> 3, part = r_ & 7, tl = tbase + tok, m = s0 + tl; float o[8];
          conv8(raw, m, tl, T, 512 + 128 * g + 16 * part, cw, cb, o);
#pragma unroll
          for (int e = 0; e < 8; ++e) Lw[tok * 128 + 16 * part + e] = o[e];
          conv8(raw, m, tl, T, 512 + 128 * g + 16 * part + 8, cw, cb, o);
#pragma unroll
          for (int e = 0; e < 8; ++e) Lw[tok * 128 + 16 * part + 8 + e] = o[e];
          conv8(raw, m, tl, T, 768 + 128 * g + 16 * part, cw, cb, o);
#pragma unroll
          for (int e = 0; e < 8; ++e) Lw[4096 + tok * 128 + 16 * part + e] = o[e];
          conv8(raw, m, tl, T, 768 + 128 * g + 16 * part + 8, cw, cb, o);
#pragma unroll
          for (int e = 0; e < 8; ++e) Lw[4096 + tok * 128 + 16 * part + 8 + e] = o[e];
          conv8(raw, m, tl, T, h * 64 + 8 * part, cw, cb, o);
#pragma unroll
          for (int e = 0; e < 8; ++e) Lw[8192 + tok * 64 + 8 * part + e] = o[e];
          if (part == 0) { const float dtv = softplus_f(DT[(size_t)m * 16 + dir * 8 + h] + dtb); Lw[10240 + tok] = dtv; Lw[10272 + tok] = expf(dtv * a); }
        }
        __syncthreads();
        for (int i = 0; i < 32; ++i) {
            const int ti = dir == 0 ? i : 31 - i;
            const float d = Lw[10272 + ti], dtv = Lw[10240 + ti], xv = Lw[8192 + ti * 64 + p], xdt = xv * dtv;
            float y = 0.f;
#pragma unroll
            for (int k4 = 0; k4 < 8; ++k4) { const f32x4 bv = *(const LAS f32x4*)(Lw + ti * 128 + 32 * nq + 4 * k4), cv = *(const LAS f32x4*)(Lw + 4096 + ti * 128 + 32 * nq + 4 * k4);
#pragma unroll
                for (int e = 0; e < 4; ++e) { s[4 * k4 + e] = s[4 * k4 + e] * d + xdt * bv[e]; y += s[4 * k4 + e] * cv[e]; } }
            y += __shfl_xor(y, 16); y += __shfl_xor(y, 32);
            if (nq == 0) atomicAdd(Y + (size_t)(s0 + tbase + ti) * 512 + h * 64 + p, y + (dir == 0 ? dskip * xv : 0.f));
        }
    }
}

__device__ __forceinline__ void attn_naive_unit(int m, int wave, int lane, const bf16* QKV, const float* rpb, const float* gattn, bf16* MIX, LAS float* Ps, volatile LAS float* exch, int parity) {
    const int h = wave; int s0, T; seq_of_row(m, s0, T);
    const int tl = m - s0, r = tl >> 6, qc = tl & 63, rows = T >> 6;
    const int cstart = min(max(qc - 8, 0), 48), rs = min(max(r - 4, 0), rows - 8);
    float q[64];
    { const bf16* qp = QKV + (size_t)m * 1536 + h * 64;
#pragma unroll
      for (int i = 0; i < 8; ++i) { const u32x4 v = *(const u32x4*)(qp + 8 * i); q[8 * i] = bf_lo(v.x); q[8 * i + 1] = bf_hi(v.x); q[8 * i + 2] = bf_lo(v.y); q[8 * i + 3] = bf_hi(v.y);
          q[8 * i + 4] = bf_lo(v.z); q[8 * i + 5] = bf_hi(v.z); q[8 * i + 6] = bf_lo(v.w); q[8 * i + 7] = bf_hi(v.w); } }
    float sc[2];
#pragma unroll
    for (int k2 = 0; k2 < 2; ++k2) { const int kk = lane + 64 * k2, kri = kk >> 4, kci = kk & 15; const int kt = s0 + (rs + kri) * 64 + cstart + kci;
        const bf16* kp = QKV + (size_t)kt * 1536 + 512 + h * 64; float d = 0.f;
#pragma unroll
        for (int i = 0; i < 8; ++i) { const u32x4 v = *(const u32x4*)(kp + 8 * i);
            d += q[8 * i] * bf_lo(v.x) + q[8 * i + 1] * bf_hi(v.x) + q[8 * i + 2] * bf_lo(v.y) + q[8 * i + 3] * bf_hi(v.y) + q[8 * i + 4] * bf_lo(v.z) + q[8 * i + 5] * bf_hi(v.z) + q[8 * i + 6] * bf_lo(v.w) + q[8 * i + 7] * bf_hi(v.w); }
        sc[k2] = d + rpb[h * 465 + (rs + kri - r + 7) * 31 + (cstart + kci - qc + 15)]; }
    const float mx = wave_max(fmaxf(sc[0], sc[1]));
    const float p0 = __expf(sc[0] - mx), p1 = __expf(sc[1] - mx);
    const float inv = 1.f / wave_sum(p0 + p1);
    Ps[lane] = p0 * inv; Ps[lane + 64] = p1 * inv;
    LDS_WAIT(); asm volatile("" ::: "memory");
    float o = 0.f; const bf16* vbase = QKV + 1024 + h * 64 + lane;
#pragma unroll 4
    for (int kk = 0; kk < 128; kk += 4) { const f32x4 pv = *(const LAS f32x4*)(Ps + kk); const int kt = s0 + (rs + (kk >> 4)) * 64 + cstart + (kk & 15);
#pragma unroll
        for (int e = 0; e < 4; ++e) o += pv[e] * bf2f(vbase[(size_t)(kt + e) * 1536]); }
    const float ssq = wave_sum(o * o);
    if (lane == 0) exch[parity * 8 + h] = ssq;
    __syncthreads();
    float tot = 0.f;
#pragma unroll
    for (int i = 0; i < 8; ++i) tot += exch[parity * 8 + i];
    const float scl = 1.f / sqrtf(tot * (1.f / 512.f) + RMS_EPS);
    MIX[(size_t)m * 1024 + h * 64 + lane] = f2bf(o * scl * gattn[h * 64 + lane]);
}


typedef short bf16x8v __attribute__((ext_vector_type(8)));
typedef short s16x4v __attribute__((ext_vector_type(4)));
#define MFMA16(a, b, c) __builtin_amdgcn_mfma_f32_16x16x32_bf16((a), (b), (c), 0, 0, 0)
constexpr int VPITCH = 144, VHEAD = 512 * VPITCH;
__device__ __forceinline__ void attn_fast_unit(int u, const bf16* QKV, const float* TB  , const float* gattn, bf16* MIX, float* SSQA, LAS unsigned char* lds, int tid, int wave, int lane) {
    const int hp = u / 1280, gr = u % 1280;
    int s0, rows, r;
    if (gr < 1024) { s0 = (gr >> 5) * 2048; r = gr & 31; rows = 32; } else { const int g2 = gr - 1024; s0 = MPROMPT + (g2 >> 6) * 4096; r = g2 & 63; rows = 64; }
    const int rs = min(max(r - 4, 0), rows - 8);
    __syncthreads();
    { u32x4 v[16];
#pragma unroll
      for (int i = 0; i < 16; ++i) { const int id = i * 512 + tid, c = id & 7, key = (id >> 3) & 511, hh = id >> 12;
          v[i] = *(const u32x4*)(QKV + (size_t)(s0 + rs * 64 + key) * 1536 + 1024 + (2 * hp + hh) * 64 + 8 * c); }
#pragma unroll
      for (int i = 0; i < 16; ++i) { const int id = i * 512 + tid, c = id & 7, key = (id >> 3) & 511, hh = id >> 12;
          *(LAS u32x4*)(lds + hh * VHEAD + key * VPITCH + 16 * c) = v[i]; } }
    __syncthreads();
    const int hh = wave >> 2, j = wave & 3, h = 2 * hp + hh, fr = lane & 15, fq = lane >> 4;
    const int kstart = j == 0 ? 0 : (j == 1 ? 8 : (j == 2 ? 24 : 32));
    const int qtok = s0 + r * 64 + 16 * j + fr;
    const bf16x8v q0 = *(const bf16x8v*)(QKV + (size_t)qtok * 1536 + h * 64 + 8 * fq), q1 = *(const bf16x8v*)(QKV + (size_t)qtok * 1536 + h * 64 + 32 + 8 * fq);
    f32x4 sacc[16];
    const float* tb = TB + (size_t)((h * 4 + j) * 15 + (rs - r + 7)) * 512 + fr * 32 + 4 * fq;
#pragma unroll
    for (int kt = 0; kt < 16; ++kt) { const int kri = kt >> 1; const size_t ktok = (size_t)(s0 + (rs + kri) * 64 + kstart + 16 * (kt & 1) + fr);
        const bf16x8v k0 = *(const bf16x8v*)(QKV + ktok * 1536 + 512 + h * 64 + 8 * fq), k1 = *(const bf16x8v*)(QKV + ktok * 1536 + 512 + h * 64 + 32 + 8 * fq);
        f32x4 a = {0.f, 0.f, 0.f, 0.f}; a = MFMA16(k0, q0, a); a = MFMA16(k1, q1, a);
        sacc[kt] = a + *(const f32x4*)(tb + kri * 512 + 16 * (kt & 1)); }
    float mx = -INFINITY;
#pragma unroll
    for (int kt = 0; kt < 16; ++kt) mx = fmaxf(mx, fmaxf(fmaxf(sacc[kt][0], sacc[kt][1]), fmaxf(sacc[kt][2], sacc[kt][3])));
    mx = fmaxf(mx, __shfl_xor(mx, 16)); mx = fmaxf(mx, __shfl_xor(mx, 32));
    float l = 0.f;
#pragma unroll
    for (int kt = 0; kt < 16; ++kt) {
#pragma unroll
        for (int i = 0; i < 4; ++i) { const float pz = __builtin_amdgcn_exp2f(sacc[kt][i] - mx); sacc[kt][i] = pz; l += pz; } }
    l += __shfl_xor(l, 16); l += __shfl_xor(l, 32);
    f32x4 o[4];
#pragma unroll
    for (int dt = 0; dt < 4; ++dt) o[dt] = (f32x4){0.f, 0.f, 0.f, 0.f};
    const LAS unsigned char* vb = lds + hh * VHEAD + (kstart + 4 * fq + ((lane & 15) >> 2)) * VPITCH + 8 * (lane & 3);
#pragma unroll
    for (int ks = 0; ks < 8; ++ks) {
        u32x4 pw; pw.x = pkbf(sacc[2 * ks][0], sacc[2 * ks][1]); pw.y = pkbf(sacc[2 * ks][2], sacc[2 * ks][3]); pw.z = pkbf(sacc[2 * ks + 1][0], sacc[2 * ks + 1][1]); pw.w = pkbf(sacc[2 * ks + 1][2], sacc[2 * ks + 1][3]);
        const bf16x8v pf = __builtin_bit_cast(bf16x8v, pw);
#pragma unroll
        for (int dt = 0; dt < 4; ++dt) {
            const s16x4v lo = __builtin_amdgcn_ds_read_tr16_b64_v4i16((LAS s16x4v*)(vb + ks * 64 * VPITCH + 32 * dt));
            const s16x4v hi = __builtin_amdgcn_ds_read_tr16_b64_v4i16((LAS s16x4v*)(vb + (ks * 64 + 16) * VPITCH + 32 * dt));
            const bf16x8v vf = __builtin_shufflevector(lo, hi, 0, 1, 2, 3, 4, 5, 6, 7);
            o[dt] = MFMA16(vf, pf, o[dt]); } }
    const float inv = 1.f / l; float ssq = 0.f;
#pragma unroll
    for (int dt = 0; dt < 4; ++dt) { o[dt] = o[dt] * inv; ssq += (o[dt][0] * o[dt][0] + o[dt][1] * o[dt][1]) + (o[dt][2] * o[dt][2] + o[dt][3] * o[dt][3]); }
    ssq += __shfl_xor(ssq, 16); ssq += __shfl_xor(ssq, 32);
    if (fq == 0) atomicAdd(SSQA + qtok, ssq);
#pragma unroll
    for (int dt = 0; dt < 4; ++dt) { const f32x4 gv = *(const f32x4*)(gattn + h * 64 + 16 * dt + 4 * fq); const f32x4 ov = o[dt] * gv;
        u32x2 w; w.x = pkbf(ov[0], ov[1]); w.y = pkbf(ov[2], ov[3]); *(u32x2*)(MIX + (size_t)qtok * 1024 + h * 64 + 16 * dt + 4 * fq) = w; }
}

typedef float f32x16 __attribute__((ext_vector_type(16)));
#define MFMA32(a, b, c) __builtin_amdgcn_mfma_f32_32x32x16_bf16((a), (b), (c), 0, 0, 0)
constexpr float LOG2E = 1.4426950408889634f;
constexpr int TPITCH = 272;
__device__ __forceinline__ void conv_item(int it, const bf16* RAW, const float* DTraw, const float* cw, const float* cb, const float* dt_bias, const float* a_log,
                                          bf16* XT, bf16* BT, bf16* BTOK, bf16* CTOK, float* CUM, float* DTA, float* WST, LAS unsigned char* lds, int tid, int wave, int lane) {
    const int ck = it >> 3, sl = it & 7, m0 = ck * 128; int s0, T; seq_of_row(m0, s0, T); const int tl0 = m0 - s0;
    const int cg = tid & 15, tg = tid >> 4, c0 = 128 * sl + 8 * cg;
    float x[8][8];
#pragma unroll
    for (int i = 0; i < 8; ++i) { const int tt = tl0 + 4 * tg - 2 + i; u32x4 v = {0u, 0u, 0u, 0u};
        if (tt >= 0 && tt < T) v = *(const u32x4*)(RAW + (size_t)(s0 + tt) * 1024 + c0);
        x[i][0] = bf_lo(v.x); x[i][1] = bf_hi(v.x); x[i][2] = bf_lo(v.y); x[i][3] = bf_hi(v.y); x[i][4] = bf_lo(v.z); x[i][5] = bf_hi(v.z); x[i][6] = bf_lo(v.w); x[i][7] = bf_hi(v.w); }
    float o[4][8];
    { const f32x4 b0 = *(const f32x4*)(cb + c0), b1 = *(const f32x4*)(cb + c0 + 4);
#pragma unroll
      for (int tk = 0; tk < 4; ++tk) { o[tk][0] = b0[0]; o[tk][1] = b0[1]; o[tk][2] = b0[2]; o[tk][3] = b0[3]; o[tk][4] = b1[0]; o[tk][5] = b1[1]; o[tk][6] = b1[2]; o[tk][7] = b1[3]; }
#pragma unroll
      for (int j = 0; j < 5; ++j) { const f32x4 w0 = *(const f32x4*)(cw + j * 1024 + c0), w1 = *(const f32x4*)(cw + j * 1024 + c0 + 4);
#pragma unroll
          for (int tk = 0; tk < 4; ++tk) { o[tk][0] += x[tk + j][0] * w0[0]; o[tk][1] += x[tk + j][1] * w0[1]; o[tk][2] += x[tk + j][2] * w0[2]; o[tk][3] += x[tk + j][3] * w0[3];
              o[tk][4] += x[tk + j][4] * w1[0]; o[tk][5] += x[tk + j][5] * w1[1]; o[tk][6] += x[tk + j][6] * w1[2]; o[tk][7] += x[tk + j][7] * w1[3]; } }
#pragma unroll
      for (int tk = 0; tk < 4; ++tk)
#pragma unroll
          for (int e = 0; e < 8; ++e) o[tk][e] = silu_f(o[tk][e]); }
    __syncthreads();
    if (sl >= 4) { bf16* dst = (sl < 6 ? BTOK : CTOK) + (size_t)(m0 + 4 * tg) * 256 + 128 * (sl & 1) + 8 * cg;
#pragma unroll
        for (int tk = 0; tk < 4; ++tk) { u32x4 w; w.x = pkbf(o[tk][0], o[tk][1]); w.y = pkbf(o[tk][2], o[tk][3]); w.z = pkbf(o[tk][4], o[tk][5]); w.w = pkbf(o[tk][6], o[tk][7]); *(u32x4*)(dst + (size_t)tk * 256) = w; } }
    if (sl < 6) {
#pragma unroll
        for (int e = 0; e < 8; ++e) { u32x2 w; w.x = pkbf(o[0][e], o[1][e]); w.y = pkbf(o[2][e], o[3][e]); *(LAS u32x2*)(lds + (8 * cg + e) * TPITCH + 8 * tg) = w; }
        __syncthreads();
        bf16* dbase = sl < 4 ? XT + ((size_t)ck * 16 + 4 * sl) * 4096 : BT + ((size_t)ck * 8 + 4 * (sl - 4)) * 4096;
#pragma unroll
        for (int i = 0; i < 4; ++i) { const int r_ = tid & 31, pc = (tid >> 5) & 15;
            *(u32x4*)(dbase + (size_t)i * 4096 + (pc * 32 + r_) * 8) = *(const LAS u32x4*)(lds + (32 * i + r_) * TPITCH + 16 * pc); }
    }
    if (sl == 0) {
#pragma unroll
        for (int q = 0; q < 2; ++q) { const int sr = 2 * wave + q, dir = sr >> 3;
            const float a = -expf(a_log[sr]) * LOG2E, bias = dt_bias[sr];
            const float dt0 = softplus_f(DTraw[(size_t)(m0 + 2 * lane) * 16 + sr] + bias), dt1 = softplus_f(DTraw[(size_t)(m0 + 2 * lane + 1) * 16 + sr] + bias);
            const float v0 = dt0 * a, v1 = dt1 * a; float inc = v0 + v1;
#pragma unroll
            for (int ofs = 1; ofs < 64; ofs <<= 1) { const float t = __shfl_up(inc, ofs); if (lane >= ofs) inc += t; }
            const float excl = inc - (v0 + v1), total = __shfl(inc, 63);
            float c0_, c1_;
            if (dir == 0) { c0_ = excl + v0; c1_ = inc; } else { c0_ = total - excl; c1_ = total - excl - v0; }
            const float tot = total;
            const size_t off = ((size_t)ck * 16 + sr) * 128 + 2 * lane;
            *(pg8::f32x2e*)(CUM + off) = (pg8::f32x2e){c0_, c1_}; *(pg8::f32x2e*)(DTA + off) = (pg8::f32x2e){dt0, dt1};
            ((unsigned*)WST)[off >> 1] = pkbf(__builtin_amdgcn_exp2f(tot - c0_) * dt0, __builtin_amdgcn_exp2f(tot - c1_) * dt1); }
    }
}
__device__ __forceinline__ void s12_unit(int u, const bf16* XT, const bf16* BT, const float* CUM, const bf16* WSTb, bf16* PREV, int nt, int lane) {
    int b, h, dir, c0, nc;
    if (u < 64) { b = u >> 4; h = (u & 15) >> 1; dir = u & 1; c0 = 512 + b * 32; nc = 32; } else { const int v = u - 64; b = v >> 4; h = (v & 15) >> 1; dir = v & 1; c0 = b * 16; nc = 16; }
    const int g = h >> 2, sr = dir * 8 + h, r = lane & 31, hh = lane >> 5;
    f32x16 prev[2];
#pragma unroll
    for (int pt = 0; pt < 2; ++pt)
#pragma unroll
        for (int i = 0; i < 16; ++i) prev[pt][i] = 0.f;
    for (int ci = 0; ci < nc; ++ci) { const int ck = dir == 0 ? c0 + ci : c0 + nc - 1 - ci;
        const bf16* bp = BT + ((size_t)ck * 8 + 4 * g + nt) * 4096 + (hh * 32 + r) * 8;
        const bf16* xp = XT + ((size_t)ck * 16 + 2 * h) * 4096 + (hh * 32 + r) * 8;
        const bf16* wp = WSTb + ((size_t)ck * 16 + sr) * 128 + 8 * hh;
        bf16x8v bf[8]; u32x4 xr[2][8], wv[8];
#pragma unroll
        for (int kk = 0; kk < 8; ++kk) { bf[kk] = *(const bf16x8v*)(bp + kk * 512); xr[0][kk] = *(const u32x4*)(xp + kk * 512); xr[1][kk] = *(const u32x4*)(xp + 4096 + kk * 512); wv[kk] = *(const u32x4*)(wp + 16 * kk); }
        const float cd = __builtin_amdgcn_exp2f(CUM[((size_t)ck * 16 + sr) * 128 + (dir == 0 ? 127 : 0)]);
#pragma unroll
        for (int pt = 0; pt < 2; ++pt) {
            bf16* pp = PREV + (((size_t)ck * 8 + h) * 2 + dir) * 8192 + pt * 4096 + r * 8 + 4 * hh;
#pragma unroll
            for (int q = 0; q < 4; ++q) { u32x2 w; w.x = pkbf(prev[pt][4 * q], prev[pt][4 * q + 1]); w.y = pkbf(prev[pt][4 * q + 2], prev[pt][4 * q + 3]);
                *(u32x2*)(pp + ((2 * nt + (q >> 1)) * 2 + (q & 1)) * 256) = w; }
            f32x16 st;
#pragma unroll
            for (int i = 0; i < 16; ++i) st[i] = 0.f;
#pragma unroll
            for (int kk = 0; kk < 8; ++kk) { const u32x4 x_ = xr[pt][kk], w_ = wv[kk];
                u32x4 xw; xw.x = pkbf(bf_lo(x_.x) * bf_lo(w_.x), bf_hi(x_.x) * bf_hi(w_.x)); xw.y = pkbf(bf_lo(x_.y) * bf_lo(w_.y), bf_hi(x_.y) * bf_hi(w_.y));
                xw.z = pkbf(bf_lo(x_.z) * bf_lo(w_.z), bf_hi(x_.z) * bf_hi(w_.z)); xw.w = pkbf(bf_lo(x_.w) * bf_lo(w_.w), bf_hi(x_.w) * bf_hi(w_.w));
                st = MFMA32(bf[kk], __builtin_bit_cast(bf16x8v, xw), st); }
            prev[pt] = prev[pt] * cd + st; }
    }
}
constexpr int S3_BM = 0, S3_CM = 34816, S3_XT = 69632, S3_CUM = 139264, S3_DT = 143360;
__device__ __forceinline__ void s3_unit(int u, const bf16* XT, const bf16* BTOK, const bf16* CTOK, const float* CUM, const float* DTA, const bf16* PREV, const bf16* Zb, const float* d_skip, const float* gssm,
                                        bf16* MIX, float* SSQS, LAS unsigned char* lds, int tid, int wave, int lane_) {
    int lane = lane_; asm volatile("" : "+v"(lane));
    const int ck = u >> 1, g = u & 1, m0 = ck * 128;
    __syncthreads();
    { asm volatile("" : "+v"(tid));
      u32x4 vb[4], vc[4], vx[8];
#pragma unroll
      for (int i = 0; i < 4; ++i) { const int id = i * 512 + tid, row = id >> 4, pc = id & 15; vb[i] = *(const u32x4*)(BTOK + (size_t)(m0 + row) * 256 + 128 * g + 8 * pc); vc[i] = *(const u32x4*)(CTOK + (size_t)(m0 + row) * 256 + 128 * g + 8 * pc); }
#pragma unroll
      for (int i = 0; i < 8; ++i) { const int r_ = tid & 31, pc = (tid >> 5) & 15; vx[i] = *(const u32x4*)(XT + ((size_t)ck * 16 + 8 * g + i) * 4096 + (pc * 32 + r_) * 8); }
      const int a4 = tid & 255, hl_ = a4 >> 6, dr_ = (a4 >> 5) & 1, e4 = a4 & 31;
      const f32x4 vs = *(const f32x4*)((tid < 256 ? CUM : DTA) + ((size_t)ck * 16 + dr_ * 8 + 4 * g + hl_) * 128 + 4 * e4);
#pragma unroll
      for (int i = 0; i < 4; ++i) { const int id = i * 512 + tid, row = id >> 4, pc = id & 15; *(LAS u32x4*)(lds + S3_BM + row * TPITCH + 16 * pc) = vb[i]; *(LAS u32x4*)(lds + S3_CM + row * TPITCH + 16 * pc) = vc[i]; }
#pragma unroll
      for (int i = 0; i < 8; ++i) { const int r_ = tid & 31, pc = (tid >> 5) & 15; *(LAS u32x4*)(lds + S3_XT + (32 * i + r_) * TPITCH + 16 * pc) = vx[i]; }
      *(LAS f32x4*)(lds + (tid < 256 ? S3_CUM : S3_DT) + ((hl_ * 2 + dr_) * 128 + 4 * e4) * 4) = vs; }
    __syncthreads();
    const int hl = wave >> 1, half = wave & 1, h = 4 * g + hl, r = lane & 31, hh = lane >> 5;
    const float dskip = d_skip[h];
    const LAS float* cumf = (const LAS float*)(lds + S3_CUM) + (hl * 2) * 128; const LAS float* cumb = cumf + 128;
    const LAS float* dtf = (const LAS float*)(lds + S3_DT) + (hl * 2) * 128; const LAS float* dtb = dtf + 128;
    for (int lbi = 0; lbi < 2; ++lbi) { const int lb = 2 * half + lbi, l = 32 * lb + r;
        const float Af_l = cumf[l], Sb_l = cumb[l];
        const size_t mrow = (size_t)(m0 + l);
        bf16x8v pf0[2][8], pf1[2][8]; u32x2 zq[2][4];
#pragma unroll
        for (int pb = 0; pb < 2; ++pb) { const bf16* pp = PREV + (((size_t)ck * 8 + h) * 2 + 0) * 8192 + pb * 4096 + (hh * 32 + r) * 8;
#pragma unroll
            for (int kk = 0; kk < 8; ++kk) pf0[pb][kk] = *(const bf16x8v*)(pp + kk * 512); }
#pragma unroll
        for (int pb = 0; pb < 2; ++pb)
#pragma unroll
            for (int q = 0; q < 4; ++q) zq[pb][q] = *(const u32x2*)(Zb + mrow * 512 + h * 64 + 32 * pb + 8 * q + 4 * hh);
        bf16x8v cf[8];
#pragma unroll
        for (int kk = 0; kk < 8; ++kk) cf[kk] = *(const LAS bf16x8v*)(lds + S3_CM + l * TPITCH + 32 * kk + 16 * hh);
        f32x16 yacc[2];
#pragma unroll
        for (int pb = 0; pb < 2; ++pb)
#pragma unroll
            for (int i = 0; i < 16; ++i) yacc[pb][i] = 0.f;
#pragma unroll 1
        for (int sb = 0; sb < 4; ++sb) {
            f32x16 cbt;
#pragma unroll
            for (int i = 0; i < 16; ++i) cbt[i] = 0.f;
#pragma unroll
            for (int kk = 0; kk < 8; ++kk) { const bf16x8v bmf = *(const LAS bf16x8v*)(lds + S3_BM + (32 * sb + r) * TPITCH + 32 * kk + 16 * hh); cbt = MFMA32(bmf, cf[kk], cbt); }
#pragma unroll
            for (int q = 0; q < 4; ++q) { const int sbase = 32 * sb + 8 * q + 4 * hh;
                const f32x4 af = *(const LAS f32x4*)(cumf + sbase), sbv = *(const LAS f32x4*)(cumb + sbase), df = *(const LAS f32x4*)(dtf + sbase), db = *(const LAS f32x4*)(dtb + sbase);
#pragma unroll
                for (int e = 0; e < 4; ++e) { const int sidx = sbase + e;
                    const float fw = sidx <= l ? __builtin_amdgcn_exp2f(Af_l - af[e]) * df[e] : 0.f;
                    const float bw = sidx >= l ? __builtin_amdgcn_exp2f(Sb_l - sbv[e]) * db[e] : 0.f;
                    cbt[4 * q + e] = cbt[4 * q + e] * (fw + bw) + (sidx == l ? dskip : 0.f); } }
#pragma unroll
            for (int ks = 0; ks < 2; ++ks) {
                u32x4 gw_; gw_.x = pkbf(cbt[8 * ks], cbt[8 * ks + 1]); gw_.y = pkbf(cbt[8 * ks + 2], cbt[8 * ks + 3]); gw_.z = pkbf(cbt[8 * ks + 4], cbt[8 * ks + 5]); gw_.w = pkbf(cbt[8 * ks + 6], cbt[8 * ks + 7]);
                const bf16x8v gf = __builtin_bit_cast(bf16x8v, gw_);
#pragma unroll
                for (int pb = 0; pb < 2; ++pb) { const LAS unsigned char* xa = lds + S3_XT + (64 * hl + 32 * pb + r) * TPITCH + 2 * (32 * sb + 16 * ks + 4 * hh);
                    const s16x4v lo = *(const LAS s16x4v*)xa, hi = *(const LAS s16x4v*)(xa + 16);
                    yacc[pb] = MFMA32(__builtin_shufflevector(lo, hi, 0, 1, 2, 3, 4, 5, 6, 7), gf, yacc[pb]); } }
        }
#pragma unroll
        for (int pb = 0; pb < 2; ++pb) { const bf16* pp = PREV + (((size_t)ck * 8 + h) * 2 + 1) * 8192 + pb * 4096 + (hh * 32 + r) * 8;
#pragma unroll
            for (int kk = 0; kk < 8; ++kk) pf1[pb][kk] = *(const bf16x8v*)(pp + kk * 512); }
#pragma unroll
        for (int dir = 0; dir < 2; ++dir) { const float el = __builtin_amdgcn_exp2f(dir == 0 ? Af_l : Sb_l);
#pragma unroll
            for (int pb = 0; pb < 2; ++pb) { f32x16 ua;
#pragma unroll
                for (int i = 0; i < 16; ++i) ua[i] = 0.f;
#pragma unroll
                for (int kk = 0; kk < 8; ++kk) ua = MFMA32(dir == 0 ? pf0[pb][kk] : pf1[pb][kk], cf[kk], ua);
                yacc[pb] = yacc[pb] + ua * el; } }
        float ssq = 0.f;
#pragma unroll
        for (int pb = 0; pb < 2; ++pb)
#pragma unroll
            for (int q = 0; q < 4; ++q) { const int pc = h * 64 + 32 * pb + 8 * q + 4 * hh; const u32x2 zv = zq[pb][q]; const f32x4 gv = *(const f32x4*)(gssm + pc);
                const float v0 = yacc[pb][4 * q] * silu_f(bf_lo(zv.x)), v1 = yacc[pb][4 * q + 1] * silu_f(bf_hi(zv.x)), v2 = yacc[pb][4 * q + 2] * silu_f(bf_lo(zv.y)), v3 = yacc[pb][4 * q + 3] * silu_f(bf_hi(zv.y));
                ssq += (v0 * v0 + v1 * v1) + (v2 * v2 + v3 * v3);
                u32x2 w; w.x = pkbf(v0 * gv[0], v1 * gv[1]); w.y = pkbf(v2 * gv[2], v3 * gv[3]); *(u32x2*)(MIX + mrow * 1024 + 512 + pc) = w; }
        ssq += __shfl_xor(ssq, 32);
        if (hh == 0) atomicAdd(SSQS + mrow, ssq);
    }
}

__device__ __forceinline__ void gate_norm_row(int m, int lane, const float* Y, const bf16* Z, const float* g, bf16* MIX) {
    const f32x4 y0 = *(const f32x4*)(Y + (size_t)m * 512 + 8 * lane), y1 = *(const f32x4*)(Y + (size_t)m * 512 + 8 * lane + 4);
    const u32x4 zv = *(const u32x4*)(Z + (size_t)m * 512 + 8 * lane);
    float v[8] = {y0[0] * silu_f(bf_lo(zv.x)), y0[1] * silu_f(bf_hi(zv.x)), y0[2] * silu_f(bf_lo(zv.y)), y0[3] * silu_f(bf_hi(zv.y)),
                  y1[0] * silu_f(bf_lo(zv.z)), y1[1] * silu_f(bf_hi(zv.z)), y1[2] * silu_f(bf_lo(zv.w)), y1[3] * silu_f(bf_hi(zv.w))};
    float ss = 0.f;
#pragma unroll
    for (int e = 0; e < 8; ++e) ss += v[e] * v[e];
    const float scl = 1.f / sqrtf(wave_sum(ss) * (1.f / 512.f) + RMS_EPS);
    const f32x4 g0 = *(const f32x4*)(g + 8 * lane), g1 = *(const f32x4*)(g + 8 * lane + 4);
    u32x4 w; w.x = pkbf(v[0] * scl * g0[0], v[1] * scl * g0[1]); w.y = pkbf(v[2] * scl * g0[2], v[3] * scl * g0[3]);
    w.z = pkbf(v[4] * scl * g1[0], v[5] * scl * g1[1]); w.w = pkbf(v[6] * scl * g1[2], v[7] * scl * g1[3]);
    *(u32x4*)(MIX + (size_t)m * 1024 + 512 + 8 * lane) = w;
}

#define XB_TMO      128
#define XB_XCNT(j)  (256  + 64 * (j))
#define XB_XSUB(j)  (1280 + 64 * (j))
#define XB_XGEN(j)  (2304 + 64 * (j))
#define XB_TOP      3328
#define XB_TOPGEN   3392
#define XCD_BAR_WORDS 3456
#define XB_SPIN_CAP (1u << 18)

__device__ __forceinline__ unsigned xb_ld(unsigned* p)              { return __hip_atomic_load(p, __ATOMIC_RELAXED, __HIP_MEMORY_SCOPE_AGENT); }
__device__ __forceinline__ unsigned xb_add(unsigned* p, unsigned v) { return __hip_atomic_fetch_add(p, v, __ATOMIC_RELAXED, __HIP_MEMORY_SCOPE_AGENT); }
__device__ __forceinline__ unsigned xb_xcc_id() { return (unsigned)__builtin_amdgcn_s_getreg((3 << 11) | 20) & 0xFu; }
#define XB_SPIN(cond, bar) do { unsigned _sp = 0; while (cond) { __builtin_amdgcn_s_sleep(1); \
    if ((++_sp & 255u) == 0u) { if (xb_ld(&(bar)[XB_TMO])) break; if (_sp > XB_SPIN_CAP) { atomicAdd(&(bar)[XB_TMO], 1u); break; } } } } while (0)

struct XcdBarrier {
    unsigned* bar; unsigned x;
    volatile LAS unsigned* st;
};

__device__ __forceinline__ XcdBarrier xcd_barrier_post(unsigned* bar, volatile LAS unsigned* st) {
    XcdBarrier b; b.bar = bar; b.x = xb_xcc_id(); b.st = st;
    if (threadIdx.x == 0) (void)xb_add(&bar[XB_XCNT(b.x)], 1u);
    return b;
}
__device__ __forceinline__ void xcd_barrier_complete(unsigned* bar, unsigned x, unsigned& nloc, unsigned& nx) {
    const unsigned G = gridDim.x * gridDim.y * gridDim.z;
    unsigned sum, cnt, mine, sp = 0u;
    for (;;) {
        sum = 0u; cnt = 0u; mine = 0u;
#pragma unroll
        for (unsigned j = 0; j < 16; ++j) { const unsigned c = xb_ld(&bar[XB_XCNT(j)]); sum += c; cnt += (c > 0u) ? 1u : 0u; mine = (j == x) ? c : mine; }
        if (sum == G) break;
        __builtin_amdgcn_s_sleep(1);
        if ((++sp & 255u) == 0u) { if (xb_ld(&bar[XB_TMO])) break; if (sp > XB_SPIN_CAP) { atomicAdd(&bar[XB_TMO], 1u); break; } }
    }
    nloc = mine > 0u ? mine : 1u; nx = cnt > 0u ? cnt : 1u;
}

__device__ __forceinline__ void xcd_barrier(const XcdBarrier& b) {
    asm volatile("s_waitcnt vmcnt(0)" ::: "memory");
    __syncthreads();
    if (threadIdx.x == 0) {
        unsigned* bar = b.bar;
        __builtin_amdgcn_s_waitcnt(0);
        unsigned nloc = b.st[0], nx = b.st[1];
        if (nloc == 0u) { xcd_barrier_complete(bar, b.x, nloc, nx); b.st[0] = nloc; b.st[1] = nx; }
        const unsigned old = xb_add(&bar[XB_XSUB(b.x)], 1u);
        const unsigned gen = old / nloc;
        if (old + 1u == (gen + 1u) * nloc) {
            __builtin_amdgcn_fence(__ATOMIC_RELEASE, "agent");
            asm volatile("s_waitcnt vmcnt(0)" ::: "memory");
            const unsigned og = xb_add(&bar[XB_TOP], 1u);
            const unsigned tg = og / nx;
            if (og + 1u == (tg + 1u) * nx) xb_add(&bar[XB_TOPGEN], 1u);
            else XB_SPIN(xb_ld(&bar[XB_TOPGEN]) == tg, bar);
            __builtin_amdgcn_fence(__ATOMIC_ACQUIRE, "agent");
            xb_add(&bar[XB_XGEN(b.x)], 1u);
            asm volatile("s_waitcnt vmcnt(0)" ::: "memory");
        } else {
            XB_SPIN(xb_ld(&bar[XB_XGEN(b.x)]) == gen, bar);
            __builtin_amdgcn_fence(__ATOMIC_ACQUIRE, "agent");
            asm volatile("s_waitcnt vmcnt(0)" ::: "memory");
        }
    }
    __syncthreads();
}

#define FRESH_IDS() int tid = threadIdx.x; asm volatile("" : "+v"(tid)); int G = gridDim.x, bx = blockIdx.x; asm volatile("" : "+s"(G), "+s"(bx)); \
    const int lane = tid & 63, wave = __builtin_amdgcn_readfirstlane(tid >> 6), gw = bx * NWAVES + wave, NGW = G * NWAVES; (void)gw; (void)lane; (void)NGW; \
    unsigned char* ws = KWS(); float* out = KOUT(); (void)out; \
    bf16* XB = (bf16*)(ws + WS_XB); bf16* Hb = (bf16*)(ws + WS_H); bf16* QKV = (bf16*)(ws + WS_QKV); bf16* Zb = (bf16*)(ws + WS_Z); bf16* RAW = (bf16*)(ws + WS_RAW); \
    float* Yb = (float*)(ws + WS_Y); float* DTb = (float*)(ws + WS_DT); (void)XB; (void)Hb; (void)QKV; (void)Zb; (void)RAW; (void)Yb; (void)DTb
template <int l> __device__ __forceinline__ void layer_body(LAS unsigned char* lds, const XcdBarrier& xb) {
        { FRESH_IDS(); pg8::Gemm g{XB, (const bf16*)(ws + WS_W + (size_t)l * W_LAYER + OW_GU1), M, NGU, D}; pg8::StaticOrder S; S.init(M, NGU, (int)gridDim.x, (int)blockIdx.x); pg8::EpiSwiGLU E{Hb, FF};
          pg8::gemm_phase<pg8::EpiSwiGLU, pg8::StaticOrder, true, true>(lds, g, S, E); }
        xcd_barrier(xb);
        { FRESH_IDS(); pg8::Gemm g{Hb, (const bf16*)(ws + WS_W + (size_t)l * W_LAYER + OW_D1), M, D, FF}; pg8::StaticOrder S; S.init(M, D, (int)gridDim.x, (int)blockIdx.x);
          pg8::EpiResidBf E{XB, 0.5f};
          pg8::gemm_phase<pg8::EpiResidBf, pg8::StaticOrder, true, true>(lds, g, S, E); }
        xcd_barrier(xb);
        { FRESH_IDS(); const float* g_ = KIN(5) + l * D; const float* b_ = KIN(6) + l * D;
          for (int m = gw; m < M; m += NGW) ln_row_bf(XB + (size_t)m * D, nullptr, g_, b_, lane);
          const f32x4 z4 = {0.f, 0.f, 0.f, 0.f};
          f32x4* sz = (f32x4*)(ws + WS_SSQ); for (int i = bx * NT + tid; i < 2 * M / 4; i += G * NT) sz[i] = z4; }
        xcd_barrier(xb);
        { FRESH_IDS(); pg8::Gemm g{XB, (const bf16*)(ws + WS_W + (size_t)l * W_LAYER + OW_IN), M, NIN, D}; pg8::StaticOrder S; S.init(M, NIN, (int)gridDim.x, (int)blockIdx.x); pg8::EpiProj E{QKV, Zb, RAW, DTb};
          pg8::gemm_phase<pg8::EpiProj, pg8::StaticOrder, true, true>(lds, g, S, E); }
        xcd_barrier(xb);
#ifndef MIXREP
#define MIXREP 1
#endif
        for (int rep = 0; rep < MIXREP; ++rep) {
        if (rep > 0) { { FRESH_IDS(); const f32x4 z4 = {0.f, 0.f, 0.f, 0.f}; f32x4* sz = (f32x4*)(ws + WS_SSQ); for (int i = bx * NT + tid; i < 2 * M / 4; i += G * NT) sz[i] = z4; } xcd_barrier(xb); }
        { FRESH_IDS();
          for (int it = bx; it < 640 * 8; it += G)
              conv_item(it, RAW, DTb, KIN(8) + (size_t)l * 5 * 1024, KIN(9) + l * 1024, KIN(10) + l * 16, KIN(11) + l * 16, (bf16*)(ws + WS_XT), (bf16*)(ws + WS_BT), (bf16*)(ws + WS_BTOK), (bf16*)(ws + WS_CTOK),
                        (float*)(ws + WS_CUM), (float*)(ws + WS_DTA), (float*)(ws + WS_WST), lds, tid, wave, lane);
          { const int per = (5120 + G - 1) / G; const int u0 = bx * per, u1 = min(u0 + per, 5120);
            for (int u = u0; u < u1; ++u) attn_fast_unit(u, QKV, (const float*)(ws + WS_TB) + (size_t)l * 8 * 4 * 15 * 512, KIN(14) + l * 512, (bf16*)out, (float*)(ws + WS_SSQ), lds, tid, wave, lane); } }
        xcd_barrier(xb);
        { FRESH_IDS();
          { const int strm = bx * 2 + (wave >> 2), nstr = 2 * G;
            if (nstr == 512) { s12_unit(strm, (const bf16*)(ws + WS_XT), (const bf16*)(ws + WS_BT), (const float*)(ws + WS_CUM), (const bf16*)(ws + WS_WST), (bf16*)(ws + WS_PREV), wave & 3, lane);
                if (strm >= 64 && strm < 128) s12_unit(448 + strm, (const bf16*)(ws + WS_XT), (const bf16*)(ws + WS_BT), (const float*)(ws + WS_CUM), (const bf16*)(ws + WS_WST), (bf16*)(ws + WS_PREV), wave & 3, lane); }
            else for (int u = strm; u < 576; u += nstr) s12_unit(u, (const bf16*)(ws + WS_XT), (const bf16*)(ws + WS_BT), (const float*)(ws + WS_CUM), (const bf16*)(ws + WS_WST), (bf16*)(ws + WS_PREV), wave & 3, lane); } }
        xcd_barrier(xb);
        { FRESH_IDS();
          for (int u = bx; u < 1280; u += G)
              s3_unit(u, (const bf16*)(ws + WS_XT), (const bf16*)(ws + WS_BTOK), (const bf16*)(ws + WS_CTOK), (const float*)(ws + WS_CUM), (const float*)(ws + WS_DTA), (const bf16*)(ws + WS_PREV), Zb,
                      KIN(12) + l * 8, KIN(13) + l * 512, (bf16*)out, (float*)(ws + WS_SSQ) + M, lds, tid, wave, lane); }
        xcd_barrier(xb);
        }
        { FRESH_IDS(); const float* ssq = (const float*)(ws + WS_SSQ);
          for (int m = gw; m < M; m += NGW) { const float sa = 1.f / sqrtf(ssq[m] * (1.f / 512.f) + RMS_EPS), ss = 1.f / sqrtf(ssq[M + m] * (1.f / 512.f) + RMS_EPS);
              u32x4* rowp = (u32x4*)((bf16*)out + (size_t)m * 1024) + lane;
#pragma unroll
              for (int hf = 0; hf < 2; ++hf) { const float f = hf ? ss : sa; u32x4 v = rowp[64 * hf];
                  v.x = pkbf(bf_lo(v.x) * f, bf_hi(v.x) * f); v.y = pkbf(bf_lo(v.y) * f, bf_hi(v.y) * f); v.z = pkbf(bf_lo(v.z) * f, bf_hi(v.z) * f); v.w = pkbf(bf_lo(v.w) * f, bf_hi(v.w) * f); rowp[64 * hf] = v; } } }
        xcd_barrier(xb);
        { FRESH_IDS(); pg8::Gemm g{(const bf16*)out, (const bf16*)(ws + WS_W + (size_t)l * W_LAYER + OW_OUT), M, D, D}; pg8::StaticOrder S; S.init(M, D, (int)gridDim.x, (int)blockIdx.x); pg8::EpiResidBf E{XB, 1.0f};
          pg8::gemm_phase<pg8::EpiResidBf, pg8::StaticOrder, true, true>(lds, g, S, E); }
        xcd_barrier(xb);
        { FRESH_IDS(); const float* g_ = KIN(17) + l * D; const float* b_ = KIN(18) + l * D;
          for (int m = gw; m < M; m += NGW) ln_row_bf(XB + (size_t)m * D, nullptr, g_, b_, lane); }
        xcd_barrier(xb);
        { FRESH_IDS(); pg8::Gemm g{XB, (const bf16*)(ws + WS_W + (size_t)l * W_LAYER + OW_GU2), M, NGU, D}; pg8::StaticOrder S; S.init(M, NGU, (int)gridDim.x, (int)blockIdx.x); pg8::EpiSwiGLU E{Hb, FF};
          pg8::gemm_phase<pg8::EpiSwiGLU, pg8::StaticOrder, true, true>(lds, g, S, E); }
        xcd_barrier(xb);
        { FRESH_IDS(); pg8::Gemm g{Hb, (const bf16*)(ws + WS_W + (size_t)l * W_LAYER + OW_D2), M, D, FF}; pg8::StaticOrder S; S.init(M, D, (int)gridDim.x, (int)blockIdx.x); pg8::EpiResidBf E{XB, 0.5f};
          pg8::gemm_phase<pg8::EpiResidBf, pg8::StaticOrder, true, true>(lds, g, S, E); }
        xcd_barrier(xb);
        { FRESH_IDS(); const float* g_ = KIN(22) + l * D; const float* b_ = KIN(23) + l * D;
          for (int m = gw; m < M; m += NGW) ln_row_bf(XB + (size_t)m * D, l == 1 ? out + (size_t)m * D : nullptr, g_, b_, lane); }
        if (l == 0) xcd_barrier(xb);
}

__global__ void __launch_bounds__(NT, 2) fwd_mega(Params P) {
    extern __shared__ __attribute__((aligned(16))) unsigned char lds_raw[];
    LAS unsigned char* lds = (LAS unsigned char*)lds_raw;
    cg::grid_group grid = cg::this_grid();
    volatile LAS unsigned* bst = (volatile LAS unsigned*)(lds + LDS_BYTES - 64);
    if (threadIdx.x < 2) bst[threadIdx.x] = 0u;
    __syncthreads();
    const XcdBarrier xb = xcd_barrier_post((unsigned*)KWS(), bst);
    { FRESH_IDS(); LAS float* scr = (LAS float*)(lds + wave * 16384);
      for (int it = gw; it < 2 * IT_LAYER; it += NGW) prologue_item(ws, it, scr, lane);
      { float* TBw = (float*)(ws + WS_TB);
        for (int i = bx * NT + tid; i < 2 * 8 * 4 * 15 * 512; i += G * NT) { const int kc = i & 31, q = (i >> 5) & 15; int t = i >> 9; const int ro = t % 15; t /= 15; const int j = t & 3; t >>= 2; const int h = t & 7, l = t >> 3;
            const int kstart = j == 0 ? 0 : (j == 1 ? 8 : (j == 2 ? 24 : 32)), qcol = 16 * j + q, kcol = kstart + kc, cst = min(max(qcol - 8, 0), 48);
            const bool valid = kcol >= cst && kcol < cst + 16;
            TBw[i] = valid ? 1.4426950408889634f * KIN(15)[((l * 8 + h) * 15 + ro) * 31 + (kcol - qcol + 15)] : -INFINITY; } }
      for (int m = gw; m < M; m += NGW) { const float* src = m < MPROMPT ? KIN(0) + (size_t)m * D : KIN(1) + (size_t)(m - MPROMPT) * D; row_to_bf16(src, XB + (size_t)m * D, lane); } }
    grid.sync();

    layer_body<0>(lds, xb);
    layer_body<1>(lds, xb);
}

extern "C" void kernel_launch(void* const* d_in, const int* in_sizes, int n_in, void* d_out, int out_size, void* d_ws, size_t ws_size, hipStream_t stream) {
    static int grid_blocks = 0;
    if (grid_blocks == 0) {
        if (n_in != 24 || out_size != M * D || ws_size < WS_END) { fprintf(stderr, "kernel_launch: unexpected shapes (n_in %d out %d ws %zu)\n", n_in, out_size, ws_size); grid_blocks = -1; return; }
        int dev = 0, cus = 0, per_cu = 0;
        (void)hipGetDevice(&dev); (void)hipDeviceGetAttribute(&cus, hipDeviceAttributeMultiprocessorCount, dev);
        if (hipFuncSetAttribute((const void*)fwd_mega, hipFuncAttributeMaxDynamicSharedMemorySize, LDS_BYTES) != hipSuccess) { fprintf(stderr, "kernel_launch: hipFuncSetAttribute failed\n"); grid_blocks = -1; return; }
        if (hipOccupancyMaxActiveBlocksPerMultiprocessor(&per_cu, (const void*)fwd_mega, NT, LDS_BYTES) != hipSuccess || per_cu < 1) { fprintf(stderr, "kernel_launch: occupancy query gave %d\n", per_cu); per_cu = 1; }
        (void)hipGetLastError();
        grid_blocks = cus * per_cu;
    }
    if (grid_blocks < 0) return;
    if (hipMemsetAsync(d_ws, 0, 65536, stream) != hipSuccess) { fprintf(stderr, "kernel_launch: memset of the barrier words failed\n"); return; }
    Params p{};
    for (int i = 0; i < 24; ++i) p.in[i] = (const float*)d_in[i];
    p.out = (float*)d_out; p.ws = (unsigned char*)d_ws;
    void* args[] = {&p};
    hipError_t e = hipLaunchCooperativeKernel((const void*)fwd_mega, dim3(grid_blocks), dim3(NT), args, LDS_BYTES, stream);
    if (e != hipSuccess) fprintf(stderr, "cooperative launch failed: %s (grid %d)\n", hipGetErrorString(e), grid_blocks);
}
```

```cpp
#include <hip/hip_runtime.h>
#include <hip/hip_cooperative_groups.h>
#include <cstdio>
#include <cstdint>
namespace cg = cooperative_groups;
namespace pg8 {
#define PG8_LAS __attribute__((address_space(3)))
typedef unsigned short bf16_t;
typedef short bf16x8 __attribute__((ext_vector_type(8)));
typedef float f32x4 __attribute__((ext_vector_type(4)));
typedef unsigned u32x4 __attribute__((ext_vector_type(4)));
constexpr int BM = 256, BK = 64, HALF = 128, HTB = HALF * BK * 2  , STAGE_BYTES = 8 * HTB, NXCD = 8, WGM = 8;

__host__ __device__ __forceinline__ int lds_byte(int r, int c) { const int st = (r >> 4) * 2 + (c >> 5), rr = r & 15, cc = c & 31, ob = rr * 64 + cc * 2; return st * 1024 + (ob ^ (((ob >> 9) & 1) << 5)); }
__host__ __device__ __forceinline__ void stage_rc(int b, int& R, int& C) { const int st = b / 1024, sb = b % 1024, swz = sb ^ (((sb >> 9) & 1) << 5); R = (st >> 1) * 16 + swz / 64; C = (st & 1) * 32 + (swz % 64) / 2; }
__host__ __device__ __forceinline__ int perm32(int rho) { const int n = rho >> 4, i = rho & 15; return 8 * (i >> 2) + 4 * n + (i & 3); }

struct Unit { int pm, pn; };
struct Gemm { const bf16_t* A; const bf16_t* Bt; int M, N, K; };

struct StaticOrder {
    int nM, nN, nwg, G, c;
    __host__ __device__ void init(int M, int N, int G_, int c_) { nM = M / BM; nN = N / BM; nwg = nM * nN; G = G_; c = c_; }
    __host__ __device__ bool next(int i, Unit& u) const {
        const long L = (long)i * G + c; if (L >= nwg) return false;
        int wgid = (int)L; { const int q = nwg / NXCD, r = nwg % NXCD, xcd = wgid % NXCD, off = wgid / NXCD; wgid = (xcd < r ? xcd * (q + 1) : r * (q + 1) + (xcd - r) * q) + off; }
        const int nig = WGM * nN, gid = wgid / nig, fm = gid * WGM, gsz = (nM - fm) < WGM ? (nM - fm) : WGM;
        u.pm = fm + ((wgid % nig) % gsz); u.pn = (wgid % nig) / gsz; return true;
    }
    __device__ __forceinline__ void a_ready(const Unit&) const {}
    __device__ __forceinline__ void done(const Unit&) const {}
};

typedef float f32x2e __attribute__((ext_vector_type(2)));
typedef __bf16 bf16x2e __attribute__((ext_vector_type(2)));
__device__ __forceinline__ unsigned pkbf(float a, float b) { f32x2e v = {a, b}; bf16x2e r = __builtin_convertvector(v, bf16x2e); return __builtin_bit_cast(unsigned, r); }
__device__ __forceinline__ float silu_f(float g) { return g * __builtin_amdgcn_rcpf(1.f + __builtin_amdgcn_exp2f(-1.4426950408889634f * g)); }
constexpr float ALPHA_F = 1.4142135623730951f;
constexpr int MPROMPT = 65536;

struct EpiSwiGLU {
    static constexpr bool PERM = true, AFTER_DRAIN = false, MID = false;
    bf16_t* H; int ldh;
    __device__ __forceinline__ void operator()(const f32x4 (&acc)[2][2][4][2], const Unit& u, int wr, int wc, int fr, int fq) const {
        const int row0 = u.pm * BM + wr * 64 + fr, col0 = u.pn * HALF + wc * 32 + 8 * fq;
#pragma unroll
        for (int ai = 0; ai < 2; ++ai)
#pragma unroll
            for (int m = 0; m < 4; ++m) {
                bf16_t* p = H + (size_t)(row0 + ai * HALF + m * 16) * ldh + col0;
                const f32x4 g0 = acc[ai][0][m][0], g1 = acc[ai][0][m][1], u0 = acc[ai][1][m][0], u1 = acc[ai][1][m][1];
                u32x4 w;
                w.x = pkbf(silu_f(g0[0]) * u0[0], silu_f(g0[1]) * u0[1]); w.y = pkbf(silu_f(g0[2]) * u0[2], silu_f(g0[3]) * u0[3]);
                w.z = pkbf(silu_f(g1[0]) * u1[0], silu_f(g1[1]) * u1[1]); w.w = pkbf(silu_f(g1[2]) * u1[2], silu_f(g1[3]) * u1[3]);
                *(u32x4*)p = w;
            }
    }
};
struct EpiResid {
    static constexpr bool PERM = false, AFTER_DRAIN = false, MID = false;
    const float* r0; const float* r1; float* out; float scale;
    __device__ __forceinline__ void operator()(const f32x4 (&acc)[2][2][4][2], const Unit& u, int wr, int wc, int fr, int fq) const {
        const float* rbase = (u.pm * BM < MPROMPT) ? r0 : r1;
#pragma unroll
        for (int ai = 0; ai < 2; ++ai)
#pragma unroll
            for (int m = 0; m < 4; ++m) {
                const size_t roff = (size_t)(u.pm * BM + ai * HALF + wr * 64 + m * 16 + fr) * 1024;
#pragma unroll
                for (int bj = 0; bj < 2; ++bj)
#pragma unroll
                    for (int n = 0; n < 2; ++n) {
                        const int c = u.pn * BM + bj * HALF + wc * 32 + n * 16 + 4 * fq;
                        const f32x4 b = *(const f32x4*)(rbase + roff + c);
                        *(f32x4*)(out + roff + c) = b * ALPHA_F + acc[ai][bj][m][n] * scale;
                    }
            }
    }
};
struct EpiResidBf {
    static constexpr bool PERM = true, AFTER_DRAIN = false, MID = false;
    bf16_t* X; float scale;
    __device__ __forceinline__ void operator()(const f32x4 (&acc)[2][2][4][2], const Unit& u, int wr, int wc, int fr, int fq) const {
        const int row0 = u.pm * BM + wr * 64 + fr, col0 = u.pn * BM + wc * 32 + 8 * fq;
#pragma unroll
        for (int ai = 0; ai < 2; ++ai)
#pragma unroll
            for (int m = 0; m < 4; ++m) { bf16_t* rowp = X + (size_t)(row0 + ai * HALF + m * 16) * 1024 + col0;
#pragma unroll
                for (int bj = 0; bj < 2; ++bj) { const u32x4 xv = *(const u32x4*)(rowp + bj * HALF); const f32x4 a0 = acc[ai][bj][m][0] * scale, a1 = acc[ai][bj][m][1] * scale;
                    u32x4 w;
                    w.x = pkbf(__uint_as_float(xv.x << 16) * ALPHA_F + a0[0], __uint_as_float(xv.x & 0xffff0000u) * ALPHA_F + a0[1]);
                    w.y = pkbf(__uint_as_float(xv.y << 16) * ALPHA_F + a0[2], __uint_as_float(xv.y & 0xffff0000u) * ALPHA_F + a0[3]);
                    w.z = pkbf(__uint_as_float(xv.z << 16) * ALPHA_F + a1[0], __uint_as_float(xv.z & 0xffff0000u) * ALPHA_F + a1[1]);
                    w.w = pkbf(__uint_as_float(xv.w << 16) * ALPHA_F + a1[2], __uint_as_float(xv.w & 0xffff0000u) * ALPHA_F + a1[3]);
                    *(u32x4*)(rowp + bj * HALF) = w; } }
    }
};
struct EpiResidMix {
    static constexpr bool PERM = false, AFTER_DRAIN = false, MID = true;
    float* out; const float* ssq;
    __device__ __forceinline__ void mid(f32x4 (&acc)[2][2][4][2], const Unit& u, int wr, int wc, int fr, int fq) const {
#pragma unroll
        for (int ai = 0; ai < 2; ++ai)
#pragma unroll
            for (int m = 0; m < 4; ++m) { const int r = u.pm * BM + ai * HALF + wr * 64 + m * 16 + fr;
                const float f = sqrtf((ssq[81920 + r] * (1.f / 512.f) + 1e-6f) / (ssq[r] * (1.f / 512.f) + 1e-6f));
#pragma unroll
                for (int bj = 0; bj < 2; ++bj)
#pragma unroll
                    for (int n = 0; n < 2; ++n) acc[ai][bj][m][n] = acc[ai][bj][m][n] * f; }
    }
    __device__ __forceinline__ void operator()(const f32x4 (&acc)[2][2][4][2], const Unit& u, int wr, int wc, int fr, int fq) const {
#pragma unroll
        for (int ai = 0; ai < 2; ++ai)
#pragma unroll
            for (int m = 0; m < 4; ++m) { const int r = u.pm * BM + ai * HALF + wr * 64 + m * 16 + fr; const size_t roff = (size_t)r * 1024;
                const float f = 1.f / sqrtf(ssq[81920 + r] * (1.f / 512.f) + 1e-6f);
#pragma unroll
                for (int bj = 0; bj < 2; ++bj)
#pragma unroll
                    for (int n = 0; n < 2; ++n) { const int c = u.pn * BM + bj * HALF + wc * 32 + n * 16 + 4 * fq;
                        const f32x4 b = *(const f32x4*)(out + roff + c);
                        *(f32x4*)(out + roff + c) = b * ALPHA_F + acc[ai][bj][m][n] * f; } }
    }
};
struct EpiProj {
    static constexpr bool PERM = true, AFTER_DRAIN = false, MID = false;
    bf16_t* QKV; bf16_t* Z; bf16_t* XBC; float* DT;
    __device__ __forceinline__ void operator()(const f32x4 (&acc)[2][2][4][2], const Unit& u, int wr, int wc, int fr, int fq) const {
        const int row0 = u.pm * BM + wr * 64 + fr, pn = u.pn;
        if (pn == 12) {
            if (wc == 0 && fq < 2) {
#pragma unroll
                for (int ai = 0; ai < 2; ++ai)
#pragma unroll
                    for (int m = 0; m < 4; ++m) { float* p = DT + (size_t)(row0 + ai * HALF + m * 16) * 16 + 8 * fq;
                        *(f32x4*)p = acc[ai][0][m][0]; *(f32x4*)(p + 4) = acc[ai][0][m][1]; }
            }
            return;
        }
        bf16_t* base; int ldc, colt; float sc = 1.f;
        if (pn < 6) { base = QKV; ldc = 1536; colt = pn * 256; if (pn < 2) sc = 0.125f * 1.4426950408889634f; }
        else if (pn < 8) { base = Z; ldc = 512; colt = (pn - 6) * 256; }
        else { base = XBC; ldc = 1024; colt = (pn - 8) * 256; }
        const int col0 = colt + wc * 32 + 8 * fq;
#pragma unroll
        for (int ai = 0; ai < 2; ++ai)
#pragma unroll
            for (int m = 0; m < 4; ++m) { bf16_t* rowp = base + (size_t)(row0 + ai * HALF + m * 16) * ldc + col0;
#pragma unroll
                for (int bj = 0; bj < 2; ++bj) { const f32x4 v0 = acc[ai][bj][m][0] * sc, v1 = acc[ai][bj][m][1] * sc;
                    u32x4 w; w.x = pkbf(v0[0], v0[1]); w.y = pkbf(v0[2], v0[3]); w.z = pkbf(v1[0], v1[1]); w.w = pkbf(v1[2], v1[3]);
                    *(u32x4*)(rowp + bj * HALF) = w; } }
    }
};

template <class Epi, class Sched, bool ALIGN_EPI = false, bool SP2 = false>
__device__ __forceinline__ void gemm_phase(PG8_LAS unsigned char* lds, const Gemm g, const Sched& S, const Epi& E) {
    int tid_ = threadIdx.x; asm volatile("" : "+v"(tid_));
    const int tid = tid_, wid = __builtin_amdgcn_readfirstlane(tid >> 6), lane = tid & 63, wr = wid >> 2, wc = wid & 3, fr = lane & 15, fq = lane >> 4;
    const int K = g.K, nt = K / BK;
    unsigned voffA[2], voffB[2];
#pragma unroll
    for (int i = 0; i < 2; ++i) { int R, C; stage_rc(tid * 16 + i * 8192, R, C); const int Rb = Epi::PERM ? ((R & ~31) + perm32(R & 31)) : R;
        voffA[i] = (unsigned)(R * K + C) * 2u; voffB[i] = (unsigned)(Rb * K + C) * 2u; }
    const size_t kstep = (size_t)(BK * 2);
    const size_t hstep = (size_t)HALF * K * 2;
    const size_t tstep = 2 * hstep;
    const unsigned ldsw = (unsigned)wid * 1024u;
    const int aoff = lds_byte(wr * 64 + fr, fq * 8), boff = lds_byte(wc * 32 + fr, fq * 8);
#define PG8_SA(b, h) (((b) * 2 + (h)) * HTB)
#define PG8_SB(b, h) ((4 + (b) * 2 + (h)) * HTB)
#define PG8_STAGE(bufoff, gbase, voff) do { _Pragma("unroll") for (int _i = 0; _i < 2; ++_i) \
        __builtin_amdgcn_global_load_lds((const unsigned*)((const char*)(gbase) + (voff)[_i]), (PG8_LAS unsigned*)(lds + (bufoff) + ldsw + _i * 8192), 16, 0, 0); } while (0)
#define PG8_LDA(dst, b, h) do { _Pragma("unroll") for (int m = 0; m < 4; ++m) _Pragma("unroll") for (int k = 0; k < 2; ++k) dst[m][k] = *(const PG8_LAS bf16x8*)(lds + PG8_SA(b, h) + aoff + m * 2048 + k * 1024); } while (0)
#define PG8_LDB(dst, b, h) do { _Pragma("unroll") for (int n = 0; n < 2; ++n) _Pragma("unroll") for (int k = 0; k < 2; ++k) dst[n][k] = *(const PG8_LAS bf16x8*)(lds + PG8_SB(b, h) + boff + n * 2048 + k * 1024); } while (0)
#define PG8_MMA(ai, bj, At, Bt) do { __builtin_amdgcn_s_setprio(1); _Pragma("unroll") for (int m = 0; m < 4; ++m) _Pragma("unroll") for (int n = 0; n < 2; ++n) _Pragma("unroll") for (int k = 0; k < 2; ++k) \
        acc[ai][bj][m][n] = __builtin_amdgcn_mfma_f32_16x16x32_bf16(Bt[n][k], At[m][k], acc[ai][bj][m][n], 0, 0, 0); __builtin_amdgcn_s_setprio(0); } while (0)
#define PG8_WAIT_V(n) asm volatile("s_waitcnt vmcnt(" #n ")" ::: "memory")
#define PG8_WAIT_L(n) asm volatile("s_waitcnt lgkmcnt(" #n ")" ::: "memory")
#define PG8_BAR __builtin_amdgcn_s_barrier()
#define PG8_SCHED __builtin_amdgcn_sched_barrier(0)
    Unit cur, nxt; int ui = 0;
    if (!S.next(0, cur)) return;
    f32x4 acc[2][2][4][2];
#pragma unroll
    for (int a = 0; a < 2; ++a)
#pragma unroll
        for (int b = 0; b < 2; ++b)
#pragma unroll
            for (int m = 0; m < 4; ++m)
#pragma unroll
                for (int n = 0; n < 2; ++n) acc[a][b][m][n] = (f32x4){0.f, 0.f, 0.f, 0.f};
    bf16x8 At[4][2], B0[2][2], B1[2][2];
    const char* cA = (const char*)g.A + (size_t)cur.pm * tstep; const char* cB = (const char*)g.Bt + (size_t)cur.pn * tstep;
    S.a_ready(cur);
    if constexpr (SP2) {
        PG8_STAGE(PG8_SB(0, 0), cB, voffB); PG8_STAGE(PG8_SB(0, 1), cB + hstep, voffB); PG8_STAGE(PG8_SA(0, 0), cA, voffA); PG8_STAGE(PG8_SA(0, 1), cA + hstep, voffA);
        if (wr == 1) PG8_BAR;
        PG8_WAIT_V(2); PG8_BAR;
        PG8_STAGE(PG8_SB(1, 0), cB + kstep, voffB); PG8_STAGE(PG8_SA(1, 0), cA + kstep, voffA); PG8_STAGE(PG8_SB(1, 1), cB + hstep + kstep, voffB);
        PG8_WAIT_V(6); PG8_BAR;
    } else {
        PG8_STAGE(PG8_SB(0, 0), cB, voffB); PG8_STAGE(PG8_SA(0, 0), cA, voffA); PG8_STAGE(PG8_SB(0, 1), cB + hstep, voffB); PG8_STAGE(PG8_SA(0, 1), cA + hstep, voffA);
        if (wr == 1) PG8_BAR;
        PG8_WAIT_V(4); PG8_BAR;
        PG8_STAGE(PG8_SB(1, 0), cB + kstep, voffB); PG8_STAGE(PG8_SA(1, 0), cA + kstep, voffA); PG8_STAGE(PG8_SB(1, 1), cB + hstep + kstep, voffB);
        PG8_WAIT_V(6); PG8_BAR;
    }
    for (;;) {
        const bool has_next = S.next(ui + 1, nxt);
        const char* nA = has_next ? (const char*)g.A + (size_t)nxt.pm * tstep : cA; const char* nB = has_next ? (const char*)g.Bt + (size_t)nxt.pn * tstep : cB;
        for (int t = 0; t < nt; t += 2) {
            if constexpr (Epi::MID) { if (t == (nt >> 1)) E.mid(acc, cur, wr, wc, fr, fq); }
            const bool last = (t == nt - 2);
            const char* a1 = cA + (size_t)(t + 1) * kstep;
            const char* a2 = last ? nA : cA + (size_t)(t + 2) * kstep; const char* b2 = last ? nB : cB + (size_t)(t + 2) * kstep;
            const char* a3 = a2 + kstep; const char* b3 = b2 + kstep;
            if (last && has_next) S.a_ready(nxt);
            if constexpr (SP2) {
            PG8_LDB(B0, 0, 0); PG8_LDB(B1, 0, 1); PG8_SCHED; PG8_LDA(At, 0, 0); PG8_STAGE(PG8_SA(1, 1), a1 + hstep, voffA);
            PG8_WAIT_V(8); PG8_WAIT_L(0); PG8_BAR; PG8_MMA(0, 0, At, B0); PG8_MMA(0, 1, At, B1); PG8_BAR; PG8_SCHED;
            PG8_LDA(At, 0, 1); PG8_STAGE(PG8_SB(0, 0), b2, voffB); PG8_STAGE(PG8_SB(0, 1), b2 + hstep, voffB); PG8_STAGE(PG8_SA(0, 0), a2, voffA);
            PG8_WAIT_V(8); PG8_WAIT_L(0); PG8_BAR; PG8_MMA(1, 0, At, B0); PG8_MMA(1, 1, At, B1); PG8_BAR; PG8_SCHED;
            PG8_LDB(B0, 1, 0); PG8_LDB(B1, 1, 1); PG8_SCHED; PG8_LDA(At, 1, 0); PG8_STAGE(PG8_SA(0, 1), a2 + hstep, voffA);
            PG8_WAIT_V(8); PG8_WAIT_L(0); PG8_BAR; PG8_MMA(0, 0, At, B0); PG8_MMA(0, 1, At, B1); PG8_BAR; PG8_SCHED;
            PG8_LDA(At, 1, 1); PG8_STAGE(PG8_SB(1, 0), b3, voffB); PG8_STAGE(PG8_SB(1, 1), b3 + hstep, voffB); PG8_STAGE(PG8_SA(1, 0), a3, voffA);
            PG8_WAIT_V(8); PG8_WAIT_L(0); PG8_BAR; PG8_MMA(1, 0, At, B0); PG8_MMA(1, 1, At, B1); PG8_BAR; PG8_SCHED;
            } else {
            PG8_LDB(B0, 0, 0); PG8_SCHED; PG8_LDA(At, 0, 0); PG8_STAGE(PG8_SA(1, 1), a1 + hstep, voffA);
            PG8_WAIT_L(8); PG8_BAR; PG8_WAIT_L(0); PG8_MMA(0, 0, At, B0); PG8_BAR; PG8_SCHED;
            PG8_LDB(B1, 0, 1); PG8_STAGE(PG8_SB(0, 0), b2, voffB);
            PG8_BAR; PG8_WAIT_L(0); PG8_MMA(0, 1, At, B1); PG8_BAR;
            PG8_LDA(At, 0, 1); PG8_STAGE(PG8_SA(0, 0), a2, voffA);
            PG8_BAR; PG8_WAIT_L(0); PG8_MMA(1, 0, At, B0); PG8_BAR; PG8_SCHED;
            PG8_STAGE(PG8_SB(0, 1), b2 + hstep, voffB);
            PG8_WAIT_V(6); PG8_BAR; PG8_MMA(1, 1, At, B1); PG8_BAR;
            PG8_LDB(B0, 1, 0); PG8_SCHED; PG8_LDA(At, 1, 0); PG8_STAGE(PG8_SA(0, 1), a2 + hstep, voffA);
            PG8_WAIT_L(8); PG8_BAR; PG8_WAIT_L(0); PG8_MMA(0, 0, At, B0); PG8_BAR; PG8_SCHED;
            PG8_LDB(B1, 1, 1); PG8_STAGE(PG8_SB(1, 0), b3, voffB);
            PG8_BAR; PG8_WAIT_L(0); PG8_MMA(0, 1, At, B1); PG8_BAR;
            PG8_LDA(At, 1, 1); PG8_STAGE(PG8_SA(1, 0), a3, voffA);
            PG8_BAR; PG8_WAIT_L(0); PG8_MMA(1, 0, At, B0); PG8_BAR; PG8_SCHED;
            PG8_STAGE(PG8_SB(1, 1), b3 + hstep, voffB);
            PG8_WAIT_V(6); PG8_BAR; PG8_MMA(1, 1, At, B1); PG8_BAR;
            }
        }
        if constexpr (ALIGN_EPI) { if (wr == 0) PG8_BAR; }
        if constexpr (!Epi::AFTER_DRAIN) { E(acc, cur, wr, wc, fr, fq); S.done(cur); }
        if (!has_next) break;
#pragma unroll
        for (int a = 0; a < 2; ++a)
#pragma unroll
            for (int b = 0; b < 2; ++b)
#pragma unroll
                for (int m = 0; m < 4; ++m)
#pragma unroll
                    for (int n = 0; n < 2; ++n) acc[a][b][m][n] = (f32x4){0.f, 0.f, 0.f, 0.f};
        cur = nxt; cA = nA; cB = nB; ++ui;
        if constexpr (ALIGN_EPI) { if (wr == 1) PG8_BAR; }
    }
    PG8_WAIT_V(0);
    if constexpr (!ALIGN_EPI) { if (wr == 0) PG8_BAR; }
    PG8_BAR;
    if constexpr (Epi::AFTER_DRAIN) { E.fused(acc, cur, wr, wc, fr, fq, lds, wid, lane); S.done(cur); }
#undef PG8_SA
#undef PG8_SB
#undef PG8_STAGE
#undef PG8_LDA
#undef PG8_LDB
#undef PG8_MMA
#undef PG8_WAIT_V
#undef PG8_WAIT_L
#undef PG8_BAR
#undef PG8_SCHED
}
}

#define LAS __attribute__((address_space(3)))
typedef unsigned short bf16;
using pg8::f32x4; using pg8::u32x4; using pg8::pkbf; using pg8::silu_f; using pg8::MPROMPT;
typedef unsigned u32x2 __attribute__((ext_vector_type(2)));
constexpr int NWAVES = 8, NT = 512;
constexpr int M = 81920, D = 1024, FF = 2816, NGU = 5632, NIN = 3328, NPROJ = 3088;
constexpr float LN_EPS = 1e-5f, RMS_EPS = 1e-6f;
constexpr size_t MiB = 1u << 20;
constexpr size_t WS_W = 1 * MiB, W_LAYER = 42 * MiB;
constexpr size_t OW_GU1 = 0, OW_D1 = 11534336, OW_IN = 17301504, OW_OUT = 24117248, OW_GU2 = 26214400, OW_D2 = 37748736;
constexpr size_t WS_XB = 85 * MiB, WS_R = 245 * MiB, WS_QKV = WS_R, WS_Z = WS_R + 240 * MiB, WS_RAW = WS_R + 320 * MiB, WS_H = WS_R;
constexpr size_t WS_Y = 725 * MiB;
constexpr size_t WS_XT = 725 * MiB, WS_BT = 805 * MiB, WS_BTOK = 845 * MiB, WS_CTOK = 885 * MiB;
constexpr size_t WS_CUM = 925 * MiB, WS_DTA = 930 * MiB, WS_WST = 935 * MiB;
constexpr size_t WS_DT = 940 * MiB, WS_SSQ = 945 * MiB, WS_TB = 946 * MiB, WS_END = 948 * MiB;
constexpr size_t WS_PREV = WS_RAW;
constexpr int LDS_BYTES = 155648;

#define LDS_WAIT() asm volatile("s_waitcnt lgkmcnt(0)" ::: "memory")
__device__ __forceinline__ float bf_lo(unsigned u) { return __uint_as_float(u << 16); }
__device__ __forceinline__ float bf_hi(unsigned u) { return __uint_as_float(u & 0xffff0000u); }
__device__ __forceinline__ float bf2f(bf16 v) { return __uint_as_float(((unsigned)v) << 16); }
__device__ __forceinline__ bf16 f2bf(float f) { return (bf16)(pkbf(f, 0.f) & 0xffffu); }
__device__ __forceinline__ float wave_sum(float v) {
#pragma unroll
    for (int o = 1; o < 64; o <<= 1) v += __shfl_xor(v, o);
    return v;
}
__device__ __forceinline__ float wave_max(float v) {
#pragma unroll
    for (int o = 1; o < 64; o <<= 1) v = fmaxf(v, __shfl_xor(v, o));
    return v;
}

struct Params { const float* in[24]; float* out; unsigned char* ws; };
__device__ __forceinline__ unsigned long long karg_u64(int i) { int j = i; asm volatile("" : "+s"(j)); const __attribute__((address_space(4))) unsigned long long* ka = (const __attribute__((address_space(4))) unsigned long long*)__builtin_amdgcn_kernarg_segment_ptr(); return ka[j]; }
#define KIN(i) ((const float*)karg_u64(i))
#define KOUT() ((float*)karg_u64(24))
#define KWS() ((unsigned char*)karg_u64(25))

__device__ __forceinline__ void tr_item(const float* W, int ldw, int ncols, bf16* WT, int Kdst, int k0, int n0, int drow, LAS float* scr, int lane) {
    int n = n0 + (lane & 31); n = n < ncols ? n : ncols - 1;
#pragma unroll 8
    for (int i = 0; i < 32; ++i) { const int kk = 2 * i + (lane >> 5); scr[kk * 33 + (lane & 31)] = W[(size_t)(k0 + kk) * ldw + n]; }
    LDS_WAIT(); asm volatile("" ::: "memory");
    const int c = lane & 7;
#pragma unroll
    for (int j = 0; j < 4; ++j) { const int nn = (lane >> 3) + 8 * j; const LAS float* s = scr + (8 * c) * 33 + nn;
        u32x4 o; o.x = pkbf(s[0 * 33], s[1 * 33]); o.y = pkbf(s[2 * 33], s[3 * 33]); o.z = pkbf(s[4 * 33], s[5 * 33]); o.w = pkbf(s[6 * 33], s[7 * 33]);
        *(u32x4*)(WT + (size_t)(drow + nn) * Kdst + k0 + 8 * c) = o; }
    LDS_WAIT(); asm volatile("" ::: "memory");
}
constexpr int IT_GU = 16 * 88, IT_D = 44 * 32, IT_IN = 16 * 97, IT_OUT = 16 * 32, IT_LAYER = 6 * IT_GU + IT_IN + IT_OUT;
__device__ __forceinline__ void prologue_item(unsigned char* wsb, int it, LAS float* scr, int lane) {
    const int l = it / IT_LAYER; int r = it % IT_LAYER;
    unsigned char* wl = wsb + WS_W + (size_t)l * W_LAYER;
    if (r < 2 * IT_GU) { const int up = r >= IT_GU; r -= up * IT_GU; const int kb = r / 88, nb = r % 88, n0 = 32 * nb;
        tr_item(KIN(up ? 3 : 2) + (size_t)l * D * FF, FF, FF, (bf16*)(wl + OW_GU1), D, 64 * kb, n0, 256 * (n0 >> 7) + (n0 & 127) + 128 * up, scr, lane); return; }
    r -= 2 * IT_GU;
    if (r < IT_D) { const int kb = r / 32, nb = r % 32; tr_item(KIN(4) + (size_t)l * FF * D, D, D, (bf16*)(wl + OW_D1), FF, 64 * kb, 32 * nb, 32 * nb, scr, lane); return; }
    r -= IT_D;
    if (r < IT_IN) { const int kb = r / 97, nb = r % 97; tr_item(KIN(7) + (size_t)l * D * NPROJ, NPROJ, NPROJ, (bf16*)(wl + OW_IN), D, 64 * kb, 32 * nb, 32 * nb, scr, lane); return; }
    r -= IT_IN;
    if (r < IT_OUT) { const int kb = r / 32, nb = r % 32; tr_item(KIN(16) + (size_t)l * D * D, D, D, (bf16*)(wl + OW_OUT), D, 64 * kb, 32 * nb, 32 * nb, scr, lane); return; }
    r -= IT_OUT;
    if (r < 2 * IT_GU) { const int up = r >= IT_GU; r -= up * IT_GU; const int kb = r / 88, nb = r % 88, n0 = 32 * nb;
        tr_item(KIN(up ? 20 : 19) + (size_t)l * D * FF, FF, FF, (bf16*)(wl + OW_GU2), D, 64 * kb, n0, 256 * (n0 >> 7) + (n0 & 127) + 128 * up, scr, lane); return; }
    r -= 2 * IT_GU;
    { const int kb = r / 32, nb = r % 32; tr_item(KIN(21) + (size_t)l * FF * D, D, D, (bf16*)(wl + OW_D2), FF, 64 * kb, 32 * nb, 32 * nb, scr, lane); }
}
__device__ __forceinline__ void row_to_bf16(const float* xrow, bf16* orow, int lane) {
    const f32x4* xr = (const f32x4*)xrow + lane; u32x2* o8 = (u32x2*)orow + lane;
#pragma unroll
    for (int j = 0; j < 4; ++j) { const f32x4 v = xr[64 * j]; u32x2 w; w.x = pkbf(v[0], v[1]); w.y = pkbf(v[2], v[3]); o8[64 * j] = w; }
}
__device__ __forceinline__ void ln_row(float* xrow, bf16* orow, const float* g, const float* b, int lane) {
    f32x4* xr = (f32x4*)xrow + lane; f32x4 v[4]; float s = 0.f;
#pragma unroll
    for (int j = 0; j < 4; ++j) { v[j] = xr[64 * j]; s += (v[j][0] + v[j][1]) + (v[j][2] + v[j][3]); }
    const float mean = wave_sum(s) * (1.f / D); float s2 = 0.f;
#pragma unroll
    for (int j = 0; j < 4; ++j) { v[j] = v[j] - mean; s2 += (v[j][0] * v[j][0] + v[j][1] * v[j][1]) + (v[j][2] * v[j][2] + v[j][3] * v[j][3]); }
    const float rstd = 1.f / sqrtf(wave_sum(s2) * (1.f / D) + LN_EPS);
    u32x2* o8 = (u32x2*)orow + lane;
#pragma unroll
    for (int j = 0; j < 4; ++j) { const f32x4 gv = ((const f32x4*)g)[lane + 64 * j], bv = ((const f32x4*)b)[lane + 64 * j];
        const f32x4 o = v[j] * rstd * gv + bv; xr[64 * j] = o; u32x2 w; w.x = pkbf(o[0], o[1]); w.y = pkbf(o[2], o[3]); o8[64 * j] = w; }
}

__device__ __forceinline__ void ln_row_bf(bf16* xrow, float* fout, const float* g, const float* b, int lane) {
    u32x4* xr = (u32x4*)xrow + lane; float v[16]; float s = 0.f;
#pragma unroll
    for (int j = 0; j < 2; ++j) { const u32x4 t = xr[64 * j]; v[8 * j] = bf_lo(t.x); v[8 * j + 1] = bf_hi(t.x); v[8 * j + 2] = bf_lo(t.y); v[8 * j + 3] = bf_hi(t.y); v[8 * j + 4] = bf_lo(t.z); v[8 * j + 5] = bf_hi(t.z); v[8 * j + 6] = bf_lo(t.w); v[8 * j + 7] = bf_hi(t.w); }
#pragma unroll
    for (int e = 0; e < 16; ++e) s += v[e];
    const float mean = wave_sum(s) * (1.f / D); float s2 = 0.f;
#pragma unroll
    for (int e = 0; e < 16; ++e) { v[e] -= mean; s2 += v[e] * v[e]; }
    const float rstd = 1.f / sqrtf(wave_sum(s2) * (1.f / D) + LN_EPS);
#pragma unroll
    for (int j = 0; j < 2; ++j) { const int c = 512 * j + 8 * lane; const f32x4 g0 = *(const f32x4*)(g + c), g1 = *(const f32x4*)(g + c + 4), b0 = *(const f32x4*)(b + c), b1 = *(const f32x4*)(b + c + 4);
        const f32x4 o0 = {v[8 * j] * rstd * g0[0] + b0[0], v[8 * j + 1] * rstd * g0[1] + b0[1], v[8 * j + 2] * rstd * g0[2] + b0[2], v[8 * j + 3] * rstd * g0[3] + b0[3]};
        const f32x4 o1 = {v[8 * j + 4] * rstd * g1[0] + b1[0], v[8 * j + 5] * rstd * g1[1] + b1[1], v[8 * j + 6] * rstd * g1[2] + b1[2], v[8 * j + 7] * rstd * g1[3] + b1[3]};
        if (fout) { *(f32x4*)(fout + c) = o0; *(f32x4*)(fout + c + 4) = o1; }
        else { u32x4 w; w.x = pkbf(o0[0], o0[1]); w.y = pkbf(o0[2], o0[3]); w.z = pkbf(o1[0], o1[1]); w.w = pkbf(o1[2], o1[3]); xr[64 * j] = w; } }
}

__device__ __forceinline__ void seq_of_row(int m, int& s0, int& T) { if (m < MPROMPT) { s0 = m & ~2047; T = 2048; } else { s0 = MPROMPT + ((m - MPROMPT) & ~4095); T = 4096; } }
__device__ __forceinline__ void conv8(const bf16* raw, int m, int tl, int T, int c0, const float* cw, const float* cb, float (&o)[8]) {
    const f32x4 b0 = *(const f32x4*)(cb + c0), b1 = *(const f32x4*)(cb + c0 + 4);
    float a[8] = {b0[0], b0[1], b0[2], b0[3], b1[0], b1[1], b1[2], b1[3]};
#pragma unroll
    for (int j = 0; j < 5; ++j) { const int tt = tl + j - 2;
        if (tt >= 0 && tt < T) { const u32x4 v = *(const u32x4*)(raw + (size_t)(m + j - 2) * 1024 + c0);
            const f32x4 w0 = *(const f32x4*)(cw + j * 1024 + c0), w1 = *(const f32x4*)(cw + j * 1024 + c0 + 4);
            a[0] += bf_lo(v.x) * w0[0]; a[1] += bf_hi(v.x) * w0[1]; a[2] += bf_lo(v.y) * w0[2]; a[3] += bf_hi(v.y) * w0[3];
            a[4] += bf_lo(v.z) * w1[0]; a[5] += bf_hi(v.z) * w1[1]; a[6] += bf_lo(v.w) * w1[2]; a[7] += bf_hi(v.w) * w1[3]; } }
#pragma unroll
    for (int e = 0; e < 8; ++e) o[e] = silu_f(a[e]);
}
__device__ __forceinline__ float softplus_f(float x) { return x > 20.f ? x : log1pf(expf(x)); }

constexpr int SCAN_DIR_F = 10368;
__device__ __forceinline__ void scan_naive_unit(int b, int h, const bf16* raw, const float* DT, float* Y, const float* cw, const float* cb, const float* dt_bias, const float* a_log, const float* d_skip, LAS float* L, int tid, int wave, int lane) {
    int s0, T; if (b < 32) { s0 = b * 2048; T = 2048; } else { s0 = MPROMPT + (b - 32) * 4096; T = 4096; }
    const int g = h >> 2, dir = wave >> 2, pb = wave & 3, p = pb * 16 + (lane & 15), nq = lane >> 4;
    const float a = -expf(a_log[dir * 8 + h]), dskip = d_skip[h], dtb = dt_bias[dir * 8 + h];
    float s[32];
#pragma unroll
    for (int k = 0; k < 32; ++k) s[k] = 0.f;
    LAS float* Lw = L + dir * SCAN_DIR_F;
    const int nblk = T >> 5;
    for (int blk = 0; blk < nblk; ++blk) {
        __syncthreads();
        const int tbase = dir == 0 ? 32 * blk : T - 32 * (blk + 1);
        { const int r_ = tid & 255, tok = r_ >> 3, part = r_ & 7, tl = tbase + tok, m = s0 + tl; float o[8];
          conv8(raw, m, tl, T, 512 + 128 * g + 16 * part, cw, cb, o);
#pragma unroll
          for (int e = 0; e < 8; ++e) Lw[tok * 128 + 16 * part + e] = o[e];
          conv8(raw, m, tl, T, 512 + 128 * g + 16 * part + 8, cw, cb, o);
#pragma unroll
          for (int e = 0; e < 8; ++e) Lw[tok * 128 + 16 * part + 8 + e] = o[e];
          conv8(raw, m, tl, T, 768 + 128 * g + 16 * part, cw, cb, o);
#pragma unroll
          for (int e = 0; e < 8; ++e) Lw[4096 + tok * 128 + 16 * part + e] = o[e];
          conv8(raw, m, tl, T, 768 + 128 * g + 16 * part + 8, cw, cb, o);
#pragma unroll
          for (int e = 0; e < 8; ++e) Lw[4096 + tok * 128 + 16 * part + 8 + e] = o[e];
          conv8(raw, m, tl, T, h * 64 + 8 * part, cw, cb, o);
#pragma unroll
          for (int e = 0; e < 8; ++e) Lw[8192 + tok * 64 + 8 * part + e] = o[e];
          if (part == 0) { const float dtv = softplus_f(DT[(size_t)m * 16 + dir * 8 + h] + dtb); Lw[10240 + tok] = dtv; Lw[10272 + tok] = expf(dtv * a); }
        }
        __syncthreads();
        for (int i = 0; i < 32; ++i) {
            const int ti = dir == 0 ? i : 31 - i;
            const float d = Lw[10272 + ti], dtv = Lw[10240 + ti], xv = Lw[8192 + ti * 64 + p], xdt = xv * dtv;
            float y = 0.f;
#pragma unroll
            for (int k4 = 0; k4 < 8; ++k4) { const f32x4 bv = *(const LAS f32x4*)(Lw + ti * 128 + 32 * nq + 4 * k4), cv = *(const LAS f32x4*)(Lw + 4096 + ti * 128 + 32 * nq + 4 * k4);
#pragma unroll
                for (int e = 0; e < 4; ++e) { s[4 * k4 + e] = s[4 * k4 + e] * d + xdt * bv[e]; y += s[4 * k4 + e] * cv[e]; } }
            y += __shfl_xor(y, 16); y += __shfl_xor(y, 32);
            if (nq == 0) atomicAdd(Y + (size_t)(s0 + tbase + ti) * 512 + h * 64 + p, y + (dir == 0 ? dskip * xv : 0.f));
        }
    }
}

__device__ __forceinline__ void attn_naive_unit(int m, int wave, int lane, const bf16* QKV, const float* rpb, const float* gattn, bf16* MIX, LAS float* Ps, volatile LAS float* exch, int parity) {
    const int h = wave; int s0, T; seq_of_row(m, s0, T);
    const int tl = m - s0, r = tl >> 6, qc = tl & 63, rows = T >> 6;
    const int cstart = min(max(qc - 8, 0), 48), rs = min(max(r - 4, 0), rows - 8);
    float q[64];
    { const bf16* qp = QKV + (size_t)m * 1536 + h * 64;
#pragma unroll
      for (int i = 0; i < 8; ++i) { const u32x4 v = *(const u32x4*)(qp + 8 * i); q[8 * i] = bf_lo(v.x); q[8 * i + 1] = bf_hi(v.x); q[8 * i + 2] = bf_lo(v.y); q[8 * i + 3] = bf_hi(v.y);
          q[8 * i + 4] = bf_lo(v.z); q[8 * i + 5] = bf_hi(v.z); q[8 * i + 6] = bf_lo(v.w); q[8 * i + 7] = bf_hi(v.w); } }
    float sc[2];
#pragma unroll
    for (int k2 = 0; k2 < 2; ++k2) { const int kk = lane + 64 * k2, kri = kk >> 4, kci = kk & 15; const int kt = s0 + (rs + kri) * 64 + cstart + kci;
        const bf16* kp = QKV + (size_t)kt * 1536 + 512 + h * 64; float d = 0.f;
#pragma unroll
        for (int i = 0; i < 8; ++i) { const u32x4 v = *(const u32x4*)(kp + 8 * i);
            d += q[8 * i] * bf_lo(v.x) + q[8 * i + 1] * bf_hi(v.x) + q[8 * i + 2] * bf_lo(v.y) + q[8 * i + 3] * bf_hi(v.y) + q[8 * i + 4] * bf_lo(v.z) + q[8 * i + 5] * bf_hi(v.z) + q[8 * i + 6] * bf_lo(v.w) + q[8 * i + 7] * bf_hi(v.w); }
        sc[k2] = d + rpb[h * 465 + (rs + kri - r + 7) * 31 + (cstart + kci - qc + 15)]; }
    const float mx = wave_max(fmaxf(sc[0], sc[1]));
    const float p0 = __expf(sc[0] - mx), p1 = __expf(sc[1] - mx);
    const float inv = 1.f / wave_sum(p0 + p1);
    Ps[lane] = p0 * inv; Ps[lane + 64] = p1 * inv;
    LDS_WAIT(); asm volatile("" ::: "memory");
    float o = 0.f; const bf16* vbase = QKV + 1024 + h * 64 + lane;
#pragma unroll 4
    for (int kk = 0; kk < 128; kk += 4) { const f32x4 pv = *(const LAS f32x4*)(Ps + kk); const int kt = s0 + (rs + (kk >> 4)) * 64 + cstart + (kk & 15);
#pragma unroll
        for (int e = 0; e < 4; ++e) o += pv[e] * bf2f(vbase[(size_t)(kt + e) * 1536]); }
    const float ssq = wave_sum(o * o);
    if (lane == 0) exch[parity * 8 + h] = ssq;
    __syncthreads();
    float tot = 0.f;
#pragma unroll
    for (int i = 0; i < 8; ++i) tot += exch[parity * 8 + i];
    const float scl = 1.f / sqrtf(tot * (1.f / 512.f) + RMS_EPS);
    MIX[(size_t)m * 1024 + h * 64 + lane] = f2bf(o * scl * gattn[h * 64 + lane]);
}


typedef short bf16x8v __attribute__((ext_vector_type(8)));
typedef short s16x4v __attribute__((ext_vector_type(4)));
#define MFMA16(a, b, c) __builtin_amdgcn_mfma_f32_16x16x32_bf16((a), (b), (c), 0, 0, 0)
constexpr int VPITCH = 144, VHEAD = 512 * VPITCH;
__device__ __forceinline__ void attn_fast_unit(int u, const bf16* QKV, const float* TB  , const float* gattn, bf16* MIX, float* SSQA, LAS unsigned char* lds, int tid, int wave, int lane, int& vkey, int& vhi) {
    const int hp = u / 1280, gr = u % 1280;
    int s0, rows, r;
    if (gr < 1024) { s0 = (gr >> 5) * 2048; r = gr & 31; rows = 32; } else { const int g2 = gr - 1024; s0 = MPROMPT + (g2 >> 6) * 4096; r = g2 & 63; rows = 64; }
    const int rs = min(max(r - 4, 0), rows - 8);
    const int key = (s0 >> 11) * 4 + hp;
    int first = rs;
    if (key == vkey && vhi > rs && vhi <= rs + 8) first = vhi;
    vkey = key; vhi = rs + 8;
    if (first == rs) {
        __syncthreads();
        { u32x4 v[16];
#pragma unroll
          for (int i = 0; i < 16; ++i) { const int id = i * 512 + tid, c = id & 7, kk_ = (id >> 3) & 511, hh_ = id >> 12;
              v[i] = *(const u32x4*)(QKV + (size_t)(s0 + rs * 64 + kk_) * 1536 + 1024 + (2 * hp + hh_) * 64 + 8 * c); }
#pragma unroll
          for (int i = 0; i < 16; ++i) { const int id = i * 512 + tid, c = id & 7, kk_ = (id >> 3) & 511, hh_ = id >> 12; const int krow = rs + (kk_ >> 6);
              *(LAS u32x4*)(lds + hh_ * VHEAD + ((krow & 7) * 64 + (kk_ & 63)) * VPITCH + 16 * c) = v[i]; } }
        __syncthreads();
    } else if (first < rs + 8) {
        __syncthreads();
        for (int krow = first; krow < rs + 8; ++krow) { u32x4 v[2];
#pragma unroll
            for (int i = 0; i < 2; ++i) { const int id = i * 512 + tid, c = id & 7, col = (id >> 3) & 63, hh_ = id >> 9;
                v[i] = *(const u32x4*)(QKV + (size_t)(s0 + krow * 64 + col) * 1536 + 1024 + (2 * hp + hh_) * 64 + 8 * c); }
#pragma unroll
            for (int i = 0; i < 2; ++i) { const int id = i * 512 + tid, c = id & 7, col = (id >> 3) & 63, hh_ = id >> 9;
                *(LAS u32x4*)(lds + hh_ * VHEAD + ((krow & 7) * 64 + col) * VPITCH + 16 * c) = v[i]; } }
        __syncthreads();
    }
    const int hh = wave >> 2, j = wave & 3, h = 2 * hp + hh, fr = lane & 15, fq = lane >> 4;
    const int kstart = j == 0 ? 0 : (j == 1 ? 8 : (j == 2 ? 24 : 32));
    const int qtok = s0 + r * 64 + 16 * j + fr;
    const bf16x8v q0 = *(const bf16x8v*)(QKV + (size_t)qtok * 1536 + h * 64 + 8 * fq), q1 = *(const bf16x8v*)(QKV + (size_t)qtok * 1536 + h * 64 + 32 + 8 * fq);
    f32x4 sacc[16];
    const float* tb = TB + (size_t)((h * 4 + j) * 15 + (rs - r + 7)) * 512 + fr * 32 + 4 * fq;
#pragma unroll
    for (int kt = 0; kt < 16; ++kt) { const int kri = kt >> 1; const size_t ktok = (size_t)(s0 + (rs + kri) * 64 + kstart + 16 * (kt & 1) + fr);
        const bf16x8v k0 = *(const bf16x8v*)(QKV + ktok * 1536 + 512 + h * 64 + 8 * fq), k1 = *(const bf16x8v*)(QKV + ktok * 1536 + 512 + h * 64 + 32 + 8 * fq);
        f32x4 a = {0.f, 0.f, 0.f, 0.f}; a = MFMA16(k0, q0, a); a = MFMA16(k1, q1, a);
        sacc[kt] = a + *(const f32x4*)(tb + kri * 512 + 16 * (kt & 1)); }
    float mx = -INFINITY;
#pragma unroll
    for (int kt = 0; kt < 16; ++kt) mx = fmaxf(mx, fmaxf(fmaxf(sacc[kt][0], sacc[kt][1]), fmaxf(sacc[kt][2], sacc[kt][3])));
    mx = fmaxf(mx, __shfl_xor(mx, 16)); mx = fmaxf(mx, __shfl_xor(mx, 32));
    float l = 0.f;
#pragma unroll
    for (int kt = 0; kt < 16; ++kt) {
#pragma unroll
        for (int i = 0; i < 4; ++i) { const float pz = __builtin_amdgcn_exp2f(sacc[kt][i] - mx); sacc[kt][i] = pz; l += pz; } }
    l += __shfl_xor(l, 16); l += __shfl_xor(l, 32);
    f32x4 o[4];
#pragma unroll
    for (int dt = 0; dt < 4; ++dt) o[dt] = (f32x4){0.f, 0.f, 0.f, 0.f};
    const LAS unsigned char* vb = lds + hh * VHEAD + (kstart + 4 * fq + ((lane & 15) >> 2)) * VPITCH + 8 * (lane & 3);
#pragma unroll
    for (int ks = 0; ks < 8; ++ks) {
        u32x4 pw; pw.x = pkbf(sacc[2 * ks][0], sacc[2 * ks][1]); pw.y = pkbf(sacc[2 * ks][2], sacc[2 * ks][3]); pw.z = pkbf(sacc[2 * ks + 1][0], sacc[2 * ks + 1][1]); pw.w = pkbf(sacc[2 * ks + 1][2], sacc[2 * ks + 1][3]);
        const bf16x8v pf = __builtin_bit_cast(bf16x8v, pw);
#pragma unroll
        for (int dt = 0; dt < 4; ++dt) {
            const int slot = ((rs + ks) & 7) * 64;
            const s16x4v lo = __builtin_amdgcn_ds_read_tr16_b64_v4i16((LAS s16x4v*)(vb + slot * VPITCH + 32 * dt));
            const s16x4v hi = __builtin_amdgcn_ds_read_tr16_b64_v4i16((LAS s16x4v*)(vb + (slot + 16) * VPITCH + 32 * dt));
            const bf16x8v vf = __builtin_shufflevector(lo, hi, 0, 1, 2, 3, 4, 5, 6, 7);
            o[dt] = MFMA16(vf, pf, o[dt]); } }
    const float inv = 1.f / l; float ssq = 0.f;
#pragma unroll
    for (int dt = 0; dt < 4; ++dt) { o[dt] = o[dt] * inv; ssq += (o[dt][0] * o[dt][0] + o[dt][1] * o[dt][1]) + (o[dt][2] * o[dt][2] + o[dt][3] * o[dt][3]); }
    ssq += __shfl_xor(ssq, 16); ssq += __shfl_xor(ssq, 32);
    if (fq == 0) atomicAdd(SSQA + qtok, ssq);
#pragma unroll
    for (int dt = 0; dt < 4; ++dt) { const f32x4 gv = *(const f32x4*)(gattn + h * 64 + 16 * dt + 4 * fq); const f32x4 ov = o[dt] * gv;
        u32x2 w; w.x = pkbf(ov[0], ov[1]); w.y = pkbf(ov[2], ov[3]); *(u32x2*)(MIX + (size_t)qtok * 1024 + h * 64 + 16 * dt + 4 * fq) = w; }
}

typedef float f32x16 __attribute__((ext_vector_type(16)));
#define MFMA32(a, b, c) __builtin_amdgcn_mfma_f32_32x32x16_bf16((a), (b), (c), 0, 0, 0)
constexpr float LOG2E = 1.4426950408889634f;
constexpr int TPITCH = 272;
__device__ __forceinline__ void conv_item(int it, const bf16* RAW, const float* DTraw, const float* cw, const float* cb, const float* dt_bias, const float* a_log,
                                          bf16* XT, bf16* BT, bf16* BTOK, bf16* CTOK, float* CUM, float* DTA, float* WST, LAS unsigned char* lds, int tid, int wave, int lane) {
    const int ck = it >> 3, sl = it & 7, m0 = ck * 128; int s0, T; seq_of_row(m0, s0, T); const int tl0 = m0 - s0;
    const int cg = tid & 15, tg = tid >> 4, c0 = 128 * sl + 8 * cg;
    float x[8][8];
#pragma unroll
    for (int i = 0; i < 8; ++i) { const int tt = tl0 + 4 * tg - 2 + i; u32x4 v = {0u, 0u, 0u, 0u};
        if (tt >= 0 && tt < T) v = *(const u32x4*)(RAW + (size_t)(s0 + tt) * 1024 + c0);
        x[i][0] = bf_lo(v.x); x[i][1] = bf_hi(v.x); x[i][2] = bf_lo(v.y); x[i][3] = bf_hi(v.y); x[i][4] = bf_lo(v.z); x[i][5] = bf_hi(v.z); x[i][6] = bf_lo(v.w); x[i][7] = bf_hi(v.w); }
    float o[4][8];
    { const f32x4 b0 = *(const f32x4*)(cb + c0), b1 = *(const f32x4*)(cb + c0 + 4);
#pragma unroll
      for (int tk = 0; tk < 4; ++tk) { o[tk][0] = b0[0]; o[tk][1] = b0[1]; o[tk][2] = b0[2]; o[tk][3] = b0[3]; o[tk][4] = b1[0]; o[tk][5] = b1[1]; o[tk][6] = b1[2]; o[tk][7] = b1[3]; }
#pragma unroll
      for (int j = 0; j < 5; ++j) { const f32x4 w0 = *(const f32x4*)(cw + j * 1024 + c0), w1 = *(const f32x4*)(cw + j * 1024 + c0 + 4);
#pragma unroll
          for (int tk = 0; tk < 4; ++tk) { o[tk][0] += x[tk + j][0] * w0[0]; o[tk][1] += x[tk + j][1] * w0[1]; o[tk][2] += x[tk + j][2] * w0[2]; o[tk][3] += x[tk + j][3] * w0[3];
              o[tk][4] += x[tk + j][4] * w1[0]; o[tk][5] += x[tk + j][5] * w1[1]; o[tk][6] += x[tk + j][6] * w1[2]; o[tk][7] += x[tk + j][7] * w1[3]; } }
#pragma unroll
      for (int tk = 0; tk < 4; ++tk)
#pragma unroll
          for (int e = 0; e < 8; ++e) o[tk][e] = silu_f(o[tk][e]); }
    __syncthreads();
    if (sl >= 4) { bf16* dst = (sl < 6 ? BTOK : CTOK) + (size_t)(m0 + 4 * tg) * 256 + 128 * (sl & 1) + 8 * cg;
#pragma unroll
        for (int tk = 0; tk < 4; ++tk) { u32x4 w; w.x = pkbf(o[tk][0], o[tk][1]); w.y = pkbf(o[tk][2], o[tk][3]); w.z = pkbf(o[tk][4], o[tk][5]); w.w = pkbf(o[tk][6], o[tk][7]); *(u32x4*)(dst + (size_t)tk * 256) = w; } }
    if (sl < 6) {
#pragma unroll
        for (int e = 0; e < 8; ++e) { u32x2 w; w.x = pkbf(o[0][e], o[1][e]); w.y = pkbf(o[2][e], o[3][e]); *(LAS u32x2*)(lds + (8 * cg + e) * TPITCH + 8 * tg) = w; }
        __syncthreads();
        bf16* dbase = sl < 4 ? XT + ((size_t)ck * 16 + 4 * sl) * 4096 : BT + ((size_t)ck * 8 + 4 * (sl - 4)) * 4096;
#pragma unroll
        for (int i = 0; i < 4; ++i) { const int r_ = tid & 31, pc = (tid >> 5) & 15;
            *(u32x4*)(dbase + (size_t)i * 4096 + (pc * 32 + r_) * 8) = *(const LAS u32x4*)(lds + (32 * i + r_) * TPITCH + 16 * pc); }
    }
    if (sl == 0) {
#pragma unroll
        for (int q = 0; q < 2; ++q) { const int sr = 2 * wave + q, dir = sr >> 3;
            const float a = -expf(a_log[sr]) * LOG2E, bias = dt_bias[sr];
            const float dt0 = softplus_f(DTraw[(size_t)(m0 + 2 * lane) * 16 + sr] + bias), dt1 = softplus_f(DTraw[(size_t)(m0 + 2 * lane + 1) * 16 + sr] + bias);
            const float v0 = dt0 * a, v1 = dt1 * a; float inc = v0 + v1;
#pragma unroll
            for (int ofs = 1; ofs < 64; ofs <<= 1) { const float t = __shfl_up(inc, ofs); if (lane >= ofs) inc += t; }
            const float excl = inc - (v0 + v1), total = __shfl(inc, 63);
            float c0_, c1_;
            if (dir == 0) { c0_ = excl + v0; c1_ = inc; } else { c0_ = total - excl; c1_ = total - excl - v0; }
            const float tot = total;
            const size_t off = ((size_t)ck * 16 + sr) * 128 + 2 * lane;
            *(pg8::f32x2e*)(CUM + off) = (pg8::f32x2e){c0_, c1_}; *(pg8::f32x2e*)(DTA + off) = (pg8::f32x2e){dt0, dt1};
            ((unsigned*)WST)[off >> 1] = pkbf(__builtin_amdgcn_exp2f(tot - c0_) * dt0, __builtin_amdgcn_exp2f(tot - c1_) * dt1); }
    }
}
__device__ __forceinline__ void s12_unit(int u, const bf16* XT, const bf16* BT, const float* CUM, const bf16* WSTb, bf16* PREV, int nt, int lane) {
    int b, h, dir, c0, nc;
    if (u < 64) { b = u >> 4; h = (u & 15) >> 1; dir = u & 1; c0 = 512 + b * 32; nc = 32; } else { const int v = u - 64; b = v >> 4; h = (v & 15) >> 1; dir = v & 1; c0 = b * 16; nc = 16; }
    const int g = h >> 2, sr = dir * 8 + h, r = lane & 31, hh = lane >> 5;
    f32x16 prev[2];
#pragma unroll
    for (int pt = 0; pt < 2; ++pt)
#pragma unroll
        for (int i = 0; i < 16; ++i) prev[pt][i] = 0.f;
    for (int ci = 0; ci < nc; ++ci) { const int ck = dir == 0 ? c0 + ci : c0 + nc - 1 - ci;
        const bf16* bp = BT + ((size_t)ck * 8 + 4 * g + nt) * 4096 + (hh * 32 + r) * 8;
        const bf16* xp = XT + ((size_t)ck * 16 + 2 * h) * 4096 + (hh * 32 + r) * 8;
        const bf16* wp = WSTb + ((size_t)ck * 16 + sr) * 128 + 8 * hh;
        bf16x8v bf[8]; u32x4 xr[2][8], wv[8];
#pragma unroll
        for (int kk = 0; kk < 8; ++kk) { bf[kk] = *(const bf16x8v*)(bp + kk * 512); xr[0][kk] = *(const u32x4*)(xp + kk * 512); xr[1][kk] = *(const u32x4*)(xp + 4096 + kk * 512); wv[kk] = *(const u32x4*)(wp + 16 * kk); }
        const float cd = __builtin_amdgcn_exp2f(CUM[((size_t)ck * 16 + sr) * 128 + (dir == 0 ? 127 : 0)]);
#pragma unroll
        for (int pt = 0; pt < 2; ++pt) {
            bf16* pp = PREV + (((size_t)ck * 8 + h) * 2 + dir) * 8192 + pt * 4096 + r * 8 + 4 * hh;
#pragma unroll
            for (int q = 0; q < 4; ++q) { u32x2 w; w.x = pkbf(prev[pt][4 * q], prev[pt][4 * q + 1]); w.y = pkbf(prev[pt][4 * q + 2], prev[pt][4 * q + 3]);
                *(u32x2*)(pp + ((2 * nt + (q >> 1)) * 2 + (q & 1)) * 256) = w; }
            f32x16 st;
#pragma unroll
            for (int i = 0; i < 16; ++i) st[i] = 0.f;
#pragma unroll
            for (int kk = 0; kk < 8; ++kk) { const u32x4 x_ = xr[pt][kk], w_ = wv[kk];
                u32x4 xw; xw.x = pkbf(bf_lo(x_.x) * bf_lo(w_.x), bf_hi(x_.x) * bf_hi(w_.x)); xw.y = pkbf(bf_lo(x_.y) * bf_lo(w_.y), bf_hi(x_.y) * bf_hi(w_.y));
                xw.z = pkbf(bf_lo(x_.z) * bf_lo(w_.z), bf_hi(x_.z) * bf_hi(w_.z)); xw.w = pkbf(bf_lo(x_.w) * bf_lo(w_.w), bf_hi(x_.w) * bf_hi(w_.w));
                st = MFMA32(bf[kk], __builtin_bit_cast(bf16x8v, xw), st); }
            prev[pt] = prev[pt] * cd + st; }
    }
}
constexpr int S3_BM = 0, S3_CM = 34816, S3_XT = 69632, S3_CUM = 139264, S3_DT = 143360;
__device__ __forceinline__ void s3_unit(int u, const bf16* XT, const bf16* BTOK, const bf16* CTOK, const float* CUM, const float* DTA, const bf16* PREV, const bf16* Zb, const float* d_skip, const float* gssm,
                                        bf16* MIX, float* SSQS, LAS unsigned char* lds, int tid, int wave, int lane_) {
    int lane = lane_; asm volatile("" : "+v"(lane));
    const int ck = u >> 1, g = u & 1, m0 = ck * 128;
    __syncthreads();
    { asm volatile("" : "+v"(tid));
      u32x4 vb[4], vc[4], vx[8];
#pragma unroll
      for (int i = 0; i < 4; ++i) { const int id = i * 512 + tid, row = id >> 4, pc = id & 15; vb[i] = *(const u32x4*)(BTOK + (size_t)(m0 + row) * 256 + 128 * g + 8 * pc); vc[i] = *(const u32x4*)(CTOK + (size_t)(m0 + row) * 256 + 128 * g + 8 * pc); }
#pragma unroll
      for (int i = 0; i < 8; ++i) { const int r_ = tid & 31, pc = (tid >> 5) & 15; vx[i] = *(const u32x4*)(XT + ((size_t)ck * 16 + 8 * g + i) * 4096 + (pc * 32 + r_) * 8); }
      const int a4 = tid & 255, hl_ = a4 >> 6, dr_ = (a4 >> 5) & 1, e4 = a4 & 31;
      const f32x4 vs = *(const f32x4*)((tid < 256 ? CUM : DTA) + ((size_t)ck * 16 + dr_ * 8 + 4 * g + hl_) * 128 + 4 * e4);
#pragma unroll
      for (int i = 0; i < 4; ++i) { const int id = i * 512 + tid, row = id >> 4, pc = id & 15; *(LAS u32x4*)(lds + S3_BM + row * TPITCH + 16 * pc) = vb[i]; *(LAS u32x4*)(lds + S3_CM + row * TPITCH + 16 * pc) = vc[i]; }
#pragma unroll
      for (int i = 0; i < 8; ++i) { const int r_ = tid & 31, pc = (tid >> 5) & 15; *(LAS u32x4*)(lds + S3_XT + (32 * i + r_) * TPITCH + 16 * pc) = vx[i]; }
      *(LAS f32x4*)(lds + (tid < 256 ? S3_CUM : S3_DT) + ((hl_ * 2 + dr_) * 128 + 4 * e4) * 4) = vs; }
    __syncthreads();
    const int hl = wave >> 1, half = wave & 1, h = 4 * g + hl, r = lane & 31, hh = lane >> 5;
    const float dskip = d_skip[h];
    const LAS float* cumf = (const LAS float*)(lds + S3_CUM) + (hl * 2) * 128; const LAS float* cumb = cumf + 128;
    const LAS float* dtf = (const LAS float*)(lds + S3_DT) + (hl * 2) * 128; const LAS float* dtb = dtf + 128;
    for (int lbi = 0; lbi < 2; ++lbi) { const int lb = 2 * half + lbi, l = 32 * lb + r;
        const float Af_l = cumf[l], Sb_l = cumb[l];
        const size_t mrow = (size_t)(m0 + l);
        bf16x8v pf0[2][8], pf1[2][8]; u32x2 zq[2][4];
#pragma unroll
        for (int pb = 0; pb < 2; ++pb) { const bf16* pp = PREV + (((size_t)ck * 8 + h) * 2 + 0) * 8192 + pb * 4096 + (hh * 32 + r) * 8;
#pragma unroll
            for (int kk = 0; kk < 8; ++kk) pf0[pb][kk] = *(const bf16x8v*)(pp + kk * 512); }
#pragma unroll
        for (int pb = 0; pb < 2; ++pb)
#pragma unroll
            for (int q = 0; q < 4; ++q) zq[pb][q] = *(const u32x2*)(Zb + mrow * 512 + h * 64 + 32 * pb + 8 * q + 4 * hh);
        bf16x8v cf[8];
#pragma unroll
        for (int kk = 0; kk < 8; ++kk) cf[kk] = *(const LAS bf16x8v*)(lds + S3_CM + l * TPITCH + 32 * kk + 16 * hh);
        f32x16 yacc[2];
#pragma unroll
        for (int pb = 0; pb < 2; ++pb)
#pragma unroll
            for (int i = 0; i < 16; ++i) yacc[pb][i] = 0.f;
#pragma unroll 1
        for (int sb = 0; sb < 4; ++sb) {
            f32x16 cbt;
#pragma unroll
            for (int i = 0; i < 16; ++i) cbt[i] = 0.f;
#pragma unroll
            for (int kk = 0; kk < 8; ++kk) { const bf16x8v bmf = *(const LAS bf16x8v*)(lds + S3_BM + (32 * sb + r) * TPITCH + 32 * kk + 16 * hh); cbt = MFMA32(bmf, cf[kk], cbt); }
#pragma unroll
            for (int q = 0; q < 4; ++q) { const int sbase = 32 * sb + 8 * q + 4 * hh;
                const f32x4 af = *(const LAS f32x4*)(cumf + sbase), sbv = *(const LAS f32x4*)(cumb + sbase), df = *(const LAS f32x4*)(dtf + sbase), db = *(const LAS f32x4*)(dtb + sbase);
#pragma unroll
                for (int e = 0; e < 4; ++e) { const int sidx = sbase + e;
                    const float fw = sidx <= l ? __builtin_amdgcn_exp2f(Af_l - af[e]) * df[e] : 0.f;
                    const float bw = sidx >= l ? __builtin_amdgcn_exp2f(Sb_l - sbv[e]) * db[e] : 0.f;
                    cbt[4 * q + e] = cbt[4 * q + e] * (fw + bw) + (sidx == l ? dskip : 0.f); } }
#pragma unroll
            for (int ks = 0; ks < 2; ++ks) {
                u32x4 gw_; gw_.x = pkbf(cbt[8 * ks], cbt[8 * ks + 1]); gw_.y = pkbf(cbt[8 * ks + 2], cbt[8 * ks + 3]); gw_.z = pkbf(cbt[8 * ks + 4], cbt[8 * ks + 5]); gw_.w = pkbf(cbt[8 * ks + 6], cbt[8 * ks + 7]);
                const bf16x8v gf = __builtin_bit_cast(bf16x8v, gw_);
#pragma unroll
                for (int pb = 0; pb < 2; ++pb) { const LAS unsigned char* xa = lds + S3_XT + (64 * hl + 32 * pb + r) * TPITCH + 2 * (32 * sb + 16 * ks + 4 * hh);
                    const s16x4v lo = *(const LAS s16x4v*)xa, hi = *(const LAS s16x4v*)(xa + 16);
                    yacc[pb] = MFMA32(__builtin_shufflevector(lo, hi, 0, 1, 2, 3, 4, 5, 6, 7), gf, yacc[pb]); } }
        }
#pragma unroll
        for (int pb = 0; pb < 2; ++pb) { const bf16* pp = PREV + (((size_t)ck * 8 + h) * 2 + 1) * 8192 + pb * 4096 + (hh * 32 + r) * 8;
#pragma unroll
            for (int kk = 0; kk < 8; ++kk) pf1[pb][kk] = *(const bf16x8v*)(pp + kk * 512); }
#pragma unroll
        for (int dir = 0; dir < 2; ++dir) { const float el = __builtin_amdgcn_exp2f(dir == 0 ? Af_l : Sb_l);
#pragma unroll
            for (int pb = 0; pb < 2; ++pb) { f32x16 ua;
#pragma unroll
                for (int i = 0; i < 16; ++i) ua[i] = 0.f;
#pragma unroll
                for (int kk = 0; kk < 8; ++kk) ua = MFMA32(dir == 0 ? pf0[pb][kk] : pf1[pb][kk], cf[kk], ua);
                yacc[pb] = yacc[pb] + ua * el; } }
        float ssq = 0.f;
#pragma unroll
        for (int pb = 0; pb < 2; ++pb)
#pragma unroll
            for (int q = 0; q < 4; ++q) { const int pc = h * 64 + 32 * pb + 8 * q + 4 * hh; const u32x2 zv = zq[pb][q]; const f32x4 gv = *(const f32x4*)(gssm + pc);
                const float v0 = yacc[pb][4 * q] * silu_f(bf_lo(zv.x)), v1 = yacc[pb][4 * q + 1] * silu_f(bf_hi(zv.x)), v2 = yacc[pb][4 * q + 2] * silu_f(bf_lo(zv.y)), v3 = yacc[pb][4 * q + 3] * silu_f(bf_hi(zv.y));
                ssq += (v0 * v0 + v1 * v1) + (v2 * v2 + v3 * v3);
                u32x2 w; w.x = pkbf(v0 * gv[0], v1 * gv[1]); w.y = pkbf(v2 * gv[2], v3 * gv[3]); *(u32x2*)(MIX + mrow * 1024 + 512 + pc) = w; }
        ssq += __shfl_xor(ssq, 32);
        if (hh == 0) atomicAdd(SSQS + mrow, ssq);
    }
}

__device__ __forceinline__ void gate_norm_row(int m, int lane, const float* Y, const bf16* Z, const float* g, bf16* MIX) {
    const f32x4 y0 = *(const f32x4*)(Y + (size_t)m * 512 + 8 * lane), y1 = *(const f32x4*)(Y + (size_t)m * 512 + 8 * lane + 4);
    const u32x4 zv = *(const u32x4*)(Z + (size_t)m * 512 + 8 * lane);
    float v[8] = {y0[0] * silu_f(bf_lo(zv.x)), y0[1] * silu_f(bf_hi(zv.x)), y0[2] * silu_f(bf_lo(zv.y)), y0[3] * silu_f(bf_hi(zv.y)),
                  y1[0] * silu_f(bf_lo(zv.z)), y1[1] * silu_f(bf_hi(zv.z)), y1[2] * silu_f(bf_lo(zv.w)), y1[3] * silu_f(bf_hi(zv.w))};
    float ss = 0.f;
#pragma unroll
    for (int e = 0; e < 8; ++e) ss += v[e] * v[e];
    const float scl = 1.f / sqrtf(wave_sum(ss) * (1.f / 512.f) + RMS_EPS);
    const f32x4 g0 = *(const f32x4*)(g + 8 * lane), g1 = *(const f32x4*)(g + 8 * lane + 4);
    u32x4 w; w.x = pkbf(v[0] * scl * g0[0], v[1] * scl * g0[1]); w.y = pkbf(v[2] * scl * g0[2], v[3] * scl * g0[3]);
    w.z = pkbf(v[4] * scl * g1[0], v[5] * scl * g1[1]); w.w = pkbf(v[6] * scl * g1[2], v[7] * scl * g1[3]);
    *(u32x4*)(MIX + (size_t)m * 1024 + 512 + 8 * lane) = w;
}

#define XB_TMO      128
#define XB_XCNT(j)  (256  + 64 * (j))
#define XB_XSUB(j)  (1280 + 64 * (j))
#define XB_XGEN(j)  (2304 + 64 * (j))
#define XB_TOP      3328
#define XB_TOPGEN   3392
#define XCD_BAR_WORDS 3456
#define XB_SPIN_CAP (1u << 18)

__device__ __forceinline__ unsigned xb_ld(unsigned* p)              { return __hip_atomic_load(p, __ATOMIC_RELAXED, __HIP_MEMORY_SCOPE_AGENT); }
__device__ __forceinline__ unsigned xb_add(unsigned* p, unsigned v) { return __hip_atomic_fetch_add(p, v, __ATOMIC_RELAXED, __HIP_MEMORY_SCOPE_AGENT); }
__device__ __forceinline__ unsigned xb_xcc_id() { return (unsigned)__builtin_amdgcn_s_getreg((3 << 11) | 20) & 0xFu; }
#define XB_SPIN(cond, bar) do { unsigned _sp = 0; while (cond) { __builtin_amdgcn_s_sleep(1); \
    if ((++_sp & 255u) == 0u) { if (xb_ld(&(bar)[XB_TMO])) break; if (_sp > XB_SPIN_CAP) { atomicAdd(&(bar)[XB_TMO], 1u); break; } } } } while (0)

struct XcdBarrier {
    unsigned* bar; unsigned x;
    volatile LAS unsigned* st;
};

__device__ __forceinline__ XcdBarrier xcd_barrier_post(unsigned* bar, volatile LAS unsigned* st) {
    XcdBarrier b; b.bar = bar; b.x = xb_xcc_id(); b.st = st;
    if (threadIdx.x == 0) (void)xb_add(&bar[XB_XCNT(b.x)], 1u);
    return b;
}
__device__ __forceinline__ void xcd_barrier_complete(unsigned* bar, unsigned x, unsigned& nloc, unsigned& nx) {
    const unsigned G = gridDim.x * gridDim.y * gridDim.z;
    unsigned sum, cnt, mine, sp = 0u;
    for (;;) {
        sum = 0u; cnt = 0u; mine = 0u;
#pragma unroll
        for (unsigned j = 0; j < 16; ++j) { const unsigned c = xb_ld(&bar[XB_XCNT(j)]); sum += c; cnt += (c > 0u) ? 1u : 0u; mine = (j == x) ? c : mine; }
        if (sum == G) break;
        __builtin_amdgcn_s_sleep(1);
        if ((++sp & 255u) == 0u) { if (xb_ld(&bar[XB_TMO])) break; if (sp > XB_SPIN_CAP) { atomicAdd(&bar[XB_TMO], 1u); break; } }
    }
    nloc = mine > 0u ? mine : 1u; nx = cnt > 0u ? cnt : 1u;
}

__device__ __forceinline__ void xcd_barrier(const XcdBarrier& b) {
    asm volatile("s_waitcnt vmcnt(0)" ::: "memory");
    __syncthreads();
    if (threadIdx.x == 0) {
        unsigned* bar = b.bar;
        __builtin_amdgcn_s_waitcnt(0);
        unsigned nloc = b.st[0], nx = b.st[1];
        if (nloc == 0u) { xcd_barrier_complete(bar, b.x, nloc, nx); b.st[0] = nloc; b.st[1] = nx; }
        const unsigned old = xb_add(&bar[XB_XSUB(b.x)], 1u);
        const unsigned gen = old / nloc;
        if (old + 1u == (gen + 1u) * nloc) {
            __builtin_amdgcn_fence(__ATOMIC_RELEASE, "agent");
            asm volatile("s_waitcnt vmcnt(0)" ::: "memory");
            const unsigned og = xb_add(&bar[XB_TOP], 1u);
            const unsigned tg = og / nx;
            if (og + 1u == (tg + 1u) * nx) xb_add(&bar[XB_TOPGEN], 1u);
            else XB_SPIN(xb_ld(&bar[XB_TOPGEN]) == tg, bar);
            __builtin_amdgcn_fence(__ATOMIC_ACQUIRE, "agent");
            xb_add(&bar[XB_XGEN(b.x)], 1u);
            asm volatile("s_waitcnt vmcnt(0)" ::: "memory");
        } else {
            XB_SPIN(xb_ld(&bar[XB_XGEN(b.x)]) == gen, bar);
            __builtin_amdgcn_fence(__ATOMIC_ACQUIRE, "agent");
            asm volatile("s_waitcnt vmcnt(0)" ::: "memory");
        }
    }
    __syncthreads();
}

#define FRESH_IDS() int tid = threadIdx.x; asm volatile("" : "+v"(tid)); int G = gridDim.x, bx = blockIdx.x; asm volatile("" : "+s"(G), "+s"(bx)); \
    const int lane = tid & 63, wave = __builtin_amdgcn_readfirstlane(tid >> 6), gw = bx * NWAVES + wave, NGW = G * NWAVES; (void)gw; (void)lane; (void)NGW; \
    unsigned char* ws = KWS(); float* out = KOUT(); (void)out; \
    bf16* XB = (bf16*)(ws + WS_XB); bf16* Hb = (bf16*)(ws + WS_H); bf16* QKV = (bf16*)(ws + WS_QKV); bf16* Zb = (bf16*)(ws + WS_Z); bf16* RAW = (bf16*)(ws + WS_RAW); \
    float* Yb = (float*)(ws + WS_Y); float* DTb = (float*)(ws + WS_DT); (void)XB; (void)Hb; (void)QKV; (void)Zb; (void)RAW; (void)Yb; (void)DTb
template <int l> __device__ __forceinline__ void layer_body(LAS unsigned char* lds, const XcdBarrier& xb) {
        { FRESH_IDS(); pg8::Gemm g{XB, (const bf16*)(ws + WS_W + (size_t)l * W_LAYER + OW_GU1), M, NGU, D}; pg8::StaticOrder S; S.init(M, NGU, (int)gridDim.x, (int)blockIdx.x); pg8::EpiSwiGLU E{Hb, FF};
          pg8::gemm_phase<pg8::EpiSwiGLU, pg8::StaticOrder, true, true>(lds, g, S, E); }
        xcd_barrier(xb);
        { FRESH_IDS(); pg8::Gemm g{Hb, (const bf16*)(ws + WS_W + (size_t)l * W_LAYER + OW_D1), M, D, FF}; pg8::StaticOrder S; S.init(M, D, (int)gridDim.x, (int)blockIdx.x);
          pg8::EpiResidBf E{XB, 0.5f};
          pg8::gemm_phase<pg8::EpiResidBf, pg8::StaticOrder, true, true>(lds, g, S, E); }
        xcd_barrier(xb);
        { FRESH_IDS(); const float* g_ = KIN(5) + l * D; const float* b_ = KIN(6) + l * D;
          for (int m = gw; m < M; m += NGW) ln_row_bf(XB + (size_t)m * D, nullptr, g_, b_, lane);
          const f32x4 z4 = {0.f, 0.f, 0.f, 0.f};
          f32x4* sz = (f32x4*)(ws + WS_SSQ); for (int i = bx * NT + tid; i < 2 * M / 4; i += G * NT) sz[i] = z4; }
        xcd_barrier(xb);
        { FRESH_IDS(); pg8::Gemm g{XB, (const bf16*)(ws + WS_W + (size_t)l * W_LAYER + OW_IN), M, NIN, D}; pg8::StaticOrder S; S.init(M, NIN, (int)gridDim.x, (int)blockIdx.x); pg8::EpiProj E{QKV, Zb, RAW, DTb};
          pg8::gemm_phase<pg8::EpiProj, pg8::StaticOrder, true, true>(lds, g, S, E); }
        xcd_barrier(xb);
#ifndef MIXREP
#define MIXREP 1
#endif
        for (int rep = 0; rep < MIXREP; ++rep) {
        if (rep > 0) { { FRESH_IDS(); const f32x4 z4 = {0.f, 0.f, 0.f, 0.f}; f32x4* sz = (f32x4*)(ws + WS_SSQ); for (int i = bx * NT + tid; i < 2 * M / 4; i += G * NT) sz[i] = z4; } xcd_barrier(xb); }
        { FRESH_IDS();
          for (int it = bx; it < 640 * 8; it += G)
              conv_item(it, RAW, DTb, KIN(8) + (size_t)l * 5 * 1024, KIN(9) + l * 1024, KIN(10) + l * 16, KIN(11) + l * 16, (bf16*)(ws + WS_XT), (bf16*)(ws + WS_BT), (bf16*)(ws + WS_BTOK), (bf16*)(ws + WS_CTOK),
                        (float*)(ws + WS_CUM), (float*)(ws + WS_DTA), (float*)(ws + WS_WST), lds, tid, wave, lane);
          { const int per = (5120 + G - 1) / G; const int u0 = bx * per, u1 = min(u0 + per, 5120);
            __syncthreads(); int vkey = -1, vhi = 0;
            for (int u = u0; u < u1; ++u) attn_fast_unit(u, QKV, (const float*)(ws + WS_TB) + (size_t)l * 8 * 4 * 15 * 512, KIN(14) + l * 512, (bf16*)out, (float*)(ws + WS_SSQ), lds, tid, wave, lane, vkey, vhi); } }
        xcd_barrier(xb);
        { FRESH_IDS();
          { const int strm = bx * 2 + (wave >> 2), nstr = 2 * G;
            if (nstr == 512) { s12_unit(strm, (const bf16*)(ws + WS_XT), (const bf16*)(ws + WS_BT), (const float*)(ws + WS_CUM), (const bf16*)(ws + WS_WST), (bf16*)(ws + WS_PREV), wave & 3, lane);
                if (strm >= 64 && strm < 128) s12_unit(448 + strm, (const bf16*)(ws + WS_XT), (const bf16*)(ws + WS_BT), (const float*)(ws + WS_CUM), (const bf16*)(ws + WS_WST), (bf16*)(ws + WS_PREV), wave & 3, lane); }
            else for (int u = strm; u < 576; u += nstr) s12_unit(u, (const bf16*)(ws + WS_XT), (const bf16*)(ws + WS_BT), (const float*)(ws + WS_CUM), (const bf16*)(ws + WS_WST), (bf16*)(ws + WS_PREV), wave & 3, lane); } }
        xcd_barrier(xb);
        { FRESH_IDS();
          for (int u = bx; u < 1280; u += G)
              s3_unit(u, (const bf16*)(ws + WS_XT), (const bf16*)(ws + WS_BTOK), (const bf16*)(ws + WS_CTOK), (const float*)(ws + WS_CUM), (const float*)(ws + WS_DTA), (const bf16*)(ws + WS_PREV), Zb,
                      KIN(12) + l * 8, KIN(13) + l * 512, (bf16*)out, (float*)(ws + WS_SSQ) + M, lds, tid, wave, lane); }
        xcd_barrier(xb);
        }
        { FRESH_IDS(); const float* ssq = (const float*)(ws + WS_SSQ);
          for (int m = gw; m < M; m += NGW) { const float sa = 1.f / sqrtf(ssq[m] * (1.f / 512.f) + RMS_EPS), ss = 1.f / sqrtf(ssq[M + m] * (1.f / 512.f) + RMS_EPS);
              u32x4* rowp = (u32x4*)((bf16*)out + (size_t)m * 1024) + lane;
#pragma unroll
              for (int hf = 0; hf < 2; ++hf) { const float f = hf ? ss : sa; u32x4 v = rowp[64 * hf];
                  v.x = pkbf(bf_lo(v.x) * f, bf_hi(v.x) * f); v.y = pkbf(bf_lo(v.y) * f, bf_hi(v.y) * f); v.z = pkbf(bf_lo(v.z) * f, bf_hi(v.z) * f); v.w = pkbf(bf_lo(v.w) * f, bf_hi(v.w) * f); rowp[64 * hf] = v; } } }
        xcd_barrier(xb);
        { FRESH_IDS(); pg8::Gemm g{(const bf16*)out, (const bf16*)(ws + WS_W + (size_t)l * W_LAYER + OW_OUT), M, D, D}; pg8::StaticOrder S; S.init(M, D, (int)gridDim.x, (int)blockIdx.x); pg8::EpiResidBf E{XB, 1.0f};
          pg8::gemm_phase<pg8::EpiResidBf, pg8::StaticOrder, true, true>(lds, g, S, E); }
        xcd_barrier(xb);
        { FRESH_IDS(); const float* g_ = KIN(17) + l * D; const float* b_ = KIN(18) + l * D;
          for (int m = gw; m < M; m += NGW) ln_row_bf(XB + (size_t)m * D, nullptr, g_, b_, lane); }
        xcd_barrier(xb);
        { FRESH_IDS(); pg8::Gemm g{XB, (const bf16*)(ws + WS_W + (size_t)l * W_LAYER + OW_GU2), M, NGU, D}; pg8::StaticOrder S; S.init(M, NGU, (int)gridDim.x, (int)blockIdx.x); pg8::EpiSwiGLU E{Hb, FF};
          pg8::gemm_phase<pg8::EpiSwiGLU, pg8::StaticOrder, true, true>(lds, g, S, E); }
        xcd_barrier(xb);
        { FRESH_IDS(); pg8::Gemm g{Hb, (const bf16*)(ws + WS_W + (size_t)l * W_LAYER + OW_D2), M, D, FF}; pg8::StaticOrder S; S.init(M, D, (int)gridDim.x, (int)blockIdx.x); pg8::EpiResidBf E{XB, 0.5f};
          pg8::gemm_phase<pg8::EpiResidBf, pg8::StaticOrder, true, true>(lds, g, S, E); }
        xcd_barrier(xb);
        { FRESH_IDS(); const float* g_ = KIN(22) + l * D; const float* b_ = KIN(23) + l * D;
          for (int m = gw; m < M; m += NGW) ln_row_bf(XB + (size_t)m * D, l == 1 ? out + (size_t)m * D : nullptr, g_, b_, lane); }
        if (l == 0) xcd_barrier(xb);
}

__global__ void __launch_bounds__(NT, 2) fwd_mega(Params P) {
    extern __shared__ __attribute__((aligned(16))) unsigned char lds_raw[];
    LAS unsigned char* lds = (LAS unsigned char*)lds_raw;
    cg::grid_group grid = cg::this_grid();
    volatile LAS unsigned* bst = (volatile LAS unsigned*)(lds + LDS_BYTES - 64);
    if (threadIdx.x < 2) bst[threadIdx.x] = 0u;
    __syncthreads();
    const XcdBarrier xb = xcd_barrier_post((unsigned*)KWS(), bst);
    { FRESH_IDS(); LAS float* scr = (LAS float*)(lds + wave * 16384);
      for (int it = gw; it < 2 * IT_LAYER; it += NGW) prologue_item(ws, it, scr, lane);
      { float* TBw = (float*)(ws + WS_TB);
        for (int i = bx * NT + tid; i < 2 * 8 * 4 * 15 * 512; i += G * NT) { const int kc = i & 31, q = (i >> 5) & 15; int t = i >> 9; const int ro = t % 15; t /= 15; const int j = t & 3; t >>= 2; const int h = t & 7, l = t >> 3;
            const int kstart = j == 0 ? 0 : (j == 1 ? 8 : (j == 2 ? 24 : 32)), qcol = 16 * j + q, kcol = kstart + kc, cst = min(max(qcol - 8, 0), 48);
            const bool valid = kcol >= cst && kcol < cst + 16;
            TBw[i] = valid ? 1.4426950408889634f * KIN(15)[((l * 8 + h) * 15 + ro) * 31 + (kcol - qcol + 15)] : -INFINITY; } }
      for (int m = gw; m < M; m += NGW) { const float* src = m < MPROMPT ? KIN(0) + (size_t)m * D : KIN(1) + (size_t)(m - MPROMPT) * D; row_to_bf16(src, XB + (size_t)m * D, lane); } }
    grid.sync();

    layer_body<0>(lds, xb);
    layer_body<1>(lds, xb);
}

extern "C" void kernel_launch(void* const* d_in, const int* in_sizes, int n_in, void* d_out, int out_size, void* d_ws, size_t ws_size, hipStream_t stream) {
    static int grid_blocks = 0;
    if (grid_blocks == 0) {
        if (n_in != 24 || out_size != M * D || ws_size < WS_END) { fprintf(stderr, "kernel_launch: unexpected shapes (n_in %d out %d ws %zu)\n", n_in, out_size, ws_size); grid_blocks = -1; return; }
        int dev = 0, cus = 0, per_cu = 0;
        (void)hipGetDevice(&dev); (void)hipDeviceGetAttribute(&cus, hipDeviceAttributeMultiprocessorCount, dev);
        if (hipFuncSetAttribute((const void*)fwd_mega, hipFuncAttributeMaxDynamicSharedMemorySize, LDS_BYTES) != hipSuccess) { fprintf(stderr, "kernel_launch: hipFuncSetAttribute failed\n"); grid_blocks = -1; return; }
        if (hipOccupancyMaxActiveBlocksPerMultiprocessor(&per_cu, (const void*)fwd_mega, NT, LDS_BYTES) != hipSuccess || per_cu < 1) { fprintf(stderr, "kernel_launch: occupancy query gave %d\n", per_cu); per_cu = 1; }
        (void)hipGetLastError();
        grid_blocks = cus * per_cu;
    }
    if (grid_blocks < 0) return;
    if (hipMemsetAsync(d_ws, 0, 65536, stream) != hipSuccess) { fprintf(stderr, "kernel_launch: memset of the barrier words failed\n"); return; }
    Params p{};
    for (int i = 0; i < 24; ++i) p.in[i] = (const float*)d_in[i];
    p.out = (float*)d_out; p.ws = (unsigned char*)d_ws;
    void* args[] = {&p};
    hipError_t e = hipLaunchCooperativeKernel((const void*)fwd_mega, dim3(grid_blocks), dim3(NT), args, LDS_BYTES, stream);
    if (e != hipSuccess) fprintf(stderr, "cooperative launch failed: %s (grid %d)\n", hipGetErrorString(e), grid_blocks);
}
```
